# Optimizing an MI355X kernel written in HIP

```python
import jax, jax.numpy as jnp
from jax import lax
import numpy as np

D_MODEL = 4096
BATCH = 2
SEQ = 4096
DEPTH = 2

GRID_W = 64
CTX_LEN = 256
D_LRU = D_MODEL // 2
LRU_HEADS = 16
LRU_BLOCK = D_LRU // LRU_HEADS
CONV_W = 4
LRU_C = 8.0
D_POOL = D_MODEL // 2
POOL_WINDOWS = (2, 4, 8, 16)
N_POOL = len(POOL_WINDOWS)
POOL_GROUP = D_POOL // N_POOL
D_IN_EVEN = 2 * D_LRU + D_POOL
MLSTM_HEADS = 8
MLSTM_DV = D_MODEL // MLSTM_HEADS
MLSTM_DQK = MLSTM_DV // 2
MLSTM_CHUNK = 64
D_IN_ODD = 2 * MLSTM_HEADS * MLSTM_DQK + 2 * D_MODEL + 4 * MLSTM_HEADS
N_EXPERTS = 16
D_EXPERT = D_MODEL // 4
CAPACITY_FACTOR = 2
N_EVEN = (DEPTH + 1) // 2
N_ODD = DEPTH // 2
DN_ALPHA = (2 * DEPTH) ** 0.25
DN_BETA = (8 * DEPTH) ** -0.25
LN_EPS = 1e-5

kernel_name = "hybrid_rglru_pool_mlstm_ecmoe_diffusion"

F32 = jnp.float32


def flip_seq(t):
    return t[:, ::-1]


def no_flip(t):
    return t


def layer_norm(x, g=None, b=None):
    xf = x.astype(F32)
    mu = jnp.mean(xf, axis=-1, keepdims=True)
    var = jnp.mean(jnp.square(xf - mu), axis=-1, keepdims=True)
    y = (xf - mu) * lax.rsqrt(var + LN_EPS)
    if g is not None:
        y = y * g + b
    return y.astype(x.dtype)


def adaln(cond, w, b):
    m = jax.nn.silu(cond) @ w + b
    return jnp.split(m[..., None, :], 6, axis=-1)


def dwconv(x, w, b):
    C = x.shape[-1]
    y = lax.conv_general_dilated(x, w[:, None, :].astype(x.dtype), window_strides=(1,),
                                 padding=[((CONV_W - 1) // 2, CONV_W // 2)],
                                 dimension_numbers=('NWC', 'WIO', 'NWC'), feature_group_count=C)
    return y + b


def linear_scan(a, bx, h0):
    def combine(l, r):
        return (l[0] * r[0], r[0] * l[1] + r[1])
    A, H = lax.associative_scan(combine, (a, bx), axis=1)
    return H + A * h0[:, None, :]


def rglru_coeffs(x, gate_w, gate_b, lam):
    B, L, _ = x.shape
    xb = x.reshape(B, L, LRU_HEADS, LRU_BLOCK)
    g = jnp.einsum('blhi,ghij->gblhj', xb, gate_w).reshape(2, B, L, D_LRU) + gate_b[:, None, None, :]
    r = jax.nn.sigmoid(g[0].astype(F32))
    i = jax.nn.sigmoid(g[1].astype(F32))
    log_a = LRU_C * r * jax.nn.log_sigmoid(lam.astype(F32))
    a = jnp.exp(log_a)
    mult = jnp.sqrt(-jnp.expm1(2.0 * log_a))
    return a, mult * (i * x.astype(F32))


def rglru_bidir(xc, xl, gate_w, gate_b, lam):
    B = xl.shape[0]
    out_c = 0.0
    out_l = 0.0
    for d in range(2):
        f = flip_seq if d else no_flip
        ac, bc = rglru_coeffs(f(xc), gate_w[d], gate_b[d], lam[d])
        hc = linear_scan(ac, bc, jnp.zeros((B, D_LRU), F32))
        al, bl = rglru_coeffs(f(xl), gate_w[d], gate_b[d], lam[d])
        hl = linear_scan(al, bl, hc[:, -1])
        out_c = out_c + f(hc)
        out_l = out_l + f(hl)
    return out_c, out_l


def window_mean(x, w, axis):
    L = x.shape[axis]
    pad = [(0, 0)] * x.ndim
    pad[axis] = (1, 0)
    cs = jnp.pad(jnp.cumsum(x.astype(F32), axis=axis), pad)
    pos = jnp.arange(L)
    lo = jnp.clip(pos - w // 2, 0, L)
    hi = jnp.clip(pos + w - w // 2, 0, L)
    shape = [1] * x.ndim
    shape[axis] = L
    cnt = (hi - lo).astype(F32).reshape(shape)
    return (jnp.take(cs, hi, axis=axis) - jnp.take(cs, lo, axis=axis)) / cnt


def pool_mix(s, pool_w, pool_scale, on_grid):
    B, L, _ = s.shape
    groups = s.reshape(B, L, N_POOL, POOL_GROUP)
    diffs = []
    for g, w in enumerate(POOL_WINDOWS):
        xg = groups[:, :, g]
        if on_grid:
            rows = L // GRID_W
            grid = xg.reshape(B, rows, GRID_W, POOL_GROUP)
            mean = window_mean(window_mean(grid, w, 2), w, 1).reshape(B, L, POOL_GROUP)
        else:
            mean = window_mean(xg, w, 1)
        diffs.append((mean - xg.astype(F32)).astype(s.dtype))
    d = jnp.stack(diffs, axis=2)
    y = jnp.einsum('blgi,gij->blgj', d, pool_w).reshape(B, L, D_POOL)
    return y * pool_scale


def even_mixer(uc, ul, w_in, conv_w, conv_b, gate_w, gate_b, lam, pool_w, pool_scale, w_out, ctx_out):
    xc, zc, sc = jnp.split(uc @ w_in, [D_LRU, 2 * D_LRU], axis=-1)
    xl, zl, sl = jnp.split(ul @ w_in, [D_LRU, 2 * D_LRU], axis=-1)
    hc, hl = rglru_bidir(dwconv(xc, conv_w, conv_b), dwconv(xl, conv_w, conv_b), gate_w, gate_b, lam)
    yl = jnp.concatenate([hl.astype(ul.dtype) * jax.nn.gelu(zl),
                          pool_mix(sl, pool_w, pool_scale, True)], axis=-1) @ w_out
    yc = None
    if ctx_out:
        yc = jnp.concatenate([hc.astype(uc.dtype) * jax.nn.gelu(zc),
                              pool_mix(sc, pool_w, pool_scale, False)], axis=-1) @ w_out
    return yc, yl


def mlstm_chunked(q, k, v, ig, lf, state):
    B, L, H, _ = q.shape
    nc = L // MLSTM_CHUNK

    def to_chunks(t):
        return jnp.moveaxis(t.reshape((B, nc, MLSTM_CHUNK) + t.shape[2:]), 1, 0)

    xs = (to_chunks(q), to_chunks(k), to_chunks(v), to_chunks(ig), to_chunks(lf))
    causal = jnp.tril(jnp.ones((MLSTM_CHUNK, MLSTM_CHUNK), bool))[None, :, :, None]

    def step(carry, inp):
        C, n, m = carry
        qc, kc, vc, ic, fc = inp
        b = jnp.cumsum(fc, axis=1)
        dmat = jnp.where(causal, b[:, :, None, :] - b[:, None, :, :] + ic[:, None, :, :], -jnp.inf)
        inter = b + m[:, None, :]
        m_comb = jnp.maximum(inter, jnp.max(dmat, axis=2))
        s = jnp.einsum('bthd,bshd->btsh', qc, kc) * jnp.exp(dmat - m_comb[:, :, None, :])
        e_inter = jnp.exp(inter - m_comb)
        num = jnp.einsum('btsh,bshv->bthv', s, vc) + e_inter[..., None] * jnp.einsum('bthd,bhdv->bthv', qc, C)
        den = jnp.sum(s, axis=2) + e_inter * jnp.einsum('bthd,bhd->bth', qc, n)
        h = num / jnp.maximum(jnp.abs(den), jnp.exp(-m_comb))[..., None]
        b_end = b[:, -1]
        g = b_end[:, None, :] - b + ic
        m_new = jnp.maximum(b_end + m, jnp.max(g, axis=1))
        w_s = jnp.exp(g - m_new[:, None, :])
        decay = jnp.exp(b_end + m - m_new)
        C_new = decay[..., None, None] * C + jnp.einsum('bsh,bshd,bshv->bhdv', w_s, kc, vc)
        n_new = decay[..., None] * n + jnp.einsum('bsh,bshd->bhd', w_s, kc)
        return (C_new, n_new, m_new), h

    state, hs = lax.scan(step, state, xs)
    return jnp.moveaxis(hs, 0, 1).reshape(B, L, H, MLSTM_DV), state


def head_norm(h, g):
    B, L = h.shape[:2]
    mu = jnp.mean(h, axis=-1, keepdims=True)
    var = jnp.mean(jnp.square(h - mu), axis=-1, keepdims=True)
    return ((h - mu) * lax.rsqrt(var + LN_EPS)).reshape(B, L, D_MODEL) * g


def odd_mixer(uc, ul, w_in, gate_b, norm_g, w_out, ctx_out):
    qk = MLSTM_HEADS * MLSTM_DQK
    split_at = [qk, 2 * qk, 2 * qk + D_MODEL, 2 * qk + 2 * D_MODEL]

    def project(u):
        B, L, _ = u.shape
        q, k, v, o, g = jnp.split(u @ w_in, split_at, axis=-1)
        q = q.reshape(B, L, MLSTM_HEADS, MLSTM_DQK).astype(F32) * (MLSTM_DQK ** -0.5)
        k = k.reshape(B, L, MLSTM_HEADS, MLSTM_DQK).astype(F32)
        v = v.reshape(B, L, MLSTM_HEADS, MLSTM_DV).astype(F32)
        g = (g + gate_b).astype(F32).reshape(B, L, 2, 2, MLSTM_HEADS)
        return q, k, v, o, g

    qc, kc, vc, oc, gc = project(uc)
    ql, kl, vl, ol, gl = project(ul)
    B = ul.shape[0]
    h_c = 0.0
    h_l = 0.0
    for d in range(2):
        f = flip_seq if d else no_flip
        state0 = (jnp.zeros((B, MLSTM_HEADS, MLSTM_DQK, MLSTM_DV), F32),
                  jnp.zeros((B, MLSTM_HEADS, MLSTM_DQK), F32),
                  jnp.zeros((B, MLSTM_HEADS), F32))
        out_c, state = mlstm_chunked(f(qc), f(kc), f(vc), f(gc[:, :, d, 0]),
                                     jax.nn.log_sigmoid(f(gc[:, :, d, 1])), state0)
        out_l, _ = mlstm_chunked(f(ql), f(kl), f(vl), f(gl[:, :, d, 0]),
                                 jax.nn.log_sigmoid(f(gl[:, :, d, 1])), state)
        h_c = h_c + f(out_c)
        h_l = h_l + f(out_l)

    def finish(h, o):
        y = jax.nn.sigmoid(o.astype(F32)) * head_norm(h, norm_g)
        return y.astype(o.dtype) @ w_out

    yl = finish(h_l, ol)
    yc = finish(h_c, oc) if ctx_out else None
    return yc, yl


def expert_choice_moe(x, w_router, w_gu, w_down):
    B, n, D = x.shape
    cap = CAPACITY_FACTOR * n // N_EXPERTS
    aff = jax.nn.softmax((x @ w_router).astype(F32), axis=-1)
    gsel, idx = lax.top_k(jnp.swapaxes(aff, 1, 2), cap)
    xe = jax.vmap(lambda xb, ib: xb[ib])(x, idx)
    hg, hu = jnp.split(jnp.einsum('becd,edf->becf', xe, w_gu), 2, axis=-1)
    ye = jnp.einsum('becf,efd->becd', jax.nn.silu(hg) * hu, w_down) * gsel[..., None].astype(x.dtype)
    return jax.vmap(lambda ib, yb: jnp.zeros((n, D), yb.dtype).at[ib.reshape(-1)].add(yb.reshape(-1, D)))(idx, ye)


def setup_inputs(seed: int = 0) -> dict:
    key = jax.random.key(seed)
    ks = jax.random.split(key, 26)
    D = D_MODEL

    def nrm(k, shape, s):
        return jax.random.normal(k, shape, F32) * s

    x = nrm(ks[0], (BATCH, SEQ, D), 1.0)
    c = nrm(ks[1], (BATCH, D), 1.0)
    ctx = nrm(ks[2], (BATCH, CTX_LEN, D), 1.0)
    c_ctx = nrm(ks[3], (D,), 1.0)
    ada_w = nrm(ks[4], (DEPTH, D, 6 * D), 0.5 * D ** -0.5)
    ada_b = nrm(ks[5], (DEPTH, 6 * D), 0.02)
    ln_g = 1.0 + nrm(ks[6], (DEPTH, 2, D), 0.02)
    ln_b = nrm(ks[7], (DEPTH, 2, D), 0.02)
    even_w_in = nrm(ks[8], (N_EVEN, D, D_IN_EVEN), D ** -0.5)
    even_conv_w = nrm(ks[9], (N_EVEN, CONV_W, D_LRU), CONV_W ** -0.5)
    even_conv_b = nrm(ks[10], (N_EVEN, D_LRU), 0.02)
    lru_gate_w = nrm(ks[11], (N_EVEN, 2, 2, LRU_HEADS, LRU_BLOCK, LRU_BLOCK), LRU_BLOCK ** -0.5)
    lru_gate_b = nrm(ks[12], (N_EVEN, 2, 2, D_LRU), 0.02)
    a_pow_c = jax.random.uniform(ks[13], (N_EVEN, 2, D_LRU), F32, 0.9, 0.999)
    sig = a_pow_c ** (1.0 / LRU_C)
    lru_lambda = jnp.log(sig) - jnp.log1p(-sig)
    pool_w = nrm(ks[14], (N_EVEN, N_POOL, POOL_GROUP, POOL_GROUP), POOL_GROUP ** -0.5)
    pool_scale = 1.0 + nrm(ks[15], (N_EVEN, D_POOL), 0.02)
    even_w_out = nrm(ks[16], (N_EVEN, D_LRU + D_POOL, D), DN_BETA * (D_LRU + D_POOL) ** -0.5)
    odd_w_in = nrm(ks[17], (N_ODD, D, D_IN_ODD), D ** -0.5)
    i_b = nrm(ks[18], (N_ODD, 2, 1, MLSTM_HEADS), 0.1)
    f_b = jnp.linspace(3.0, 6.0, MLSTM_HEADS, dtype=F32) + nrm(ks[19], (N_ODD, 2, 1, MLSTM_HEADS), 0.1)
    odd_gate_b = jnp.concatenate([i_b, f_b], axis=2).reshape(N_ODD, 4 * MLSTM_HEADS)
    odd_norm_g = 1.0 + nrm(ks[20], (N_ODD, D), 0.02)
    odd_w_out = nrm(ks[21], (N_ODD, D, D), DN_BETA * D ** -0.5)
    router_w = nrm(ks[22], (DEPTH, D, N_EXPERTS), D ** -0.5)
    expert_w_gu = nrm(ks[23], (DEPTH, N_EXPERTS, D, 2 * D_EXPERT), D ** -0.5)
    expert_w_down = nrm(ks[24], (DEPTH, N_EXPERTS, D_EXPERT, D), DN_BETA * D_EXPERT ** -0.5)
    return {"x": x, "c": c, "ctx": ctx, "c_ctx": c_ctx, "ada_w": ada_w, "ada_b": ada_b,
            "ln_g": ln_g, "ln_b": ln_b, "even_w_in": even_w_in, "even_conv_w": even_conv_w,
            "even_conv_b": even_conv_b, "lru_gate_w": lru_gate_w, "lru_gate_b": lru_gate_b,
            "lru_lambda": lru_lambda, "pool_w": pool_w, "pool_scale": pool_scale,
            "even_w_out": even_w_out, "odd_w_in": odd_w_in, "odd_gate_b": odd_gate_b,
            "odd_norm_g": odd_norm_g, "odd_w_out": odd_w_out, "router_w": router_w,
            "expert_w_gu": expert_w_gu, "expert_w_down": expert_w_down}


def reference(x, c, ctx, c_ctx, ada_w, ada_b, ln_g, ln_b, even_w_in, even_conv_w, even_conv_b,
              lru_gate_w, lru_gate_b, lru_lambda, pool_w, pool_scale, even_w_out, odd_w_in,
              odd_gate_b, odd_norm_g, odd_w_out, router_w, expert_w_gu, expert_w_down):
    h_lat = layer_norm(x)
    h_ctx = layer_norm(ctx)
    for layer in range(DEPTH):
        j = layer // 2
        need_ctx = layer < DEPTH - 1
        sh_l, sc_l, g_l, sh2_l, sc2_l, g2_l = adaln(c, ada_w[layer], ada_b[layer])
        sh_c, sc_c, g_c, sh2_c, sc2_c, g2_c = adaln(c_ctx, ada_w[layer], ada_b[layer])
        u_lat = h_lat * (1.0 + sc_l) + sh_l
        u_ctx = h_ctx * (1.0 + sc_c) + sh_c
        if layer % 2 == 0:
            y_ctx, y_lat = even_mixer(u_ctx, u_lat, even_w_in[j], even_conv_w[j], even_conv_b[j],
                                      lru_gate_w[j], lru_gate_b[j], lru_lambda[j], pool_w[j],
                                      pool_scale[j], even_w_out[j], need_ctx)
        else:
            y_ctx, y_lat = odd_mixer(u_ctx, u_lat, odd_w_in[j], odd_gate_b[j], odd_norm_g[j],
                                     odd_w_out[j], need_ctx)
        h_lat = layer_norm(DN_ALPHA * h_lat + g_l * y_lat, ln_g[layer, 0], ln_b[layer, 0])
        m_lat = expert_choice_moe(h_lat * (1.0 + sc2_l) + sh2_l, router_w[layer], expert_w_gu[layer], expert_w_down[layer])
        h_lat = layer_norm(DN_ALPHA * h_lat + g2_l * m_lat, ln_g[layer, 1], ln_b[layer, 1])
        if need_ctx:
            h_ctx = layer_norm(DN_ALPHA * h_ctx + g_c * y_ctx, ln_g[layer, 0], ln_b[layer, 0])
            m_ctx = expert_choice_moe(h_ctx * (1.0 + sc2_c) + sh2_c, router_w[layer], expert_w_gu[layer], expert_w_down[layer])
            h_ctx = layer_norm(DN_ALPHA * h_ctx + g2_c * m_ctx, ln_g[layer, 1], ln_b[layer, 1])
    return h_lat
```

```cpp
#ifndef MK_ONE_LAUNCH
#define MK_ONE_LAUNCH 0
#endif
#include <hip/hip_runtime.h>
#include <cstdio>
#include <cstdint>
namespace pg8 {
#define PG8_LAS __attribute__((address_space(3)))
typedef unsigned short bf16_t;
typedef short bf16x8 __attribute__((ext_vector_type(8)));
typedef float f32x4 __attribute__((ext_vector_type(4)));
typedef float f32x2 __attribute__((ext_vector_type(2)));
typedef unsigned u32x4 __attribute__((ext_vector_type(4)));
typedef unsigned u32x2 __attribute__((ext_vector_type(2)));
constexpr int BM = 256, BK = 64, HALF = 128, HTB = HALF * BK * 2  , STAGE_BYTES = 8 * HTB, NXCD = 8, WGM = 8;

__host__ __device__ __forceinline__ int lds_byte(int r, int c) { const int st = (r >> 4) * 2 + (c >> 5), rr = r & 15, cc = c & 31, ob = rr * 64 + cc * 2; return st * 1024 + (ob ^ (((ob >> 9) & 1) << 5)); }
__host__ __device__ __forceinline__ void stage_rc(int b, int& R, int& C) { const int st = b / 1024, sb = b % 1024, swz = sb ^ (((sb >> 9) & 1) << 5); R = (st >> 1) * 16 + swz / 64; C = (st & 1) * 32 + (swz % 64) / 2; }
__host__ __device__ __forceinline__ int perm32(int rho) { const int n = rho >> 4, i = rho & 15; return 8 * (i >> 2) + 4 * n + (i & 3); }

struct Unit { int pm, pn, g; };
struct Gemm { const bf16_t* A; const bf16_t* Bt; int lda, ldb, K; size_t gA, gB; };

struct TileOrder {
    int nG, nM, nN, per, nwg, G, c;
    __device__ __forceinline__ void init(int nG_, int nM_, int nN_, int G_, int c_) { nG = nG_; nM = nM_; nN = nN_; per = nM * nN; nwg = nG * per; G = G_; c = c_; }
    __device__ __forceinline__ bool next(int i, Unit& u) const {
        const long L = (long)i * G + c; if (L >= nwg) return false;
        int wgid = (int)L; { const int q = nwg / NXCD, r = nwg % NXCD, xcd = wgid % NXCD, off = wgid / NXCD; wgid = (xcd < r ? xcd * (q + 1) : r * (q + 1) + (xcd - r) * q) + off; }
        u.g = wgid / per; wgid -= u.g * per;
        const int nig = WGM * nN, gid = wgid / nig, fm = gid * WGM, gsz = (nM - fm) < WGM ? (nM - fm) : WGM;
        u.pm = fm + ((wgid % nig) % gsz); u.pn = (wgid % nig) / gsz; return true;
    }
};

__device__ __forceinline__ unsigned cvt_pk_bf16(float lo, float hi) { unsigned r; asm volatile("v_cvt_pk_bf16_f32 %0, %1, %2" : "=v"(r) : "v"(lo), "v"(hi)); return r; }

template <class Epi, class Sched>
__device__ __forceinline__ void gemm_phase(PG8_LAS unsigned char* lds, const Gemm g, const Sched& S, const Epi& E) {
    const int tid = threadIdx.x, wid = __builtin_amdgcn_readfirstlane(tid >> 6), lane = tid & 63, wr = wid >> 2, wc = wid & 3, fr = lane & 15, fq = lane >> 4;
    const int K = g.K, nt = K / BK;
    unsigned voffA[2], voffB[2];
#pragma unroll
    for (int i = 0; i < 2; ++i) { int R, C; stage_rc(tid * 16 + i * 8192, R, C); const int Rb = Epi::PERM ? ((R & ~31) + perm32(R & 31)) : R;
        voffA[i] = (unsigned)(R * g.lda + C) * 2u; voffB[i] = (unsigned)(Rb * g.ldb + C) * 2u; }
    const size_t kstep = (size_t)(BK * 2);
    const size_t hstepA = (size_t)HALF * g.lda * 2, hstepB = (size_t)HALF * g.ldb * 2;
    const size_t tstepA = 2 * hstepA, tstepB = 2 * hstepB;
    const unsigned ldsw = (unsigned)wid * 1024u;
    const int aoff = lds_byte(wr * 64 + fr, fq * 8), boff = lds_byte(wc * 32 + fr, fq * 8);
#define PG8_SA(b, h) (((b) * 2 + (h)) * HTB)
#define PG8_SB(b, h) ((4 + (b) * 2 + (h)) * HTB)
#define PG8_STAGE(bufoff, gbase, voff) do { _Pragma("unroll") for (int _i = 0; _i < 2; ++_i) \
        __builtin_amdgcn_global_load_lds((const unsigned*)((const char*)(gbase) + (voff)[_i]), (PG8_LAS unsigned*)(lds + (bufoff) + ldsw + _i * 8192), 16, 0, 0); } while (0)
#define PG8_LDA(dst, b, h) do { _Pragma("unroll") for (int m = 0; m < 4; ++m) _Pragma("unroll") for (int k = 0; k < 2; ++k) dst[m][k] = *(const PG8_LAS bf16x8*)(lds + PG8_SA(b, h) + aoff + m * 2048 + k * 1024); } while (0)
#define PG8_LDB(dst, b, h) do { _Pragma("unroll") for (int n = 0; n < 2; ++n) _Pragma("unroll") for (int k = 0; k < 2; ++k) dst[n][k] = *(const PG8_LAS bf16x8*)(lds + PG8_SB(b, h) + boff + n * 2048 + k * 1024); } while (0)
#define PG8_MMA(ai, bj, At, Bt) do { __builtin_amdgcn_s_setprio(1); _Pragma("unroll") for (int m = 0; m < 4; ++m) _Pragma("unroll") for (int n = 0; n < 2; ++n) _Pragma("unroll") for (int k = 0; k < 2; ++k) \
        acc[ai][bj][m][n] = __builtin_amdgcn_mfma_f32_16x16x32_bf16(Bt[n][k], At[m][k], acc[ai][bj][m][n], 0, 0, 0); __builtin_amdgcn_s_setprio(0); } while (0)
#define PG8_WAIT_V(n) asm volatile("s_waitcnt vmcnt(" #n ")" ::: "memory")
#define PG8_WAIT_L(n) asm volatile("s_waitcnt lgkmcnt(" #n ")" ::: "memory")
#define PG8_BAR __builtin_amdgcn_s_barrier()
#define PG8_SCHED __builtin_amdgcn_sched_barrier(0)
    Unit cur, nxt; int ui = 0;
    if (!S.next(0, cur)) return;
    f32x4 acc[2][2][4][2];
#pragma unroll
    for (int a = 0; a < 2; ++a)
#pragma unroll
        for (int b = 0; b < 2; ++b)
#pragma unroll
            for (int m = 0; m < 4; ++m)
#pragma unroll
                for (int n = 0; n < 2; ++n) acc[a][b][m][n] = (f32x4){0.f, 0.f, 0.f, 0.f};
    bf16x8 At[4][2], B0[2][2], B1[2][2];
    const char* cA = (const char*)g.A + (size_t)cur.g * g.gA + (size_t)cur.pm * tstepA; const char* cB = (const char*)g.Bt + (size_t)cur.g * g.gB + (size_t)cur.pn * tstepB;
    PG8_STAGE(PG8_SB(0, 0), cB, voffB); PG8_STAGE(PG8_SB(0, 1), cB + hstepB, voffB); PG8_STAGE(PG8_SA(0, 0), cA, voffA); PG8_STAGE(PG8_SA(0, 1), cA + hstepA, voffA);
    if (wr == 1) PG8_BAR;
    PG8_WAIT_V(2); PG8_BAR;
    PG8_STAGE(PG8_SB(1, 0), cB + kstep, voffB); PG8_STAGE(PG8_SA(1, 0), cA + kstep, voffA); PG8_STAGE(PG8_SB(1, 1), cB + hstepB + kstep, voffB);
    PG8_WAIT_V(6); PG8_BAR;
    for (;;) {
        const bool has_next = S.next(ui + 1, nxt);
        const char* nA = has_next ? (const char*)g.A + (size_t)nxt.g * g.gA + (size_t)nxt.pm * tstepA : cA; const char* nB = has_next ? (const char*)g.Bt + (size_t)nxt.g * g.gB + (size_t)nxt.pn * tstepB : cB;
        for (int t = 0; t < nt; t += 2) {
            const bool last = (t == nt - 2);
            const char* a1 = cA + (size_t)(t + 1) * kstep;
            const char* a2 = last ? nA : cA + (size_t)(t + 2) * kstep; const char* b2 = last ? nB : cB + (size_t)(t + 2) * kstep;
            const char* a3 = a2 + kstep; const char* b3 = b2 + kstep;
            PG8_LDB(B0, 0, 0); PG8_LDB(B1, 0, 1); PG8_SCHED; PG8_LDA(At, 0, 0); PG8_STAGE(PG8_SA(1, 1), a1 + hstepA, voffA);
            PG8_WAIT_V(8); PG8_WAIT_L(0); PG8_BAR; PG8_MMA(0, 0, At, B0); PG8_MMA(0, 1, At, B1); PG8_BAR; PG8_SCHED;
            PG8_LDA(At, 0, 1); PG8_STAGE(PG8_SB(0, 0), b2, voffB); PG8_STAGE(PG8_SB(0, 1), b2 + hstepB, voffB); PG8_STAGE(PG8_SA(0, 0), a2, voffA);
            PG8_WAIT_V(8); PG8_WAIT_L(0); PG8_BAR; PG8_MMA(1, 0, At, B0); PG8_MMA(1, 1, At, B1); PG8_BAR; PG8_SCHED;
            PG8_LDB(B0, 1, 0); PG8_LDB(B1, 1, 1); PG8_SCHED; PG8_LDA(At, 1, 0); PG8_STAGE(PG8_SA(0, 1), a2 + hstepA, voffA);
            PG8_WAIT_V(8); PG8_WAIT_L(0); PG8_BAR; PG8_MMA(0, 0, At, B0); PG8_MMA(0, 1, At, B1); PG8_BAR; PG8_SCHED;
            PG8_LDA(At, 1, 1); PG8_STAGE(PG8_SB(1, 0), b3, voffB); PG8_STAGE(PG8_SB(1, 1), b3 + hstepB, voffB); PG8_STAGE(PG8_SA(1, 0), a3, voffA);
            PG8_WAIT_V(8); PG8_WAIT_L(0); PG8_BAR; PG8_MMA(1, 0, At, B0); PG8_MMA(1, 1, At, B1); PG8_BAR; PG8_SCHED;
        }
        if (wr == 0) PG8_BAR;
        E(acc, cur, wr, wc, fr, fq);
        if (!has_next) break;
#pragma unroll
        for (int a = 0; a < 2; ++a)
#pragma unroll
            for (int b = 0; b < 2; ++b)
#pragma unroll
                for (int m = 0; m < 4; ++m)
#pragma unroll
                    for (int n = 0; n < 2; ++n) acc[a][b][m][n] = (f32x4){0.f, 0.f, 0.f, 0.f};
        cur = nxt; cA = nA; cB = nB; ++ui;
        if (wr == 1) PG8_BAR;
    }
    PG8_WAIT_V(0);
    PG8_BAR;
#undef PG8_SA
#undef PG8_SB
#undef PG8_STAGE
#undef PG8_LDA
#undef PG8_LDB
#undef PG8_MMA
#undef PG8_WAIT_V
#undef PG8_WAIT_L
#undef PG8_BAR
#undef PG8_SCHED
}
}
#define GAS __attribute__((address_space(1)))
#define LAS __attribute__((address_space(3)))
typedef unsigned short bf16;
typedef unsigned v4u __attribute__((ext_vector_type(4)));
typedef unsigned v2u __attribute__((ext_vector_type(2)));
typedef float f32x4 __attribute__((ext_vector_type(4)));
typedef float f32x2 __attribute__((ext_vector_type(2)));
typedef short bf16x8 __attribute__((ext_vector_type(8)));

constexpr int D = 4096, NB = 2, SEQ = 4096, CTXL = 256;
constexpr int ML = NB * SEQ, MC = NB * CTXL, MT = ML + MC;
constexpr int DLRU = 2048, LRUH = 16, LRUB = 128, DPOOL = 2048, DIN0 = 6144;
constexpr int MH = 8, DQK = 256, DV = 512, DIN1 = 12288, DIN1P = 12544, CHUNK = 64;
constexpr int NE = 16, DE = 1024;
constexpr int ER0 = 1280, ER1 = 1024;
constexpr float LN_EPS = 1e-5f, DN_ALPHA = 1.41421356237f;
constexpr int NT_TILES = 136;

constexpr size_t WS_CTL = 0ull, CTL_ZERO_BYTES = 1048576ull;
constexpr size_t WS_MOD = 1048576ull;
constexpr size_t WS_WRT = 1638400ull;
constexpr size_t WS_LS8 = 2162688ull;
constexpr size_t WS_W1T = 2179072ull;
constexpr size_t WS_W2T = 52510720ull;
constexpr size_t WS_W3T = 86065152ull;
constexpr size_t WS_W4T = 188825600ull;
constexpr size_t WS_WGU = 222380032ull;
constexpr size_t WS_WDN = 759250944ull;
constexpr size_t WS_GWT = 1027686400ull;
constexpr size_t WS_PWT = 1029783552ull;
constexpr size_t WS_H = 1031880704ull;
constexpr size_t WS_U = 1174487040ull;
constexpr size_t WS_BIG = 1245790208ull;
constexpr size_t WS_A2 = 1459699712ull;
constexpr size_t WS_CM = 1531002880ull;
constexpr size_t WS_DP = 1598111744ull;
constexpr size_t WS_SUMM = 1633763328ull;
constexpr size_t WS_CARRY = 1638219776ull;
constexpr size_t WS_AFF = 1640448000ull;
constexpr size_t WS_IDX = 1641496576ull;
constexpr size_t WS_GSEL = 1641627648ull;
constexpr size_t WS_INV = 1641758720ull;
constexpr size_t WS_GX = 1642315776ull;
constexpr size_t WS_XE = 1642397696ull;
constexpr size_t WS_ACT = 1810169856ull;
constexpr size_t WS_YE = 1852112896ull;
constexpr size_t WS_G = 2019885056ull;
constexpr size_t WS_HD = 2020999168ull;
constexpr size_t WS_END = 2155216896ull;

constexpr int CW_BAR = 4096;
constexpr int LDS_BYTES = 147456;
constexpr int MISC_OFF = 144 * 1024 - 256;
constexpr int NTHR = 512;

__device__ __forceinline__ unsigned f2bf(float f) { unsigned u = __builtin_bit_cast(unsigned, f); return (u + 0x7fffu + ((u >> 16) & 1u)) >> 16; }
__device__ __forceinline__ unsigned pk2(float lo, float hi) { return f2bf(lo) | (f2bf(hi) << 16); }
__device__ __forceinline__ float bf2f(unsigned b) { return __builtin_bit_cast(float, b << 16); }
__device__ __forceinline__ float bflo(unsigned w) { return __builtin_bit_cast(float, w << 16); }
__device__ __forceinline__ float bfhi(unsigned w) { return __builtin_bit_cast(float, w & 0xffff0000u); }
__device__ __forceinline__ float wave_sum(float v) {
#pragma unroll
    for (int o = 1; o < 64; o <<= 1) v += __shfl_xor(v, o);
    return v;
}
__device__ __forceinline__ float wave_max(float v) {
#pragma unroll
    for (int o = 1; o < 64; o <<= 1) v = fmaxf(v, __shfl_xor(v, o));
    return v;
}
__device__ __forceinline__ float sigmoidf_(float x) { return 1.f / (1.f + __expf(-x)); }
__device__ __forceinline__ float siluf_(float x) { return x / (1.f + __expf(-x)); }
__device__ __forceinline__ float logsigmoidf_(float x) { return fminf(x, 0.f) - log1pf(__expf(-fabsf(x))); }
__device__ __forceinline__ float gelu_tanh(float x) { const float u = 0.7978845608028654f * (x + 0.044715f * x * x * x); const float t = 1.f - 2.f / (__expf(2.f * u) + 1.f); return 0.5f * x * (1.f + t); }

__device__ __forceinline__ int seq_row0(int s) { return s < 2 ? s * SEQ : ML + (s - 2) * CTXL; }
__device__ __forceinline__ int seq_len(int s) { return s < 2 ? SEQ : CTXL; }
__device__ __forceinline__ int row_mod(int row) { return row < SEQ ? 0 : (row < ML ? 1 : 2); }
__device__ __forceinline__ int tile_row0(int tt) { return tt < 128 ? tt * 64 : ML + (tt - 128) * 64; }
__device__ __forceinline__ void tile_seq(int tt, int& lo, int& hi) { if (tt < 128) { lo = (tt >> 6) * SEQ; hi = lo + SEQ; } else { lo = ML + ((tt - 128) >> 2) * CTXL; hi = lo + CTXL; } }
struct Frame {
    LAS unsigned char* lds;
    int tid, lane, wave;
    int bid, G;
    unsigned char* ws;
    const float* in[24];
    float* out;
};
#define WSP(T, off) ((T*)(F.ws + (off)))

__device__ __forceinline__ void transpose_item(const float* W, int N, bf16* WT, int ldk, int k0, int n0, int drow0, LAS float* scr, int lane) {
#pragma unroll 8
    for (int i = 0; i < 32; ++i) { const int kk = 2 * i + (lane >> 5); scr[kk * 33 + (lane & 31)] = W[(size_t)(k0 + kk) * N + n0 + (lane & 31)]; }
    asm volatile("s_waitcnt lgkmcnt(0)" ::: "memory");
    const int c = lane & 7;
#pragma unroll
    for (int j = 0; j < 4; ++j) { const int n = (lane >> 3) + 8 * j; const LAS float* s = scr + (8 * c) * 33 + n;
        v4u o; o.x = pk2(s[0 * 33], s[1 * 33]); o.y = pk2(s[2 * 33], s[3 * 33]); o.z = pk2(s[4 * 33], s[5 * 33]); o.w = pk2(s[6 * 33], s[7 * 33]);
        *(v4u*)(WT + (size_t)(drow0 + n) * ldk + k0 + 8 * c) = o; }
    asm volatile("s_waitcnt lgkmcnt(0)" ::: "memory");
}

__device__ __forceinline__ void p0_convert(Frame& F) {
    LAS float* scr = (LAS float*)(F.lds + F.wave * 16384);
    const int gw = F.bid * 8 + F.wave, NGW = F.G * 8;
    constexpr int I0 = 64 * 192, I1 = 64 * 128, I2 = 64 * 385, I3 = 64 * 128, I4 = 32 * 4096, I5 = 32 * 2048, I6 = 64 * 8, I7 = 4 * 128;
    constexpr int NITEMS = I0 + I1 + I2 + I3 + I4 + I5 + I6 + I7;
    for (int it = gw; it < NITEMS; it += NGW) {
        int r = it;
        if (r < I0) { const int kb = r / 192, nb = r % 192; transpose_item(F.in[8], DIN0, WSP(bf16, WS_W1T), D, kb * 64, nb * 32, nb * 32, scr, F.lane); continue; } r -= I0;
        if (r < I1) { const int kb = r / 128, nb = r % 128; transpose_item(F.in[16], D, WSP(bf16, WS_W2T), D, kb * 64, nb * 32, nb * 32, scr, F.lane); continue; } r -= I1;
        if (r < I2) { const int kb = r / 385, nb = r % 385; transpose_item(F.in[17], 12320, WSP(bf16, WS_W3T), D, kb * 64, nb * 32, nb * 32, scr, F.lane); continue; } r -= I2;
        if (r < I3) { const int kb = r / 128, nb = r % 128; transpose_item(F.in[20], D, WSP(bf16, WS_W4T), D, kb * 64, nb * 32, nb * 32, scr, F.lane); continue; } r -= I3;
        if (r < I4) { const int mat = r / 4096, q = r % 4096, kb = q / 64, nb = q % 64, n0 = nb * 32;
            const int drow0 = 256 * ((n0 & 1023) >> 7) + 128 * (n0 >> 10) + (n0 & 127);
            transpose_item(F.in[22] + (size_t)mat * D * 2048, 2048, WSP(bf16, WS_WGU) + (size_t)mat * 2048 * D, D, kb * 64, n0, drow0, scr, F.lane); continue; } r -= I4;
        if (r < I5) { const int mat = r / 2048, q = r % 2048, kb = q / 128, nb = q % 128;
            transpose_item(F.in[23] + (size_t)mat * DE * D, D, WSP(bf16, WS_WDN) + (size_t)mat * D * DE, DE, kb * 64, nb * 32, nb * 32, scr, F.lane); continue; } r -= I5;
        if (r < I6) { const int mat = r / 8, q = r % 8, kb = q / 4, nb = q % 4;
            transpose_item(F.in[11] + (size_t)mat * 16384, 128, WSP(bf16, WS_GWT) + (size_t)mat * 16384, 128, kb * 64, nb * 32, nb * 32, scr, F.lane); continue; } r -= I6;
        { const int mat = r / 128, q = r % 128, kb = q / 16, nb = q % 16;
            transpose_item(F.in[14] + (size_t)mat * 262144, 512, WSP(bf16, WS_PWT) + (size_t)mat * 262144, 512, kb * 64, nb * 32, nb * 32, scr, F.lane); }
    }
    const int gt = F.bid * NTHR + F.tid, NGT = F.G * NTHR;
    float* wrt = WSP(float, WS_WRT);
    for (int i = gt; i < 2 * 16 * 4096; i += NGT) { const int l = i >> 16, e = (i >> 12) & 15, k = i & 4095; wrt[i] = F.in[21][(size_t)l * 65536 + k * 16 + e]; }
    float* ls8 = WSP(float, WS_LS8);
    for (int i = gt; i < 2 * DLRU; i += NGT) ls8[i] = 8.0f * logsigmoidf_(F.in[13][i]);
}

__device__ __forceinline__ void p0_adaln(Frame& F) {
    LAS float* sc = (LAS float*)F.lds;
    LAS float* red = (LAS float*)(F.lds + 49152);
    constexpr int NIT = 2 * 384;
    if (F.bid >= NIT) return;
    for (int i = F.tid; i < 3 * D; i += NTHR) { const int r = i >> 12, k = i & 4095; const float v = r < 2 ? F.in[1][r * D + k] : F.in[3][k]; sc[i] = siluf_(v); }
    __syncthreads();
    float* mod = WSP(float, WS_MOD);
    for (int it = F.bid; it < NIT; it += F.G) {
        const int l = it / 384, n0 = (it % 384) * 64;
        const float* W = F.in[4] + (size_t)l * D * 24576 + n0 + F.lane;
        float a0 = 0.f, a1 = 0.f, a2 = 0.f;
        const int kbeg = F.wave * 512;
#pragma unroll 16
        for (int k = kbeg; k < kbeg + 512; ++k) { const float w = W[(size_t)k * 24576]; a0 += sc[k] * w; a1 += sc[D + k] * w; a2 += sc[2 * D + k] * w; }
        red[(F.wave * 3 + 0) * 64 + F.lane] = a0; red[(F.wave * 3 + 1) * 64 + F.lane] = a1; red[(F.wave * 3 + 2) * 64 + F.lane] = a2;
        __syncthreads();
        if (F.tid < 192) { const int r = F.tid >> 6, ln = F.tid & 63; float s = 0.f;
#pragma unroll
            for (int w = 0; w < 8; ++w) s += red[(w * 3 + r) * 64 + ln];
            mod[((size_t)l * 3 + r) * 24576 + n0 + ln] = s + F.in[5][l * 24576 + n0 + ln]; }
        __syncthreads();
    }
}

struct RowV { f32x4 v[16]; };
__device__ __forceinline__ void row_stats(const RowV& r, float& mean, float& rstd) {
    float s = 0.f;
#pragma unroll
    for (int j = 0; j < 16; ++j) s += (r.v[j].x + r.v[j].y) + (r.v[j].z + r.v[j].w);
    mean = wave_sum(s) * (1.f / D);
    float q = 0.f;
#pragma unroll
    for (int j = 0; j < 16; ++j) { const f32x4 d = r.v[j] - mean; q += (d.x * d.x + d.y * d.y) + (d.z * d.z + d.w * d.w); }
    rstd = 1.f / sqrtf(wave_sum(q) * (1.f / D) + LN_EPS);
}

__device__ __forceinline__ void p1_ln0(Frame& F) {
    const int gw = F.bid * 8 + F.wave, NGW = F.G * 8;
    float* H = WSP(float, WS_H); bf16* U = WSP(bf16, WS_U); const float* mod = WSP(float, WS_MOD);
    for (int row = gw; row < MT; row += NGW) {
        const float* src = row < ML ? F.in[0] + (size_t)row * D : F.in[2] + (size_t)(row - ML) * D;
        RowV r;
#pragma unroll
        for (int j = 0; j < 16; ++j) r.v[j] = *(const f32x4*)(src + 4 * (F.lane + 64 * j));
        float mean, rstd; row_stats(r, mean, rstd);
        const float* m = mod + (size_t)(0 * 3 + row_mod(row)) * 24576;
#pragma unroll
        for (int j = 0; j < 16; ++j) { const int c = 4 * (F.lane + 64 * j); const f32x4 y = (r.v[j] - mean) * rstd;
            *(f32x4*)(H + (size_t)row * D + c) = y;
            const f32x4 sh = *(const f32x4*)(m + c), scl = *(const f32x4*)(m + D + c); const f32x4 u = y * (1.f + scl) + sh;
            v2u o; o.x = pk2(u.x, u.y); o.y = pk2(u.z, u.w); *(v2u*)(U + (size_t)row * D + c) = o; }
    }
}

using pg8::Unit;
struct EpiBf16Plain {
    static constexpr bool PERM = true;
    bf16* O; int ldc;
    __device__ __forceinline__ void operator()(const f32x4 (&acc)[2][2][4][2], const Unit& u, int wr, int wc, int fr, int fq) const {
        const int row0 = u.pm * 256 + wr * 64 + fr, col0 = u.pn * 256 + wc * 32 + 8 * fq;
#pragma unroll
        for (int ai = 0; ai < 2; ++ai)
#pragma unroll
            for (int m = 0; m < 4; ++m) { bf16* rowp = O + (size_t)(row0 + ai * 128 + m * 16) * ldc + col0;
#pragma unroll
                for (int bj = 0; bj < 2; ++bj) { const f32x4 v0 = acc[ai][bj][m][0], v1 = acc[ai][bj][m][1];
                    v4u w; w.x = pg8::cvt_pk_bf16(v0[0], v0[1]); w.y = pg8::cvt_pk_bf16(v0[2], v0[3]); w.z = pg8::cvt_pk_bf16(v1[0], v1[1]); w.w = pg8::cvt_pk_bf16(v1[2], v1[3]);
                    *(v4u*)(rowp + bj * 128) = w; } }
    }
};
struct EpiOddIn {
    static constexpr bool PERM = true;
    bf16* O; float* Gt; const float* gb;
    __device__ __forceinline__ void operator()(const f32x4 (&acc)[2][2][4][2], const Unit& u, int wr, int wc, int fr, int fq) const {
        const int row0 = u.pm * 256 + wr * 64 + fr;
        if (u.pn < 48) {
            const int col0 = u.pn * 256 + wc * 32 + 8 * fq;
#pragma unroll
            for (int ai = 0; ai < 2; ++ai)
#pragma unroll
                for (int m = 0; m < 4; ++m) { bf16* rowp = O + (size_t)(row0 + ai * 128 + m * 16) * DIN1 + col0;
#pragma unroll
                    for (int bj = 0; bj < 2; ++bj) { const f32x4 v0 = acc[ai][bj][m][0], v1 = acc[ai][bj][m][1];
                        v4u w; w.x = pg8::cvt_pk_bf16(v0[0], v0[1]); w.y = pg8::cvt_pk_bf16(v0[2], v0[3]); w.z = pg8::cvt_pk_bf16(v1[0], v1[1]); w.w = pg8::cvt_pk_bf16(v1[2], v1[3]);
                        *(v4u*)(rowp + bj * 128) = w; } }
        } else if (wc == 0) {
            const int c0 = 8 * fq; const f32x4 b0 = *(const f32x4*)(gb + c0), b1 = *(const f32x4*)(gb + c0 + 4);
#pragma unroll
            for (int ai = 0; ai < 2; ++ai)
#pragma unroll
                for (int m = 0; m < 4; ++m) { float* rowp = Gt + (size_t)(row0 + ai * 128 + m * 16) * 32 + c0;
                    *(f32x4*)(rowp) = acc[ai][0][m][0] + b0; *(f32x4*)(rowp + 4) = acc[ai][0][m][1] + b1; }
        }
    }
};
struct EpiResid {
    static constexpr bool PERM = false;
    float* H; const float* modl;
    int goff;
    __device__ __forceinline__ void operator()(const f32x4 (&acc)[2][2][4][2], const Unit& u, int wr, int wc, int fr, int fq) const {
        const int row0 = u.pm * 256 + wr * 64 + fr, col0 = u.pn * 256 + wc * 32 + 4 * fq;
        const float* gv = modl + (size_t)row_mod(u.pm * 256) * 24576 + goff + col0;
        f32x4 g[2][2];
#pragma unroll
        for (int bj = 0; bj < 2; ++bj)
#pragma unroll
            for (int n = 0; n < 2; ++n) g[bj][n] = *(const f32x4*)(gv + bj * 128 + n * 16);
#pragma unroll
        for (int ai = 0; ai < 2; ++ai)
#pragma unroll
            for (int m = 0; m < 4; ++m) { float* rowp = H + (size_t)(row0 + ai * 128 + m * 16) * D + col0;
#pragma unroll
                for (int bj = 0; bj < 2; ++bj)
#pragma unroll
                    for (int n = 0; n < 2; ++n) { const f32x4 h = *(const f32x4*)(rowp + bj * 128 + n * 16); *(f32x4*)(rowp + bj * 128 + n * 16) = DN_ALPHA * h + g[bj][n] * acc[ai][bj][m][n]; }
                asm volatile("" ::: "memory"); }
    }
};
struct EpiPool {
    static constexpr bool PERM = true;
    bf16* A2; const float* ps;
    __device__ __forceinline__ void operator()(const f32x4 (&acc)[2][2][4][2], const Unit& u, int wr, int wc, int fr, int fq) const {
        const int row0 = u.pm * 256 + wr * 64 + fr, col0 = 512 * u.g + u.pn * 256 + wc * 32 + 8 * fq;
#pragma unroll
        for (int ai = 0; ai < 2; ++ai)
#pragma unroll
            for (int m = 0; m < 4; ++m) { bf16* rowp = A2 + (size_t)(row0 + ai * 128 + m * 16) * D + 2048 + col0;
#pragma unroll
                for (int bj = 0; bj < 2; ++bj) { const f32x4 s0 = *(const f32x4*)(ps + col0 + bj * 128), s1 = *(const f32x4*)(ps + col0 + bj * 128 + 4);
                    const f32x4 v0 = acc[ai][bj][m][0] * s0, v1 = acc[ai][bj][m][1] * s1;
                    v4u w; w.x = pg8::cvt_pk_bf16(v0[0], v0[1]); w.y = pg8::cvt_pk_bf16(v0[2], v0[3]); w.z = pg8::cvt_pk_bf16(v1[0], v1[1]); w.w = pg8::cvt_pk_bf16(v1[2], v1[3]);
                    *(v4u*)(rowp + bj * 128) = w; } }
    }
};
struct EpiGU {
    static constexpr bool PERM = true;
    bf16* ACT; int er;
    __device__ __forceinline__ void operator()(const f32x4 (&acc)[2][2][4][2], const Unit& u, int wr, int wc, int fr, int fq) const {
        const int row0 = u.pm * 256 + wr * 64 + fr, col0 = u.pn * 128 + wc * 32 + 8 * fq;
        bf16* base = ACT + (size_t)u.g * er * DE;
#pragma unroll
        for (int ai = 0; ai < 2; ++ai)
#pragma unroll
            for (int m = 0; m < 4; ++m) { bf16* rowp = base + (size_t)(row0 + ai * 128 + m * 16) * DE + col0;
                f32x4 v0, v1;
#pragma unroll
                for (int j = 0; j < 4; ++j) { v0[j] = siluf_(acc[ai][0][m][0][j]) * acc[ai][1][m][0][j]; v1[j] = siluf_(acc[ai][0][m][1][j]) * acc[ai][1][m][1][j]; }
                v4u w; w.x = pg8::cvt_pk_bf16(v0[0], v0[1]); w.y = pg8::cvt_pk_bf16(v0[2], v0[3]); w.z = pg8::cvt_pk_bf16(v1[0], v1[1]); w.w = pg8::cvt_pk_bf16(v1[2], v1[3]);
                *(v4u*)(rowp) = w; }
    }
};
struct EpiDown {
    static constexpr bool PERM = true;
    bf16* YE; const float* GX; int er;
    __device__ __forceinline__ void operator()(const f32x4 (&acc)[2][2][4][2], const Unit& u, int wr, int wc, int fr, int fq) const {
        const int row0 = u.pm * 256 + wr * 64 + fr, col0 = u.pn * 256 + wc * 32 + 8 * fq;
        bf16* base = YE + (size_t)u.g * er * D; const float* gx = GX + u.g * er;
#pragma unroll
        for (int ai = 0; ai < 2; ++ai)
#pragma unroll
            for (int m = 0; m < 4; ++m) { const int row = row0 + ai * 128 + m * 16; const float s = gx[row]; bf16* rowp = base + (size_t)row * D + col0;
#pragma unroll
                for (int bj = 0; bj < 2; ++bj) { const f32x4 v0 = acc[ai][bj][m][0] * s, v1 = acc[ai][bj][m][1] * s;
                    v4u w; w.x = pg8::cvt_pk_bf16(v0[0], v0[1]); w.y = pg8::cvt_pk_bf16(v0[2], v0[3]); w.z = pg8::cvt_pk_bf16(v1[0], v1[1]); w.w = pg8::cvt_pk_bf16(v1[2], v1[3]);
                    *(v4u*)(rowp + bj * 128) = w; } }
    }
};
constexpr int LRU_XC = 0, LRU_AF = 17408, LRU_BF = 50176, LRU_HF = 82944;
template <bool APPLY>
__device__ __forceinline__ void lru_phase(Frame& F) {
    const bf16* XZS = WSP(bf16, WS_BIG);
    const bf16* GWT = WSP(bf16, WS_GWT);
    const float* LS8 = WSP(float, WS_LS8);
    float* SUMM = WSP(float, WS_SUMM); const float* CARRY = WSP(float, WS_CARRY);
    bf16* A2 = WSP(bf16, WS_A2);
    const float* convw = F.in[9]; const float* convb = F.in[10]; const float* gateb = F.in[12];
    const int wr = F.wave >> 2, wc = F.wave & 3, fr = F.lane & 15, fq = F.lane >> 4;
    LAS unsigned char* XC = F.lds + LRU_XC; LAS float* AF = (LAS float*)(F.lds + LRU_AF); LAS float* BF = (LAS float*)(F.lds + LRU_BF); LAS float* HF = (LAS float*)(F.lds + LRU_HF);
    for (int unit = F.bid; unit < NT_TILES * LRUH; unit += F.G) {
        const int tt = unit >> 4, h = unit & 15;
        const int r0 = tile_row0(tt); int slo, shi; tile_seq(tt, slo, shi);
        f32x4 xcv[2][2];
#pragma unroll
        for (int m = 0; m < 2; ++m)
#pragma unroll
            for (int n = 0; n < 2; ++n) {
                const int t = 32 * wr + 16 * m + fr, c = 32 * wc + 16 * n + 4 * fq, ch = h * 128 + c;
                f32x4 a = *(const f32x4*)(convb + ch);
#pragma unroll
                for (int j = 0; j < 4; ++j) { const int row = r0 + t + j - 1;
                    if (row >= slo && row < shi) { const v2u xv = *(const v2u*)(XZS + (size_t)row * DIN0 + ch); const f32x4 w = *(const f32x4*)(convw + j * DLRU + ch);
                        a.x += w.x * bflo(xv.x); a.y += w.y * bfhi(xv.x); a.z += w.z * bflo(xv.y); a.w += w.w * bfhi(xv.y); } }
                xcv[m][n] = a;
                v2u o; o.x = pk2(a.x, a.y); o.y = pk2(a.z, a.w); *(LAS v2u*)(XC + t * 272 + c * 2) = o;
            }
        __syncthreads();
#pragma unroll 1
        for (int d = 0; d < 2; ++d) {
            f32x4 acc[2][2][2];
#pragma unroll
            for (int g = 0; g < 2; ++g)
#pragma unroll
                for (int m = 0; m < 2; ++m)
#pragma unroll
                    for (int n = 0; n < 2; ++n) acc[g][m][n] = (f32x4){0.f, 0.f, 0.f, 0.f};
#pragma unroll
            for (int ks = 0; ks < 4; ++ks) {
                bf16x8 af[2];
#pragma unroll
                for (int m = 0; m < 2; ++m) af[m] = *(const LAS bf16x8*)(XC + (32 * wr + 16 * m + fr) * 272 + (ks * 32 + fq * 8) * 2);
#pragma unroll
                for (int g = 0; g < 2; ++g)
#pragma unroll
                    for (int n = 0; n < 2; ++n) { const bf16x8 bfv = *(const bf16x8*)(GWT + (size_t)((d * 2 + g) * 16 + h) * 16384 + (32 * wc + 16 * n + fr) * 128 + ks * 32 + fq * 8);
#pragma unroll
                        for (int m = 0; m < 2; ++m) acc[g][m][n] = __builtin_amdgcn_mfma_f32_16x16x32_bf16(bfv, af[m], acc[g][m][n], 0, 0, 0); }
            }
#pragma unroll
            for (int m = 0; m < 2; ++m)
#pragma unroll
                for (int n = 0; n < 2; ++n) {
                    const int t = 32 * wr + 16 * m + fr, c = 32 * wc + 16 * n + 4 * fq, ch = h * 128 + c;
                    const f32x4 b0 = *(const f32x4*)(gateb + (d * 2 + 0) * DLRU + ch), b1 = *(const f32x4*)(gateb + (d * 2 + 1) * DLRU + ch), l8 = *(const f32x4*)(LS8 + d * DLRU + ch);
                    f32x4 av, bv;
#pragma unroll
                    for (int j = 0; j < 4; ++j) { const float r = sigmoidf_(acc[0][m][n][j] + b0[j]), ig = sigmoidf_(acc[1][m][n][j] + b1[j]);
                        const float la = l8[j] * r; av[j] = __expf(la); bv[j] = sqrtf(-expm1f(2.f * la)) * ig * xcv[m][n][j]; }
                    *(LAS f32x4*)(AF + t * 128 + c) = av; *(LAS f32x4*)(BF + t * 128 + c) = bv;
                }
            __syncthreads();
            if (F.tid < 128) {
                const int c = F.tid, ch = h * 128 + c;
                if (!APPLY) {
                    float hs = 0.f, P = 1.f;
                    if (d == 0) { for (int t = 0; t < 64; ++t) { const float a = AF[t * 128 + c]; hs = a * hs + BF[t * 128 + c]; P *= a; } }
                    else { for (int t = 63; t >= 0; --t) { const float a = AF[t * 128 + c]; hs = a * hs + BF[t * 128 + c]; P *= a; } }
                    SUMM[((size_t)(tt * 2 + d) * 2 + 0) * DLRU + ch] = P; SUMM[((size_t)(tt * 2 + d) * 2 + 1) * DLRU + ch] = hs;
                } else {
                    float hs = CARRY[(size_t)(tt * 2 + d) * DLRU + ch];
                    if (d == 0) { for (int t = 0; t < 64; ++t) { hs = AF[t * 128 + c] * hs + BF[t * 128 + c]; HF[t * 128 + c] = hs; } }
                    else { for (int t = 63; t >= 0; --t) { hs = AF[t * 128 + c] * hs + BF[t * 128 + c];
                            const float z = bf2f(XZS[(size_t)(r0 + t) * DIN0 + DLRU + ch]);
                            A2[(size_t)(r0 + t) * D + ch] = (bf16)f2bf((HF[t * 128 + c] + hs) * gelu_tanh(z)); } }
                }
            }
            __syncthreads();
        }
    }
}

__device__ __forceinline__ void lru_carry(Frame& F) {
    const float* SUMM = WSP(float, WS_SUMM); float* CARRY = WSP(float, WS_CARRY);
    const int gt = F.bid * NTHR + F.tid, NGT = F.G * NTHR;
    for (int i = gt; i < NB * 2 * DLRU; i += NGT) {
        const int ch = i & 2047, d = (i >> 11) & 1, b = i >> 12;
        float st = 0.f;
        for (int s = 0; s < 68; ++s) {
            int tt; if (s < 4) tt = 128 + 4 * b + (d ? 3 - s : s); else tt = 64 * b + (d ? 63 - (s - 4) : (s - 4));
            CARRY[(size_t)(tt * 2 + d) * DLRU + ch] = st;
            st = SUMM[((size_t)(tt * 2 + d) * 2 + 0) * DLRU + ch] * st + SUMM[((size_t)(tt * 2 + d) * 2 + 1) * DLRU + ch];
        }
    }
}

__device__ __forceinline__ int pool_w_of(int g) { return 2 << g; }
__device__ __forceinline__ void pool_pass1(Frame& F) {
    const bf16* XZS = WSP(bf16, WS_BIG); float* CM = WSP(float, WS_CM);
    LAS unsigned char* T = F.lds;
    for (int unit = F.bid; unit < NB * 64 * 4; unit += F.G) {
        const int g = unit & 3, gr = (unit >> 2) & 63, b = unit >> 8; const int row0 = b * SEQ + gr * 64, w = pool_w_of(g);
        for (int i = F.tid; i < 64 * 64; i += NTHR) { const int r = i >> 6, cseg = i & 63;
            *(LAS v4u*)(T + r * 1024 + cseg * 16) = *(const v4u*)(XZS + (size_t)(row0 + r) * DIN0 + 2 * DLRU + g * 512 + cseg * 8); }
        __syncthreads();
        const int cp = F.tid & 255, half = F.tid >> 8;
        for (int j = half * 32; j < half * 32 + 32; ++j) {
            const int lo = max(0, j - w / 2), hi = min(64, j + w - w / 2);
            float s0 = 0.f, s1 = 0.f;
            for (int q = lo; q < hi; ++q) { const unsigned v = *(const LAS unsigned*)(T + q * 1024 + cp * 4); s0 += bflo(v); s1 += bfhi(v); }
            const float inv = 1.f / (float)(hi - lo);
            *(f32x2*)(CM + (size_t)(row0 + j) * DPOOL + g * 512 + 2 * cp) = (f32x2){s0 * inv, s1 * inv};
        }
        __syncthreads();
    }
}
__device__ __forceinline__ void pool_pass2(Frame& F) {
    const bf16* XZS = WSP(bf16, WS_BIG); const float* CM = WSP(float, WS_CM); bf16* DP = WSP(bf16, WS_DP);
    LAS float* T = (LAS float*)F.lds;
    for (int unit = F.bid; unit < NB * 64 * 4 * 2; unit += F.G) {
        const int hc = unit & 1, g = (unit >> 1) & 3, gc = (unit >> 3) & 63, b = unit >> 9; const int w = pool_w_of(g), cb = g * 512 + hc * 256;
        for (int i = F.tid; i < 64 * 64; i += NTHR) { const int r = i >> 6, cseg = i & 63;
            *(LAS f32x4*)(T + r * 256 + cseg * 4) = *(const f32x4*)(CM + (size_t)(b * SEQ + r * 64 + gc) * DPOOL + cb + cseg * 4); }
        __syncthreads();
        const int c = F.tid & 255, half = F.tid >> 8;
        for (int r = half * 32; r < half * 32 + 32; ++r) {
            const int lo = max(0, r - w / 2), hi = min(64, r + w - w / 2);
            float s = 0.f;
            for (int q = lo; q < hi; ++q) s += T[q * 256 + c];
            const size_t tok = (size_t)(b * SEQ + r * 64 + gc);
            const float x = bf2f(XZS[tok * DIN0 + 2 * DLRU + cb + c]);
            DP[tok * DPOOL + cb + c] = (bf16)f2bf(s / (float)(hi - lo) - x);
        }
        __syncthreads();
    }
}
__device__ __forceinline__ void pool_ctx(Frame& F) {
    const bf16* XZS = WSP(bf16, WS_BIG); bf16* DP = WSP(bf16, WS_DP);
    const int gt = F.bid * NTHR + F.tid, NGT = F.G * NTHR;
    for (int i = gt; i < MC * DPOOL; i += NGT) {
        const int ch = i & 2047, r = i >> 11, b = r >> 8, t = r & 255; const int w = pool_w_of(ch >> 9);
        const int lo = max(0, t - w / 2), hi = min(CTXL, t + w - w / 2);
        float s = 0.f;
        for (int q = lo; q < hi; ++q) s += bf2f(XZS[(size_t)(ML + b * CTXL + q) * DIN0 + 2 * DLRU + ch]);
        const float x = bf2f(XZS[(size_t)(ML + r) * DIN0 + 2 * DLRU + ch]);
        DP[(size_t)(ML + r) * DPOOL + ch] = (bf16)f2bf(s / (float)(hi - lo) - x);
    }
}
__device__ __forceinline__ void ln_router_phase(Frame& F, int l, int nrows) {
    const int gw = F.bid * 8 + F.wave, NGW = F.G * 8;
    float* H = WSP(float, WS_H); bf16* U = WSP(bf16, WS_U); const float* mod = WSP(float, WS_MOD) + (size_t)l * 3 * 24576;
    const float* wrt = WSP(float, WS_WRT) + (size_t)l * 16 * D; float* AFF = WSP(float, WS_AFF);
    const float* lg = F.in[6] + (size_t)(l * 2 + 0) * D; const float* lb = F.in[7] + (size_t)(l * 2 + 0) * D;
    for (int row = gw; row < nrows; row += NGW) {
        RowV r;
#pragma unroll
        for (int j = 0; j < 16; ++j) r.v[j] = *(const f32x4*)(H + (size_t)row * D + 4 * (F.lane + 64 * j));
        float mean, rstd; row_stats(r, mean, rstd);
        const float* m = mod + (size_t)row_mod(row) * 24576;
#pragma unroll
        for (int j = 0; j < 16; ++j) { const int c = 4 * (F.lane + 64 * j);
            const f32x4 y = (r.v[j] - mean) * rstd * *(const f32x4*)(lg + c) + *(const f32x4*)(lb + c);
            *(f32x4*)(H + (size_t)row * D + c) = y;
            const f32x4 sh = *(const f32x4*)(m + 3 * D + c), scl = *(const f32x4*)(m + 4 * D + c); const f32x4 u = y * (1.f + scl) + sh;
            v2u o; o.x = pk2(u.x, u.y); o.y = pk2(u.z, u.w); *(v2u*)(U + (size_t)row * D + c) = o;
            r.v[j] = u; }
        float mylogit = 0.f;
#pragma unroll 1
        for (int e = 0; e < 16; ++e) { float s = 0.f;
#pragma unroll
            for (int j = 0; j < 16; ++j) { const f32x4 w = *(const f32x4*)(wrt + (size_t)e * D + 4 * (F.lane + 64 * j)); s += (r.v[j].x * w.x + r.v[j].y * w.y) + (r.v[j].z * w.z + r.v[j].w * w.w); }
            s = wave_sum(s); if (F.lane == e) mylogit = s; }
        float v = F.lane < 16 ? mylogit : -3.0e38f;
        const float mx = wave_max(v); const float ex = F.lane < 16 ? __expf(v - mx) : 0.f; const float den = wave_sum(ex);
        if (F.lane < 16) { int s, n; if (row < ML) { s = row >> 12; n = row & 4095; } else { s = 2 + ((row - ML) >> 8); n = (row - ML) & 255; }
            AFF[((size_t)s * 16 + F.lane) * SEQ + n] = ex / den; }
    }
}

__device__ __forceinline__ void topk_phase(Frame& F, int nseq) {
    const float* AFF = WSP(float, WS_AFF); int* IDX = WSP(int, WS_IDX); float* GSEL = WSP(float, WS_GSEL); int* INV = WSP(int, WS_INV);
    LAS unsigned long long* key = (LAS unsigned long long*)F.lds;
    for (int p = F.bid; p < nseq * 16; p += F.G) {
        const int s = p >> 4, e = p & 15, n = seq_len(s), cap = n >> 3;
        for (int i = F.tid; i < n; i += NTHR) { const float a = AFF[((size_t)s * 16 + e) * SEQ + i]; key[i] = ((unsigned long long)__builtin_bit_cast(unsigned, a) << 32) | (unsigned long long)(0xFFFFFFFFu - (unsigned)i); }
        __syncthreads();
        for (int k = 2; k <= n; k <<= 1)
            for (int j = k >> 1; j > 0; j >>= 1) {
                for (int i = F.tid; i < n; i += NTHR) { const int ixj = i ^ j;
                    if (ixj > i) { const unsigned long long a = key[i], b = key[ixj]; const bool desc = (i & k) == 0;
                        if (desc ? (a < b) : (a > b)) { key[i] = b; key[ixj] = a; } } }
                __syncthreads();
            }
        const int rbase = seq_row0(s);
        for (int i = F.tid; i < n; i += NTHR) { const unsigned long long kk = key[i]; const int tok = (int)(0xFFFFFFFFu - (unsigned)(kk & 0xFFFFFFFFull));
            if (i < cap) { IDX[(s * 16 + e) * 512 + i] = tok; GSEL[(s * 16 + e) * 512 + i] = __builtin_bit_cast(float, (unsigned)(kk >> 32)); }
            INV[(size_t)(rbase + tok) * 16 + e] = i < cap ? i : -1; }
        __syncthreads();
    }
}

__device__ __forceinline__ bool erow_decode(int r, int& s, int& slot) {
    if (r < 512) { s = 0; slot = r; return true; } if (r < 1024) { s = 1; slot = r - 512; return true; }
    if (r < 1056) { s = 2; slot = r - 1024; return true; } if (r < 1088) { s = 3; slot = r - 1056; return true; } return false;
}
__device__ __forceinline__ int slot_base(int s) { return s == 0 ? 0 : (s == 1 ? 512 : (s == 2 ? 1024 : 1056)); }

__device__ __forceinline__ void gather_phase(Frame& F, int er) {
    const int gw = F.bid * 8 + F.wave, NGW = F.G * 8;
    const bf16* U = WSP(bf16, WS_U); bf16* XE = WSP(bf16, WS_XE); float* GX = WSP(float, WS_GX);
    const int* IDX = WSP(int, WS_IDX); const float* GSEL = WSP(float, WS_GSEL);
    for (int i = gw; i < 16 * er; i += NGW) {
        const int e = i / er, r = i - e * er; int s, slot; const bool ok = erow_decode(r, s, slot);
        v4u* dst = (v4u*)(XE + (size_t)i * D);
        if (ok) { const int tok = IDX[(s * 16 + e) * 512 + slot]; const v4u* src = (const v4u*)(U + (size_t)(seq_row0(s) + tok) * D);
#pragma unroll
            for (int j = 0; j < 8; ++j) dst[F.lane + 64 * j] = src[F.lane + 64 * j];
            if (F.lane == 0) GX[i] = GSEL[(s * 16 + e) * 512 + slot];
        } else {
#pragma unroll
            for (int j = 0; j < 8; ++j) dst[F.lane + 64 * j] = (v4u){0u, 0u, 0u, 0u};
            if (F.lane == 0) GX[i] = 0.f; }
    }
}

template <bool LAST>
__device__ __forceinline__ void combine_phase(Frame& F, int l, int nrows, int er) {
    const int gw = F.bid * 8 + F.wave, NGW = F.G * 8;
    float* H = WSP(float, WS_H); bf16* U = WSP(bf16, WS_U); const float* mod = WSP(float, WS_MOD) + (size_t)l * 3 * 24576; const float* modn = WSP(float, WS_MOD) + (size_t)(l + 1) * 3 * 24576;
    const bf16* YE = WSP(bf16, WS_YE); const int* INV = WSP(int, WS_INV);
    const float* lg = F.in[6] + (size_t)(l * 2 + 1) * D; const float* lb = F.in[7] + (size_t)(l * 2 + 1) * D;
    for (int row = gw; row < nrows; row += NGW) {
        RowV r, ms;
#pragma unroll
        for (int j = 0; j < 16; ++j) { r.v[j] = *(const f32x4*)(H + (size_t)row * D + 4 * (F.lane + 64 * j)); ms.v[j] = (f32x4){0.f, 0.f, 0.f, 0.f}; }
        const int s = row < ML ? (row >> 12) : 2 + ((row - ML) >> 8); const int sb = slot_base(s);
#pragma unroll 1
        for (int e = 0; e < 16; ++e) { const int slot = INV[(size_t)row * 16 + e];
            if (slot >= 0) { const bf16* y = YE + ((size_t)e * er + sb + slot) * D;
#pragma unroll
                for (int j = 0; j < 16; ++j) { const v2u w = *(const v2u*)(y + 4 * (F.lane + 64 * j)); ms.v[j].x += bflo(w.x); ms.v[j].y += bfhi(w.x); ms.v[j].z += bflo(w.y); ms.v[j].w += bfhi(w.y); } } }
        const float* m = mod + (size_t)row_mod(row) * 24576;
#pragma unroll
        for (int j = 0; j < 16; ++j) { const f32x4 g2 = *(const f32x4*)(m + 5 * D + 4 * (F.lane + 64 * j)); r.v[j] = DN_ALPHA * r.v[j] + g2 * ms.v[j]; }
        float mean, rstd; row_stats(r, mean, rstd);
        const float* mn = modn + (size_t)row_mod(row) * 24576;
#pragma unroll
        for (int j = 0; j < 16; ++j) { const int c = 4 * (F.lane + 64 * j);
            const f32x4 y = (r.v[j] - mean) * rstd * *(const f32x4*)(lg + c) + *(const f32x4*)(lb + c);
            if (LAST) { *(f32x4*)(F.out + (size_t)row * D + c) = y; }
            else { *(f32x4*)(H + (size_t)row * D + c) = y;
                const f32x4 sh = *(const f32x4*)(mn + c), scl = *(const f32x4*)(mn + D + c); const f32x4 u = y * (1.f + scl) + sh;
                v2u o; o.x = pk2(u.x, u.y); o.y = pk2(u.z, u.w); *(v2u*)(U + (size_t)row * D + c) = o; } }
    }
}
template <int MR, int NR>
__device__ __forceinline__ void mma_lds(f32x4 (&acc)[MR][NR], const LAS unsigned char* A, int strideA, int arow0, const LAS unsigned char* B, int strideB, int brow0, int K, int fr, int fq) {
    for (int ks = 0; ks < K; ks += 32) {
        bf16x8 af[MR], bfv[NR];
#pragma unroll
        for (int m = 0; m < MR; ++m) af[m] = *(const LAS bf16x8*)(A + (arow0 + 16 * m + fr) * strideA + (ks + fq * 8) * 2);
#pragma unroll
        for (int n = 0; n < NR; ++n) bfv[n] = *(const LAS bf16x8*)(B + (brow0 + 16 * n + fr) * strideB + (ks + fq * 8) * 2);
#pragma unroll
        for (int m = 0; m < MR; ++m)
#pragma unroll
            for (int n = 0; n < NR; ++n) acc[m][n] = __builtin_amdgcn_mfma_f32_16x16x32_bf16(bfv[n], af[m], acc[m][n], 0, 0, 0);
    }
}
constexpr int ML_R1 = 0, ML_KS = 36864, ML_VT = 70656, ML_VW = 79872, ML_SP = 89088, ML_CT = 98304, ML_SM = 132096;
constexpr int SM_A = 0, SM_ROWC = 64, SM_EINT = 128, SM_LOW = 192, SM_W = 256, SM_DEN4 = 320, SM_QN = 576, SM_NST = 640, SM_SCAL = 896;
__device__ __forceinline__ v4u scale_bf16x8_16th(v4u v) {
    v4u o;
#pragma unroll
    for (int i = 0; i < 4; ++i) { const unsigned w = v[i]; o[i] = pk2(bflo(w) * 0.0625f, bfhi(w) * 0.0625f); }
    return o;
}
__device__ __forceinline__ void mlstm_phase(Frame& F) {
    const bf16* QKVO = WSP(bf16, WS_BIG); const float* Gt = WSP(float, WS_G); bf16* HD = WSP(bf16, WS_HD);
    LAS unsigned char* R1 = F.lds + ML_R1; LAS unsigned char* KS = F.lds + ML_KS; LAS unsigned char* VT = F.lds + ML_VT; LAS unsigned char* VW = F.lds + ML_VW;
    LAS unsigned char* SP = F.lds + ML_SP; LAS unsigned char* CT = F.lds + ML_CT; LAS float* SM = (LAS float*)(F.lds + ML_SM);
    const int wr = F.wave >> 2, wc = F.wave & 3, fr = F.lane & 15, fq = F.lane >> 4, tid = F.tid;
    for (int unit = F.bid; unit < 256; unit += F.G) {
        const int x = unit & 7, y = unit >> 3; const int combo = x + 8 * (y >> 3), jv = y & 7;
        const int b = combo >> 4, h = (combo >> 1) & 7, d = combo & 1;
        f32x4 accC[2][4];
#pragma unroll
        for (int m = 0; m < 2; ++m)
#pragma unroll
            for (int n = 0; n < 4; ++n) accC[m][n] = (f32x4){0.f, 0.f, 0.f, 0.f};
        float n_reg = 0.f, m_prev = 0.f;
#pragma unroll 1
        for (int step = 0; step < 68; ++step) {
            const bool lat = step >= 4;
            int base; if (!lat) base = ML + b * CTXL + 64 * (d ? 3 - step : step); else base = b * SEQ + 64 * (d ? 63 - (step - 4) : (step - 4));
            if (F.wave == 0) {
                const int row = base + (d ? 63 - F.lane : F.lane);
                const float ig = Gt[(size_t)row * 32 + d * 16 + h], fp = Gt[(size_t)row * 32 + d * 16 + 8 + h];
                float bc = logsigmoidf_(fp);
#pragma unroll
                for (int o = 1; o < 64; o <<= 1) { const float t = __shfl_up(bc, o); if (F.lane >= o) bc += t; }
                const float a = ig - bc; float pm = a;
#pragma unroll
                for (int o = 1; o < 64; o <<= 1) { const float t = __shfl_up(pm, o); if (F.lane >= o) pm = fmaxf(pm, t); }
                const float mcomb = bc + fmaxf(m_prev, pm);
                const float bend = __shfl(bc, 63), pm63 = __shfl(pm, 63);
                const float m_new = fmaxf(bend + m_prev, bend + pm63);
                SM[SM_A + F.lane] = a; SM[SM_ROWC + F.lane] = bc - mcomb; SM[SM_EINT + F.lane] = __expf(bc + m_prev - mcomb); SM[SM_LOW + F.lane] = __expf(-mcomb);
                SM[SM_W + F.lane] = __expf(bend + a - m_new);
                if (F.lane == 0) { SM[SM_SCAL + 0] = __expf(bend + m_prev - m_new); SM[SM_SCAL + 1] = m_new; }
            }
            {
                v4u kq[4], qq[4]; v4u vv;
#pragma unroll
                for (int i = 0; i < 4; ++i) { const int q = tid + 512 * i, r = q >> 5, cs = q & 31; const size_t row = (size_t)(base + (d ? 63 - r : r));
                    kq[i] = *(const v4u*)(QKVO + row * DIN1 + 2048 + h * DQK + cs * 8);
                    if (lat) qq[i] = *(const v4u*)(QKVO + row * DIN1 + h * DQK + cs * 8); }
                { const int r = tid >> 3, cs = tid & 7; const size_t row = (size_t)(base + (d ? 63 - r : r)); vv = *(const v4u*)(QKVO + row * DIN1 + 4096 + h * DV + jv * 64 + cs * 8); }
#pragma unroll
                for (int i = 0; i < 4; ++i) { const int q = tid + 512 * i, r = q >> 5, cs = q & 31;
                    *(LAS v4u*)(KS + r * 528 + cs * 16) = kq[i];
                    if (lat) *(LAS v4u*)(R1 + r * 528 + cs * 16) = scale_bf16x8_16th(qq[i]); }
                { const int r = tid >> 3, cs = tid & 7;
#pragma unroll
                    for (int i = 0; i < 4; ++i) { const unsigned w = vv[i];
                        *(LAS unsigned short*)(VT + (cs * 8 + 2 * i) * 144 + r * 2) = (unsigned short)(w & 0xffffu);
                        *(LAS unsigned short*)(VT + (cs * 8 + 2 * i + 1) * 144 + r * 2) = (unsigned short)(w >> 16); } }
            }
            __syncthreads();
            const float decay = SM[SM_SCAL + 0], m_new = SM[SM_SCAL + 1];
            {
                const int v = tid >> 3, ss = tid & 7; const v4u x = *(const LAS v4u*)(VT + v * 144 + ss * 16); v4u o;
#pragma unroll
                for (int i = 0; i < 4; ++i) o[i] = pk2(bflo(x[i]) * SM[SM_W + ss * 8 + 2 * i], bfhi(x[i]) * SM[SM_W + ss * 8 + 2 * i + 1]);
                *(LAS v4u*)(VW + v * 144 + ss * 16) = o;
            }
            if (lat) {
                {
                    const int t = tid >> 3, part = tid & 7; float s = 0.f;
#pragma unroll
                    for (int i = 0; i < 4; ++i) { const v4u x = *(const LAS v4u*)(R1 + t * 528 + (part * 32 + i * 8) * 2);
#pragma unroll
                        for (int k = 0; k < 4; ++k) s += bflo(x[k]) * SM[SM_NST + part * 32 + i * 8 + 2 * k] + bfhi(x[k]) * SM[SM_NST + part * 32 + i * 8 + 2 * k + 1]; }
                    s += __shfl_xor(s, 1); s += __shfl_xor(s, 2); s += __shfl_xor(s, 4);
                    if (part == 0) SM[SM_QN + t] = s;
                }
                f32x4 accS[2][1];
                accS[0][0] = (f32x4){0.f, 0.f, 0.f, 0.f}; accS[1][0] = (f32x4){0.f, 0.f, 0.f, 0.f};
                mma_lds<2, 1>(accS, R1, 528, 32 * wr, KS, 528, 16 * wc, 256, fr, fq);
#pragma unroll
                for (int m = 0; m < 2; ++m) { const int t = 32 * wr + 16 * m + fr, s0 = 16 * wc + 4 * fq; const float rc = SM[SM_ROWC + t];
                    f32x4 p; float ps = 0.f;
#pragma unroll
                    for (int j = 0; j < 4; ++j) { const int s = s0 + j; p[j] = (s <= t) ? accS[m][0][j] * __expf(rc + SM[SM_A + s]) : 0.f; ps += p[j]; }
                    ps += __shfl_xor(ps, 16); ps += __shfl_xor(ps, 32);
                    if (fq == 0) SM[SM_DEN4 + t * 4 + wc] = ps;
                    v2u o; o.x = pk2(p[0], p[1]); o.y = pk2(p[2], p[3]); *(LAS v2u*)(SP + t * 144 + s0 * 2) = o; }
            }
            __syncthreads();
            if (lat) {
                f32x4 acc1[2][1], acc2[2][1];
                acc1[0][0] = acc1[1][0] = acc2[0][0] = acc2[1][0] = (f32x4){0.f, 0.f, 0.f, 0.f};
                mma_lds<2, 1>(acc2, R1, 528, 32 * wr, CT, 528, 16 * wc, 256, fr, fq);
                mma_lds<2, 1>(acc1, SP, 144, 32 * wr, VT, 144, 16 * wc, 64, fr, fq);
#pragma unroll
                for (int m = 0; m < 2; ++m) { const int t = 32 * wr + 16 * m + fr; const float ei = SM[SM_EINT + t];
                    const float den = (SM[SM_DEN4 + t * 4 + 0] + SM[SM_DEN4 + t * 4 + 1]) + (SM[SM_DEN4 + t * 4 + 2] + SM[SM_DEN4 + t * 4 + 3]) + ei * SM[SM_QN + t];
                    const float inv = 1.f / fmaxf(fabsf(den), SM[SM_LOW + t]);
                    const f32x4 hv = (acc1[m][0] + ei * acc2[m][0]) * inv;
                    const size_t row = (size_t)(base + (d ? 63 - t : t));
                    v2u o; o.x = pk2(hv[0], hv[1]); o.y = pk2(hv[2], hv[3]);
                    *(v2u*)(HD + ((size_t)d * ML + row) * D + h * DV + jv * 64 + 16 * wc + 4 * fq) = o; }
            }
            if (tid < 256) {
                float s = 0.f;
                for (int q = 0; q < 64; ++q) s += SM[SM_W + q] * bf2f(*(const LAS unsigned short*)(KS + q * 528 + tid * 2));
                n_reg = decay * n_reg + s;
            }
            __syncthreads();
            if (tid < 256) SM[SM_NST + tid] = n_reg;
#pragma unroll
            for (int i = 0; i < 4; ++i) { const int q = tid + 512 * i, s = q >> 5, cs = q & 31; const v4u x = *(const LAS v4u*)(KS + s * 528 + cs * 16);
#pragma unroll
                for (int k = 0; k < 4; ++k) { *(LAS unsigned short*)(R1 + (cs * 8 + 2 * k) * 144 + s * 2) = (unsigned short)(x[k] & 0xffffu); *(LAS unsigned short*)(R1 + (cs * 8 + 2 * k + 1) * 144 + s * 2) = (unsigned short)(x[k] >> 16); } }
            __syncthreads();
#pragma unroll
            for (int m = 0; m < 2; ++m)
#pragma unroll
                for (int n = 0; n < 4; ++n) accC[m][n] = accC[m][n] * decay;
            mma_lds<2, 4>(accC, VW, 144, 32 * wr, R1, 144, 64 * wc, 64, fr, fq);
#pragma unroll
            for (int m = 0; m < 2; ++m)
#pragma unroll
                for (int n = 0; n < 4; ++n) { const int v = 32 * wr + 16 * m + fr, dd = 64 * wc + 16 * n + 4 * fq; v2u o; o.x = pk2(accC[m][n][0], accC[m][n][1]); o.y = pk2(accC[m][n][2], accC[m][n][3]);
                    *(LAS v2u*)(CT + v * 528 + dd * 2) = o; }
            m_prev = m_new;
            __syncthreads();
        }
    }
}

__device__ __forceinline__ void headnorm_phase(Frame& F) {
    const int gw = F.bid * 8 + F.wave, NGW = F.G * 8;
    const bf16* HD = WSP(bf16, WS_HD); const bf16* QKVO = WSP(bf16, WS_BIG); bf16* A2 = WSP(bf16, WS_A2); const float* ng = F.in[19];
    for (int row = gw; row < ML; row += NGW) {
        float v[64]; const int c0 = F.lane * 64;
        const v4u* p0 = (const v4u*)(HD + (size_t)row * D + c0); const v4u* p1 = (const v4u*)(HD + ((size_t)ML + row) * D + c0);
        float s = 0.f;
#pragma unroll
        for (int i = 0; i < 8; ++i) { const v4u a = p0[i], bq = p1[i];
#pragma unroll
            for (int k = 0; k < 4; ++k) { v[i * 8 + 2 * k] = bflo(a[k]) + bflo(bq[k]); v[i * 8 + 2 * k + 1] = bfhi(a[k]) + bfhi(bq[k]); s += v[i * 8 + 2 * k] + v[i * 8 + 2 * k + 1]; } }
        s += __shfl_xor(s, 1); s += __shfl_xor(s, 2); s += __shfl_xor(s, 4);
        const float mean = s * (1.f / DV); float q = 0.f;
#pragma unroll
        for (int i = 0; i < 64; ++i) { v[i] -= mean; q += v[i] * v[i]; }
        q += __shfl_xor(q, 1); q += __shfl_xor(q, 2); q += __shfl_xor(q, 4);
        const float rstd = 1.f / sqrtf(q * (1.f / DV) + LN_EPS);
        const v4u* po = (const v4u*)(QKVO + (size_t)row * DIN1 + 8192 + c0); v4u* pd = (v4u*)(A2 + (size_t)row * D + c0);
#pragma unroll
        for (int i = 0; i < 8; ++i) { const v4u o = po[i]; v4u w;
#pragma unroll
            for (int k = 0; k < 4; ++k) { const int c = i * 8 + 2 * k; const f32x2 g = *(const f32x2*)(ng + c0 + c);
                w[k] = pk2(sigmoidf_(bflo(o[k])) * v[c] * rstd * g.x, sigmoidf_(bfhi(o[k])) * v[c + 1] * rstd * g.y); }
            pd[i] = w; }
    }
}
#define XB_TMO      128
#define XB_XCNT(j)  (256  + 64 * (j))
#define XB_XSUB(j)  (1280 + 64 * (j))
#define XB_XGEN(j)  (2304 + 64 * (j))
#define XB_TOP      3328
#define XB_TOPGEN   3392
#define XCD_BAR_WORDS 3456
#define XB_SPIN_CAP (1u << 22)

__device__ __forceinline__ unsigned xb_ld(unsigned* p)              { return __hip_atomic_load(p, __ATOMIC_RELAXED, __HIP_MEMORY_SCOPE_AGENT); }
__device__ __forceinline__ unsigned xb_add(unsigned* p, unsigned v) { return __hip_atomic_fetch_add(p, v, __ATOMIC_RELAXED, __HIP_MEMORY_SCOPE_AGENT); }
__device__ __forceinline__ unsigned xb_xcc_id() { return (unsigned)__builtin_amdgcn_s_getreg((3 << 11) | 20) & 0xFu; }
#define XB_SPIN(cond, bar) do { unsigned _sp = 0; while (cond) { __builtin_amdgcn_s_sleep(1); \
    if ((++_sp & 255u) == 0u) { if (xb_ld(&(bar)[XB_TMO])) break; if (_sp > XB_SPIN_CAP) { atomicAdd(&(bar)[XB_TMO], 1u); break; } } } } while (0)

struct XcdBarrier { unsigned* bar; unsigned x; volatile LAS unsigned* st; };

__device__ __forceinline__ XcdBarrier xcd_barrier_post(unsigned* bar, volatile LAS unsigned* st) {
    XcdBarrier b; b.bar = bar; b.x = xb_xcc_id(); b.st = st;
    if (threadIdx.x == 0) (void)xb_add(&bar[XB_XCNT(b.x)], 1u);
    return b;
}
__device__ __forceinline__ void xcd_barrier_complete(unsigned* bar, unsigned x, unsigned& nloc, unsigned& nx) {
    const unsigned G = gridDim.x * gridDim.y * gridDim.z;
    unsigned sum, cnt, mine, sp = 0u;
    for (;;) {
        sum = 0u; cnt = 0u; mine = 0u;
#pragma unroll
        for (unsigned j = 0; j < 16; ++j) { const unsigned c = xb_ld(&bar[XB_XCNT(j)]); sum += c; cnt += (c > 0u) ? 1u : 0u; mine = (j == x) ? c : mine; }
        if (sum == G) break;
        __builtin_amdgcn_s_sleep(1);
        if ((++sp & 255u) == 0u) { if (xb_ld(&bar[XB_TMO])) break; if (sp > XB_SPIN_CAP) { atomicAdd(&bar[XB_TMO], 1u); break; } }
    }
    nloc = mine > 0u ? mine : 1u; nx = cnt > 0u ? cnt : 1u;
}
__device__ __forceinline__ void xcd_barrier(const XcdBarrier& b) {
    asm volatile("s_waitcnt vmcnt(0)" ::: "memory");
    __syncthreads();
    if (threadIdx.x == 0) {
        unsigned* bar = b.bar;
        __builtin_amdgcn_s_waitcnt(0);
        unsigned nloc = b.st[0], nx = b.st[1];
        if (nloc == 0u) { xcd_barrier_complete(bar, b.x, nloc, nx); b.st[0] = nloc; b.st[1] = nx; }
        const unsigned old = xb_add(&bar[XB_XSUB(b.x)], 1u);
        const unsigned gen = old / nloc;
        if (old + 1u == (gen + 1u) * nloc) {
            __builtin_amdgcn_fence(__ATOMIC_RELEASE, "agent");
            asm volatile("s_waitcnt vmcnt(0)" ::: "memory");
            const unsigned og = xb_add(&bar[XB_TOP], 1u);
            const unsigned tg = og / nx;
            if (og + 1u == (tg + 1u) * nx) xb_add(&bar[XB_TOPGEN], 1u);
            else XB_SPIN(xb_ld(&bar[XB_TOPGEN]) == tg, bar);
            __builtin_amdgcn_fence(__ATOMIC_ACQUIRE, "agent");
            xb_add(&bar[XB_XGEN(b.x)], 1u);
            asm volatile("s_waitcnt vmcnt(0)" ::: "memory");
        } else {
            XB_SPIN(xb_ld(&bar[XB_XGEN(b.x)]) == gen, bar);
            __builtin_amdgcn_fence(__ATOMIC_ACQUIRE, "agent");
            asm volatile("s_waitcnt vmcnt(0)" ::: "memory");
        }
    }
    __syncthreads();
}

constexpr int N_PHASES = 23;
struct Args { const float* in[24]; float* out; unsigned char* ws; int ph_lo, ph_hi; };
__global__ void __launch_bounds__(NTHR, 2) fwd_kernel(Args args) {
    extern __shared__ __attribute__((aligned(16))) unsigned char lds_raw[];
    Frame F;
    F.lds = (LAS unsigned char*)lds_raw;
    F.tid = threadIdx.x; F.lane = F.tid & 63; F.wave = __builtin_amdgcn_readfirstlane(F.tid >> 6);
    F.bid = blockIdx.x; F.G = gridDim.x; F.ws = args.ws; F.out = args.out;
#pragma unroll
    for (int i = 0; i < 24; ++i) F.in[i] = args.in[i];
    volatile LAS unsigned* MISC = (volatile LAS unsigned*)(F.lds + MISC_OFF);
    if (F.tid < 64) MISC[F.tid] = 0u;
    __syncthreads();
    const int lo = args.ph_lo, hi = args.ph_hi;
    const bool multi = (hi - lo) > 1;
    unsigned* barw = (unsigned*)(F.ws + WS_CTL) + CW_BAR;
    XcdBarrier bar; bar.bar = barw; bar.x = 0; bar.st = MISC + 8;
    if (multi) bar = xcd_barrier_post(barw, MISC + 8);
#define IN(k) (lo <= (k) && (k) < hi)
#define SEAM(k) do { if (IN(k) && IN((k) + 1)) xcd_barrier(bar); } while (0)
    LAS unsigned char* ring = F.lds;

    if (IN(0)) { p0_convert(F); __syncthreads(); p0_adaln(F); } SEAM(0);
    if (IN(1)) { p1_ln0(F); } SEAM(1);
    if (IN(2)) { pg8::Gemm g{WSP(bf16, WS_U), WSP(bf16, WS_W1T), D, D, D, 0, 0}; pg8::TileOrder S; S.init(1, MT / 256, DIN0 / 256, F.G, F.bid);
        EpiBf16Plain E{WSP(bf16, WS_BIG), DIN0}; pg8::gemm_phase(ring, g, S, E); } SEAM(2);
    if (IN(3)) { lru_phase<false>(F); pool_pass1(F); pool_ctx(F); } SEAM(3);
    if (IN(4)) { lru_carry(F); pool_pass2(F); } SEAM(4);
    if (IN(5)) { lru_phase<true>(F);
        pg8::Gemm g{WSP(bf16, WS_DP), WSP(bf16, WS_PWT), DPOOL, 512, 512, 512 * 2, 512 * 512 * 2}; pg8::TileOrder S; S.init(4, MT / 256, 2, F.G, F.bid);
        EpiPool E{WSP(bf16, WS_A2), F.in[15]}; pg8::gemm_phase(ring, g, S, E); } SEAM(5);
    if (IN(6)) { pg8::Gemm g{WSP(bf16, WS_A2), WSP(bf16, WS_W2T), D, D, D, 0, 0}; pg8::TileOrder S; S.init(1, MT / 256, D / 256, F.G, F.bid);
        EpiResid E{WSP(float, WS_H), WSP(float, WS_MOD), 2 * D}; pg8::gemm_phase(ring, g, S, E); } SEAM(6);
    if (IN(7)) { ln_router_phase(F, 0, MT); } SEAM(7);
    if (IN(8)) { topk_phase(F, 4); } SEAM(8);
    if (IN(9)) { gather_phase(F, ER0); } SEAM(9);
    if (IN(10)) { pg8::Gemm g{WSP(bf16, WS_XE), WSP(bf16, WS_WGU), D, D, D, (size_t)ER0 * D * 2, (size_t)2048 * D * 2}; pg8::TileOrder S; S.init(16, ER0 / 256, 8, F.G, F.bid);
        EpiGU E{WSP(bf16, WS_ACT), ER0}; pg8::gemm_phase(ring, g, S, E); } SEAM(10);
    if (IN(11)) { pg8::Gemm g{WSP(bf16, WS_ACT), WSP(bf16, WS_WDN), DE, DE, DE, (size_t)ER0 * DE * 2, (size_t)D * DE * 2}; pg8::TileOrder S; S.init(16, ER0 / 256, 16, F.G, F.bid);
        EpiDown E{WSP(bf16, WS_YE), WSP(float, WS_GX), ER0}; pg8::gemm_phase(ring, g, S, E); } SEAM(11);
    if (IN(12)) { combine_phase<false>(F, 0, MT, ER0); } SEAM(12);
    if (IN(13)) { pg8::Gemm g{WSP(bf16, WS_U), WSP(bf16, WS_W3T), D, D, D, 0, 0}; pg8::TileOrder S; S.init(1, MT / 256, DIN1P / 256, F.G, F.bid);
        EpiOddIn E{WSP(bf16, WS_BIG), WSP(float, WS_G), F.in[18]}; pg8::gemm_phase(ring, g, S, E); } SEAM(13);
    if (IN(14)) { mlstm_phase(F); } SEAM(14);
    if (IN(15)) { headnorm_phase(F); } SEAM(15);
    if (IN(16)) { pg8::Gemm g{WSP(bf16, WS_A2), WSP(bf16, WS_W4T), D, D, D, 0, 0}; pg8::TileOrder S; S.init(1, ML / 256, D / 256, F.G, F.bid);
        EpiResid E{WSP(float, WS_H), WSP(float, WS_MOD) + 3 * 24576, 2 * D}; pg8::gemm_phase(ring, g, S, E); } SEAM(16);
    if (IN(17)) { ln_router_phase(F, 1, ML); } SEAM(17);
    if (IN(18)) { topk_phase(F, 2); } SEAM(18);
    if (IN(19)) { gather_phase(F, ER1); } SEAM(19);
    if (IN(20)) { pg8::Gemm g{WSP(bf16, WS_XE), WSP(bf16, WS_WGU) + (size_t)16 * 2048 * D, D, D, D, (size_t)ER1 * D * 2, (size_t)2048 * D * 2}; pg8::TileOrder S; S.init(16, ER1 / 256, 8, F.G, F.bid);
        EpiGU E{WSP(bf16, WS_ACT), ER1}; pg8::gemm_phase(ring, g, S, E); } SEAM(20);
    if (IN(21)) { pg8::Gemm g{WSP(bf16, WS_ACT), WSP(bf16, WS_WDN) + (size_t)16 * D * DE, DE, DE, DE, (size_t)ER1 * DE * 2, (size_t)D * DE * 2}; pg8::TileOrder S; S.init(16, ER1 / 256, 16, F.G, F.bid);
        EpiDown E{WSP(bf16, WS_YE), WSP(float, WS_GX), ER1}; pg8::gemm_phase(ring, g, S, E); } SEAM(21);
    if (IN(22)) { combine_phase<true>(F, 1, ML, ER1); }
#undef IN
#undef SEAM
}

#ifndef MK_ONE_LAUNCH
#define MK_ONE_LAUNCH 0
#endif
extern "C" void kernel_launch(void* const* d_in, const int* in_sizes, int n_in, void* d_out, int out_size, void* d_ws, size_t ws_size, hipStream_t stream) {
    static int grid = 0;
    if (grid == 0) {
        if (n_in != 24 || out_size != ML * D || ws_size < WS_END) { fprintf(stderr, "kernel_launch: unexpected shapes (n_in %d, out %d, ws %zu); nothing launched\n", n_in, out_size, ws_size); grid = -1; return; }
        int dev = 0, cus = 0, per_cu = 0;
        if (hipGetDevice(&dev) != hipSuccess || hipDeviceGetAttribute(&cus, hipDeviceAttributeMultiprocessorCount, dev) != hipSuccess) { grid = -1; return; }
        if (hipFuncSetAttribute((const void*)fwd_kernel, hipFuncAttributeMaxDynamicSharedMemorySize, LDS_BYTES) != hipSuccess) { fprintf(stderr, "kernel_launch: hipFuncSetAttribute failed\n"); grid = -1; return; }
        if (hipOccupancyMaxActiveBlocksPerMultiprocessor(&per_cu, (const void*)fwd_kernel, NTHR, LDS_BYTES) != hipSuccess || per_cu < 1) { fprintf(stderr, "kernel_launch: occupancy query says %d\n", per_cu); }
        (void)hipGetLastError();
        grid = cus;
    }
    if (grid < 0) return;
    if (hipMemsetAsync((char*)d_ws + WS_CTL, 0, CTL_ZERO_BYTES, stream) != hipSuccess) return;
    Args a{};
    for (int i = 0; i < 24; ++i) a.in[i] = (const float*)d_in[i];
    a.out = (float*)d_out; a.ws = (unsigned char*)d_ws;
#if MK_ONE_LAUNCH
    a.ph_lo = 0; a.ph_hi = N_PHASES;
    hipLaunchKernelGGL(fwd_kernel, dim3(grid), dim3(NTHR), LDS_BYTES, stream, a);
#else
    for (int p = 0; p < N_PHASES; ++p) { a.ph_lo = p; a.ph_hi = p + 1; hipLaunchKernelGGL(fwd_kernel, dim3(grid), dim3(NTHR), LDS_BYTES, stream, a); }
#endif
}
```

```cpp
#ifndef MK_ONE_LAUNCH
#define MK_ONE_LAUNCH 1
#endif
#include <hip/hip_runtime.h>
#include <cstdio>
#include <cstdint>
namespace pg8 {
#define PG8_LAS __attribute__((address_space(3)))
typedef unsigned short bf16_t;
typedef short bf16x8 __attribute__((ext_vector_type(8)));
typedef float f32x4 __attribute__((ext_vector_type(4)));
typedef float f32x2 __attribute__((ext_vector_type(2)));
typedef unsigned u32x4 __attribute__((ext_vector_type(4)));
typedef unsigned u32x2 __attribute__((ext_vector_type(2)));
constexpr int BM = 256, BK = 64, HALF = 128, HTB = HALF * BK * 2  , STAGE_BYTES = 8 * HTB, NXCD = 8, WGM = 8;

__host__ __device__ __forceinline__ int lds_byte(int r, int c) { const int st = (r >> 4) * 2 + (c >> 5), rr = r & 15, cc = c & 31, ob = rr * 64 + cc * 2; return st * 1024 + (ob ^ (((ob >> 9) & 1) << 5)); }
__host__ __device__ __forceinline__ void stage_rc(int b, int& R, int& C) { const int st = b / 1024, sb = b % 1024, swz = sb ^ (((sb >> 9) & 1) << 5); R = (st >> 1) * 16 + swz / 64; C = (st & 1) * 32 + (swz % 64) / 2; }
__host__ __device__ __forceinline__ int perm32(int rho) { const int n = rho >> 4, i = rho & 15; return 8 * (i >> 2) + 4 * n + (i & 3); }

struct Unit { int pm, pn, g; };
struct Gemm { const bf16_t* A; const bf16_t* Bt; int lda, ldb, K; size_t gA, gB; };

struct TileOrder {
    int nG, nM, nN, per, nwg, G, c;
    __device__ __forceinline__ void init(int nG_, int nM_, int nN_, int G_, int c_) { nG = nG_; nM = nM_; nN = nN_; per = nM * nN; nwg = nG * per; G = G_; c = c_; }
    __device__ __forceinline__ bool next(int i, Unit& u) const {
        const long L = (long)i * G + c; if (L >= nwg) return false;
        int wgid = (int)L; { const int q = nwg / NXCD, r = nwg % NXCD, xcd = wgid % NXCD, off = wgid / NXCD; wgid = (xcd < r ? xcd * (q + 1) : r * (q + 1) + (xcd - r) * q) + off; }
        u.g = wgid / per; wgid -= u.g * per;
        const int nig = WGM * nN, gid = wgid / nig, fm = gid * WGM, gsz = (nM - fm) < WGM ? (nM - fm) : WGM;
        u.pm = fm + ((wgid % nig) % gsz); u.pn = (wgid % nig) / gsz; return true;
    }
};

__device__ __forceinline__ unsigned cvt_pk_bf16(float lo, float hi) { unsigned r; asm volatile("v_cvt_pk_bf16_f32 %0, %1, %2" : "=v"(r) : "v"(lo), "v"(hi)); return r; }

template <class Epi, class Sched>
__device__ __forceinline__ void gemm_phase(PG8_LAS unsigned char* lds, const Gemm g, const Sched& S, const Epi& E) {
    const int tid = threadIdx.x, wid = __builtin_amdgcn_readfirstlane(tid >> 6), lane = tid & 63, wr = wid >> 2, wc = wid & 3, fr = lane & 15, fq = lane >> 4;
    const int K = g.K, nt = K / BK;
    unsigned voffA[2], voffB[2];
#pragma unroll
    for (int i = 0; i < 2; ++i) { int R, C; stage_rc(tid * 16 + i * 8192, R, C); const int Rb = Epi::PERM ? ((R & ~31) + perm32(R & 31)) : R;
        voffA[i] = (unsigned)(R * g.lda + C) * 2u; voffB[i] = (unsigned)(Rb * g.ldb + C) * 2u; }
    const size_t kstep = (size_t)(BK * 2);
    const size_t hstepA = (size_t)HALF * g.lda * 2, hstepB = (size_t)HALF * g.ldb * 2;
    const size_t tstepA = 2 * hstepA, tstepB = 2 * hstepB;
    const unsigned ldsw = (unsigned)wid * 1024u;
    const int aoff = lds_byte(wr * 64 + fr, fq * 8), boff = lds_byte(wc * 32 + fr, fq * 8);
#define PG8_SA(b, h) (((b) * 2 + (h)) * HTB)
#define PG8_SB(b, h) ((4 + (b) * 2 + (h)) * HTB)
#define PG8_STAGE(bufoff, gbase, voff) do { _Pragma("unroll") for (int _i = 0; _i < 2; ++_i) \
        __builtin_amdgcn_global_load_lds((const unsigned*)((const char*)(gbase) + (voff)[_i]), (PG8_LAS unsigned*)(lds + (bufoff) + ldsw + _i * 8192), 16, 0, 0); } while (0)
#define PG8_LDA(dst, b, h) do { _Pragma("unroll") for (int m = 0; m < 4; ++m) _Pragma("unroll") for (int k = 0; k < 2; ++k) dst[m][k] = *(const PG8_LAS bf16x8*)(lds + PG8_SA(b, h) + aoff + m * 2048 + k * 1024); } while (0)
#define PG8_LDB(dst, b, h) do { _Pragma("unroll") for (int n = 0; n < 2; ++n) _Pragma("unroll") for (int k = 0; k < 2; ++k) dst[n][k] = *(const PG8_LAS bf16x8*)(lds + PG8_SB(b, h) + boff + n * 2048 + k * 1024); } while (0)
#define PG8_MMA(ai, bj, At, Bt) do { __builtin_amdgcn_s_setprio(1); _Pragma("unroll") for (int m = 0; m < 4; ++m) _Pragma("unroll") for (int n = 0; n < 2; ++n) _Pragma("unroll") for (int k = 0; k < 2; ++k) \
        acc[ai][bj][m][n] = __builtin_amdgcn_mfma_f32_16x16x32_bf16(Bt[n][k], At[m][k], acc[ai][bj][m][n], 0, 0, 0); __builtin_amdgcn_s_setprio(0); } while (0)
#define PG8_WAIT_V(n) asm volatile("s_waitcnt vmcnt(" #n ")" ::: "memory")
#define PG8_WAIT_L(n) asm volatile("s_waitcnt lgkmcnt(" #n ")" ::: "memory")
#define PG8_BAR __builtin_amdgcn_s_barrier()
#define PG8_SCHED __builtin_amdgcn_sched_barrier(0)
    Unit cur, nxt; int ui = 0;
    if (!S.next(0, cur)) return;
    f32x4 acc[2][2][4][2];
#pragma unroll
    for (int a = 0; a < 2; ++a)
#pragma unroll
        for (int b = 0; b < 2; ++b)
#pragma unroll
            for (int m = 0; m < 4; ++m)
#pragma unroll
                for (int n = 0; n < 2; ++n) acc[a][b][m][n] = (f32x4){0.f, 0.f, 0.f, 0.f};
    bf16x8 At[4][2], B0[2][2], B1[2][2];
    const char* cA = (const char*)g.A + (size_t)cur.g * g.gA + (size_t)cur.pm * tstepA; const char* cB = (const char*)g.Bt + (size_t)cur.g * g.gB + (size_t)cur.pn * tstepB;
    PG8_STAGE(PG8_SB(0, 0), cB, voffB); PG8_STAGE(PG8_SB(0, 1), cB + hstepB, voffB); PG8_STAGE(PG8_SA(0, 0), cA, voffA); PG8_STAGE(PG8_SA(0, 1), cA + hstepA, voffA);
    if (wr == 1) PG8_BAR;
    PG8_WAIT_V(2); PG8_BAR;
    PG8_STAGE(PG8_SB(1, 0), cB + kstep, voffB); PG8_STAGE(PG8_SA(1, 0), cA + kstep, voffA); PG8_STAGE(PG8_SB(1, 1), cB + hstepB + kstep, voffB);
    PG8_WAIT_V(6); PG8_BAR;
    for (;;) {
        const bool has_next = S.next(ui + 1, nxt);
        const char* nA = has_next ? (const char*)g.A + (size_t)nxt.g * g.gA + (size_t)nxt.pm * tstepA : cA; const char* nB = has_next ? (const char*)g.Bt + (size_t)nxt.g * g.gB + (size_t)nxt.pn * tstepB : cB;
        for (int t = 0; t < nt; t += 2) {
            const bool last = (t == nt - 2);
            const char* a1 = cA + (size_t)(t + 1) * kstep;
            const char* a2 = last ? nA : cA + (size_t)(t + 2) * kstep; const char* b2 = last ? nB : cB + (size_t)(t + 2) * kstep;
            const char* a3 = a2 + kstep; const char* b3 = b2 + kstep;
            PG8_LDB(B0, 0, 0); PG8_LDB(B1, 0, 1); PG8_SCHED; PG8_LDA(At, 0, 0); PG8_STAGE(PG8_SA(1, 1), a1 + hstepA, voffA);
            PG8_WAIT_V(8); PG8_WAIT_L(0); PG8_BAR; PG8_MMA(0, 0, At, B0); PG8_MMA(0, 1, At, B1); PG8_BAR; PG8_SCHED;
            PG8_LDA(At, 0, 1); PG8_STAGE(PG8_SB(0, 0), b2, voffB); PG8_STAGE(PG8_SB(0, 1), b2 + hstepB, voffB); PG8_STAGE(PG8_SA(0, 0), a2, voffA);
            PG8_WAIT_V(8); PG8_WAIT_L(0); PG8_BAR; PG8_MMA(1, 0, At, B0); PG8_MMA(1, 1, At, B1); PG8_BAR; PG8_SCHED;
            PG8_LDB(B0, 1, 0); PG8_LDB(B1, 1, 1); PG8_SCHED; PG8_LDA(At, 1, 0); PG8_STAGE(PG8_SA(0, 1), a2 + hstepA, voffA);
            PG8_WAIT_V(8); PG8_WAIT_L(0); PG8_BAR; PG8_MMA(0, 0, At, B0); PG8_MMA(0, 1, At, B1); PG8_BAR; PG8_SCHED;
            PG8_LDA(At, 1, 1); PG8_STAGE(PG8_SB(1, 0), b3, voffB); PG8_STAGE(PG8_SB(1, 1), b3 + hstepB, voffB); PG8_STAGE(PG8_SA(1, 0), a3, voffA);
            PG8_WAIT_V(8); PG8_WAIT_L(0); PG8_BAR; PG8_MMA(1, 0, At, B0); PG8_MMA(1, 1, At, B1); PG8_BAR; PG8_SCHED;
        }
        if (wr == 0) PG8_BAR;
        E(acc, cur, wr, wc, fr, fq);
        if (!has_next) break;
#pragma unroll
        for (int a = 0; a < 2; ++a)
#pragma unroll
            for (int b = 0; b < 2; ++b)
#pragma unroll
                for (int m = 0; m < 4; ++m)
#pragma unroll
                    for (int n = 0; n < 2; ++n) acc[a][b][m][n] = (f32x4){0.f, 0.f, 0.f, 0.f};
        cur = nxt; cA = nA; cB = nB; ++ui;
        if (wr == 1) PG8_BAR;
    }
    PG8_WAIT_V(0);
    PG8_BAR;
#undef PG8_SA
#undef PG8_SB
#undef PG8_STAGE
#undef PG8_LDA
#undef PG8_LDB
#undef PG8_MMA
#undef PG8_WAIT_V
#undef PG8_WAIT_L
#undef PG8_BAR
#undef PG8_SCHED
}
}
#define GAS __attribute__((address_space(1)))
#define LAS __attribute__((address_space(3)))
typedef unsigned short bf16;
typedef unsigned v4u __attribute__((ext_vector_type(4)));
typedef unsigned v2u __attribute__((ext_vector_type(2)));
typedef float f32x4 __attribute__((ext_vector_type(4)));
typedef float f32x2 __attribute__((ext_vector_type(2)));
typedef short bf16x8 __attribute__((ext_vector_type(8)));

constexpr int D = 4096, NB = 2, SEQ = 4096, CTXL = 256;
constexpr int ML = NB * SEQ, MC = NB * CTXL, MT = ML + MC;
constexpr int DLRU = 2048, LRUH = 16, LRUB = 128, DPOOL = 2048, DIN0 = 6144;
constexpr int MH = 8, DQK = 256, DV = 512, DIN1 = 12288, DIN1P = 12544, CHUNK = 64;
constexpr int NE = 16, DE = 1024;
constexpr int ER0 = 1280, ER1 = 1024;
constexpr float LN_EPS = 1e-5f, DN_ALPHA = 1.41421356237f;
constexpr int NT_TILES = 136;

constexpr size_t WS_CTL = 0ull, CTL_ZERO_BYTES = 1048576ull;
constexpr size_t WS_MOD = 1048576ull;
constexpr size_t WS_WRT = 1638400ull;
constexpr size_t WS_LS8 = 2162688ull;
constexpr size_t WS_W1T = 2179072ull;
constexpr size_t WS_W2T = 52510720ull;
constexpr size_t WS_W3T = 86065152ull;
constexpr size_t WS_W4T = 188825600ull;
constexpr size_t WS_WGU = 222380032ull;
constexpr size_t WS_WDN = 759250944ull;
constexpr size_t WS_GWT = 1027686400ull;
constexpr size_t WS_PWT = 1029783552ull;
constexpr size_t WS_H = 1031880704ull;
constexpr size_t WS_U = 1174487040ull;
constexpr size_t WS_BIG = 1245790208ull;
constexpr size_t WS_A2 = 1459699712ull;
constexpr size_t WS_CM = 1531002880ull;
constexpr size_t WS_DP = 1598111744ull;
constexpr size_t WS_SUMM = 1633763328ull;
constexpr size_t WS_CARRY = 1638219776ull;
constexpr size_t WS_AFF = 1640448000ull;
constexpr size_t WS_IDX = 1641496576ull;
constexpr size_t WS_GSEL = 1641627648ull;
constexpr size_t WS_INV = 1641758720ull;
constexpr size_t WS_GX = 1642315776ull;
constexpr size_t WS_XE = 1642397696ull;
constexpr size_t WS_ACT = 1810169856ull;
constexpr size_t WS_YE = 1852112896ull;
constexpr size_t WS_G = 2019885056ull;
constexpr size_t WS_HD = 2020999168ull;
constexpr size_t WS_END = 2155216896ull;

constexpr int CW_BAR = 4096;
constexpr int LDS_BYTES = 147456;
constexpr int MISC_OFF = 144 * 1024 - 256;
constexpr int NTHR = 512;

__device__ __forceinline__ unsigned f2bf(float f) { unsigned u = __builtin_bit_cast(unsigned, f); return (u + 0x7fffu + ((u >> 16) & 1u)) >> 16; }
__device__ __forceinline__ unsigned pk2(float lo, float hi) { return f2bf(lo) | (f2bf(hi) << 16); }
__device__ __forceinline__ float bf2f(unsigned b) { return __builtin_bit_cast(float, b << 16); }
__device__ __forceinline__ float bflo(unsigned w) { return __builtin_bit_cast(float, w << 16); }
__device__ __forceinline__ float bfhi(unsigned w) { return __builtin_bit_cast(float, w & 0xffff0000u); }
__device__ __forceinline__ float wave_sum(float v) {
#pragma unroll
    for (int o = 1; o < 64; o <<= 1) v += __shfl_xor(v, o);
    return v;
}
__device__ __forceinline__ float wave_max(float v) {
#pragma unroll
    for (int o = 1; o < 64; o <<= 1) v = fmaxf(v, __shfl_xor(v, o));
    return v;
}
__device__ __forceinline__ float sigmoidf_(float x) { return 1.f / (1.f + __expf(-x)); }
__device__ __forceinline__ float siluf_(float x) { return x / (1.f + __expf(-x)); }
__device__ __forceinline__ float logsigmoidf_(float x) { return fminf(x, 0.f) - log1pf(__expf(-fabsf(x))); }
__device__ __forceinline__ float gelu_tanh(float x) { const float u = 0.7978845608028654f * (x + 0.044715f * x * x * x); const float t = 1.f - 2.f / (__expf(2.f * u) + 1.f); return 0.5f * x * (1.f + t); }

__device__ __forceinline__ int seq_row0(int s) { return s < 2 ? s * SEQ : ML + (s - 2) * CTXL; }
__device__ __forceinline__ int seq_len(int s) { return s < 2 ? SEQ : CTXL; }
__device__ __forceinline__ int row_mod(int row) { return row < SEQ ? 0 : (row < ML ? 1 : 2); }
__device__ __forceinline__ int tile_row0(int tt) { return tt < 128 ? tt * 64 : ML + (tt - 128) * 64; }
__device__ __forceinline__ void tile_seq(int tt, int& lo, int& hi) { if (tt < 128) { lo = (tt >> 6) * SEQ; hi = lo + SEQ; } else { lo = ML + ((tt - 128) >> 2) * CTXL; hi = lo + CTXL; } }
struct Frame {
    LAS unsigned char* lds;
    int tid, lane, wave;
    int bid, G;
    unsigned char* ws;
    const float* in[24];
    float* out;
};
#define WSP(T, off) ((T*)(F.ws + (off)))

__device__ __forceinline__ void transpose_item(const float* W, int N, bf16* WT, int ldk, int k0, int n0, int drow0, LAS float* scr, int lane) {
    const bool ok = n0 + lane < N; const float* src = W + (size_t)k0 * N + (ok ? n0 + lane : N - 1);
#pragma unroll 16
    for (int kk = 0; kk < 64; ++kk) { const float v = src[(size_t)kk * N]; scr[kk * 65 + lane] = ok ? v : 0.f; }
    asm volatile("s_waitcnt lgkmcnt(0)" ::: "memory");
    const int c = lane & 7;
#pragma unroll
    for (int j = 0; j < 8; ++j) { const int n = (lane >> 3) + 8 * j; const LAS float* s = scr + (8 * c) * 65 + n;
        v4u o; o.x = pk2(s[0 * 65], s[1 * 65]); o.y = pk2(s[2 * 65], s[3 * 65]); o.z = pk2(s[4 * 65], s[5 * 65]); o.w = pk2(s[6 * 65], s[7 * 65]);
        *(v4u*)(WT + (size_t)(drow0 + n) * ldk + k0 + 8 * c) = o; }
    asm volatile("s_waitcnt lgkmcnt(0)" ::: "memory");
}

__device__ __forceinline__ void p0_convert(Frame& F) {
    LAS float* scr = (LAS float*)(F.lds + F.wave * 16640);
    const int gw = F.bid * 8 + F.wave, NGW = F.G * 8;
    constexpr int I0 = 64 * 96, I1 = 64 * 64, I2 = 64 * 193, I3 = 64 * 64, I4 = 32 * 2048, I5 = 32 * 1024, I6 = 64 * 4, I7 = 4 * 64;
    constexpr int NITEMS = I0 + I1 + I2 + I3 + I4 + I5 + I6 + I7;
    for (int it = gw; it < NITEMS; it += NGW) {
        int r = it;
        if (r < I0) { const int kb = r / 96, nb = r % 96; transpose_item(F.in[8], DIN0, WSP(bf16, WS_W1T), D, kb * 64, nb * 64, nb * 64, scr, F.lane); continue; } r -= I0;
        if (r < I1) { const int kb = r / 64, nb = r % 64; transpose_item(F.in[16], D, WSP(bf16, WS_W2T), D, kb * 64, nb * 64, nb * 64, scr, F.lane); continue; } r -= I1;
        if (r < I2) { const int kb = r / 193, nb = r % 193; transpose_item(F.in[17], 12320, WSP(bf16, WS_W3T), D, kb * 64, nb * 64, nb * 64, scr, F.lane); continue; } r -= I2;
        if (r < I3) { const int kb = r / 64, nb = r % 64; transpose_item(F.in[20], D, WSP(bf16, WS_W4T), D, kb * 64, nb * 64, nb * 64, scr, F.lane); continue; } r -= I3;
        if (r < I4) { const int mat = r / 2048, q = r % 2048, kb = q / 32, nb = q % 32, n0 = nb * 64;
            const int drow0 = 256 * ((n0 & 1023) >> 7) + 128 * (n0 >> 10) + (n0 & 127);
            transpose_item(F.in[22] + (size_t)mat * D * 2048, 2048, WSP(bf16, WS_WGU) + (size_t)mat * 2048 * D, D, kb * 64, n0, drow0, scr, F.lane); continue; } r -= I4;
        if (r < I5) { const int mat = r / 1024, q = r % 1024, kb = q / 64, nb = q % 64;
            transpose_item(F.in[23] + (size_t)mat * DE * D, D, WSP(bf16, WS_WDN) + (size_t)mat * D * DE, DE, kb * 64, nb * 64, nb * 64, scr, F.lane); continue; } r -= I5;
        if (r < I6) { const int mat = r / 4, q = r % 4, kb = q / 2, nb = q % 2;
            transpose_item(F.in[11] + (size_t)mat * 16384, 128, WSP(bf16, WS_GWT) + (size_t)mat * 16384, 128, kb * 64, nb * 64, nb * 64, scr, F.lane); continue; } r -= I6;
        { const int mat = r / 64, q = r % 64, kb = q / 8, nb = q % 8;
            transpose_item(F.in[14] + (size_t)mat * 262144, 512, WSP(bf16, WS_PWT) + (size_t)mat * 262144, 512, kb * 64, nb * 64, nb * 64, scr, F.lane); }
    }
    const int gt = F.bid * NTHR + F.tid, NGT = F.G * NTHR;
    float* wrt = WSP(float, WS_WRT);
    for (int i = gt; i < 2 * 16 * 4096; i += NGT) { const int l = i >> 16, e = (i >> 12) & 15, k = i & 4095; wrt[i] = F.in[21][(size_t)l * 65536 + k * 16 + e]; }
    float* ls8 = WSP(float, WS_LS8);
    for (int i = gt; i < 2 * DLRU; i += NGT) ls8[i] = 8.0f * logsigmoidf_(F.in[13][i]);
}

__device__ __forceinline__ void p0_adaln(Frame& F) {
    LAS float* sc = (LAS float*)F.lds;
    LAS float* red = (LAS float*)(F.lds + 49152);
    constexpr int NIT = 2 * 384;
    if (F.bid >= NIT) return;
    for (int i = F.tid; i < 3 * D; i += NTHR) { const int r = i >> 12, k = i & 4095; const float v = r < 2 ? F.in[1][r * D + k] : F.in[3][k]; sc[i] = siluf_(v); }
    __syncthreads();
    float* mod = WSP(float, WS_MOD);
    for (int it = F.bid; it < NIT; it += F.G) {
        const int l = it / 384, n0 = (it % 384) * 64;
        const float* W = F.in[4] + (size_t)l * D * 24576 + n0 + F.lane;
        float a0 = 0.f, a1 = 0.f, a2 = 0.f;
        const int kbeg = F.wave * 512;
#pragma unroll 32
        for (int k = kbeg; k < kbeg + 512; ++k) { const float w = W[(size_t)k * 24576]; a0 += sc[k] * w; a1 += sc[D + k] * w; a2 += sc[2 * D + k] * w; }
        red[(F.wave * 3 + 0) * 64 + F.lane] = a0; red[(F.wave * 3 + 1) * 64 + F.lane] = a1; red[(F.wave * 3 + 2) * 64 + F.lane] = a2;
        __syncthreads();
        if (F.tid < 192) { const int r = F.tid >> 6, ln = F.tid & 63; float s = 0.f;
#pragma unroll
            for (int w = 0; w < 8; ++w) s += red[(w * 3 + r) * 64 + ln];
            mod[((size_t)l * 3 + r) * 24576 + n0 + ln] = s + F.in[5][l * 24576 + n0 + ln]; }
        __syncthreads();
    }
}

struct RowV { f32x4 v[16]; };
__device__ __forceinline__ void row_stats(const RowV& r, float& mean, float& rstd) {
    float s = 0.f;
#pragma unroll
    for (int j = 0; j < 16; ++j) s += (r.v[j].x + r.v[j].y) + (r.v[j].z + r.v[j].w);
    mean = wave_sum(s) * (1.f / D);
    float q = 0.f;
#pragma unroll
    for (int j = 0; j < 16; ++j) { const f32x4 d = r.v[j] - mean; q += (d.x * d.x + d.y * d.y) + (d.z * d.z + d.w * d.w); }
    rstd = 1.f / sqrtf(wave_sum(q) * (1.f / D) + LN_EPS);
}

__device__ __forceinline__ void p1_ln0(Frame& F) {
    const int gw = F.bid * 8 + F.wave, NGW = F.G * 8;
    float* H = WSP(float, WS_H); bf16* U = WSP(bf16, WS_U); const float* mod = WSP(float, WS_MOD);
    for (int row = gw; row < MT; row += NGW) {
        const float* src = row < ML ? F.in[0] + (size_t)row * D : F.in[2] + (size_t)(row - ML) * D;
        RowV r;
#pragma unroll
        for (int j = 0; j < 16; ++j) r.v[j] = *(const f32x4*)(src + 4 * (F.lane + 64 * j));
        float mean, rstd; row_stats(r, mean, rstd);
        const float* m = mod + (size_t)(0 * 3 + row_mod(row)) * 24576;
#pragma unroll
        for (int j = 0; j < 16; ++j) { const int c = 4 * (F.lane + 64 * j); const f32x4 y = (r.v[j] - mean) * rstd;
            *(f32x4*)(H + (size_t)row * D + c) = y;
            const f32x4 sh = *(const f32x4*)(m + c), scl = *(const f32x4*)(m + D + c); const f32x4 u = y * (1.f + scl) + sh;
            v2u o; o.x = pk2(u.x, u.y); o.y = pk2(u.z, u.w); *(v2u*)(U + (size_t)row * D + c) = o; }
    }
}

using pg8::Unit;
struct EpiBf16Plain {
    static constexpr bool PERM = true;
    bf16* O; int ldc;
    __device__ __forceinline__ void operator()(const f32x4 (&acc)[2][2][4][2], const Unit& u, int wr, int wc, int fr, int fq) const {
        const int row0 = u.pm * 256 + wr * 64 + fr, col0 = u.pn * 256 + wc * 32 + 8 * fq;
#pragma unroll
        for (int ai = 0; ai < 2; ++ai)
#pragma unroll
            for (int m = 0; m < 4; ++m) { bf16* rowp = O + (size_t)(row0 + ai * 128 + m * 16) * ldc + col0;
#pragma unroll
                for (int bj = 0; bj < 2; ++bj) { const f32x4 v0 = acc[ai][bj][m][0], v1 = acc[ai][bj][m][1];
                    v4u w; w.x = pg8::cvt_pk_bf16(v0[0], v0[1]); w.y = pg8::cvt_pk_bf16(v0[2], v0[3]); w.z = pg8::cvt_pk_bf16(v1[0], v1[1]); w.w = pg8::cvt_pk_bf16(v1[2], v1[3]);
                    *(v4u*)(rowp + bj * 128) = w; } }
    }
};
struct EpiOddIn {
    static constexpr bool PERM = true;
    bf16* O; float* Gt; const float* gb;
    __device__ __forceinline__ void operator()(const f32x4 (&acc)[2][2][4][2], const Unit& u, int wr, int wc, int fr, int fq) const {
        const int row0 = u.pm * 256 + wr * 64 + fr;
        if (u.pn < 48) {
            const int col0 = u.pn * 256 + wc * 32 + 8 * fq;
#pragma unroll
            for (int ai = 0; ai < 2; ++ai)
#pragma unroll
                for (int m = 0; m < 4; ++m) { bf16* rowp = O + (size_t)(row0 + ai * 128 + m * 16) * DIN1 + col0;
#pragma unroll
                    for (int bj = 0; bj < 2; ++bj) { const f32x4 v0 = acc[ai][bj][m][0], v1 = acc[ai][bj][m][1];
                        v4u w; w.x = pg8::cvt_pk_bf16(v0[0], v0[1]); w.y = pg8::cvt_pk_bf16(v0[2], v0[3]); w.z = pg8::cvt_pk_bf16(v1[0], v1[1]); w.w = pg8::cvt_pk_bf16(v1[2], v1[3]);
                        *(v4u*)(rowp + bj * 128) = w; } }
        } else if (wc == 0) {
            const int c0 = 8 * fq; const f32x4 b0 = *(const f32x4*)(gb + c0), b1 = *(const f32x4*)(gb + c0 + 4);
#pragma unroll
            for (int ai = 0; ai < 2; ++ai)
#pragma unroll
                for (int m = 0; m < 4; ++m) { float* rowp = Gt + (size_t)(row0 + ai * 128 + m * 16) * 32 + c0;
                    *(f32x4*)(rowp) = acc[ai][0][m][0] + b0; *(f32x4*)(rowp + 4) = acc[ai][0][m][1] + b1; }
        }
    }
};
struct EpiResid {
    static constexpr bool PERM = false;
    float* H; const float* modl;
    int goff;
    __device__ __forceinline__ void operator()(const f32x4 (&acc)[2][2][4][2], const Unit& u, int wr, int wc, int fr, int fq) const {
        const int row0 = u.pm * 256 + wr * 64 + fr, col0 = u.pn * 256 + wc * 32 + 4 * fq;
        const float* gv = modl + (size_t)row_mod(u.pm * 256) * 24576 + goff + col0;
        f32x4 g[2][2];
#pragma unroll
        for (int bj = 0; bj < 2; ++bj)
#pragma unroll
            for (int n = 0; n < 2; ++n) g[bj][n] = *(const f32x4*)(gv + bj * 128 + n * 16);
#pragma unroll
        for (int ai = 0; ai < 2; ++ai)
#pragma unroll
            for (int m = 0; m < 4; ++m) { float* rowp = H + (size_t)(row0 + ai * 128 + m * 16) * D + col0;
#pragma unroll
                for (int bj = 0; bj < 2; ++bj)
#pragma unroll
                    for (int n = 0; n < 2; ++n) { const f32x4 h = *(const f32x4*)(rowp + bj * 128 + n * 16); *(f32x4*)(rowp + bj * 128 + n * 16) = DN_ALPHA * h + g[bj][n] * acc[ai][bj][m][n]; }
                asm volatile("" ::: "memory"); }
    }
};
struct EpiPool {
    static constexpr bool PERM = true;
    bf16* A2; const float* ps;
    __device__ __forceinline__ void operator()(const f32x4 (&acc)[2][2][4][2], const Unit& u, int wr, int wc, int fr, int fq) const {
        const int row0 = u.pm * 256 + wr * 64 + fr, col0 = 512 * u.g + u.pn * 256 + wc * 32 + 8 * fq;
#pragma unroll
        for (int ai = 0; ai < 2; ++ai)
#pragma unroll
            for (int m = 0; m < 4; ++m) { bf16* rowp = A2 + (size_t)(row0 + ai * 128 + m * 16) * D + 2048 + col0;
#pragma unroll
                for (int bj = 0; bj < 2; ++bj) { const f32x4 s0 = *(const f32x4*)(ps + col0 + bj * 128), s1 = *(const f32x4*)(ps + col0 + bj * 128 + 4);
                    const f32x4 v0 = acc[ai][bj][m][0] * s0, v1 = acc[ai][bj][m][1] * s1;
                    v4u w; w.x = pg8::cvt_pk_bf16(v0[0], v0[1]); w.y = pg8::cvt_pk_bf16(v0[2], v0[3]); w.z = pg8::cvt_pk_bf16(v1[0], v1[1]); w.w = pg8::cvt_pk_bf16(v1[2], v1[3]);
                    *(v4u*)(rowp + bj * 128) = w; } }
    }
};
struct EpiGU {
    static constexpr bool PERM = true;
    bf16* ACT; int er;
    __device__ __forceinline__ void operator()(const f32x4 (&acc)[2][2][4][2], const Unit& u, int wr, int wc, int fr, int fq) const {
        const int row0 = u.pm * 256 + wr * 64 + fr, col0 = u.pn * 128 + wc * 32 + 8 * fq;
        bf16* base = ACT + (size_t)u.g * er * DE;
#pragma unroll
        for (int ai = 0; ai < 2; ++ai)
#pragma unroll
            for (int m = 0; m < 4; ++m) { bf16* rowp = base + (size_t)(row0 + ai * 128 + m * 16) * DE + col0;
                f32x4 v0, v1;
#pragma unroll
                for (int j = 0; j < 4; ++j) { v0[j] = siluf_(acc[ai][0][m][0][j]) * acc[ai][1][m][0][j]; v1[j] = siluf_(acc[ai][0][m][1][j]) * acc[ai][1][m][1][j]; }
                v4u w; w.x = pg8::cvt_pk_bf16(v0[0], v0[1]); w.y = pg8::cvt_pk_bf16(v0[2], v0[3]); w.z = pg8::cvt_pk_bf16(v1[0], v1[1]); w.w = pg8::cvt_pk_bf16(v1[2], v1[3]);
                *(v4u*)(rowp) = w; }
    }
};
struct EpiDown {
    static constexpr bool PERM = true;
    bf16* YE; const float* GX; int er;
    __device__ __forceinline__ void operator()(const f32x4 (&acc)[2][2][4][2], const Unit& u, int wr, int wc, int fr, int fq) const {
        const int row0 = u.pm * 256 + wr * 64 + fr, col0 = u.pn * 256 + wc * 32 + 8 * fq;
        bf16* base = YE + (size_t)u.g * er * D; const float* gx = GX + u.g * er;
#pragma unroll
        for (int ai = 0; ai < 2; ++ai)
#pragma unroll
            for (int m = 0; m < 4; ++m) { const int row = row0 + ai * 128 + m * 16; const float s = gx[row]; bf16* rowp = base + (size_t)row * D + col0;
#pragma unroll
                for (int bj = 0; bj < 2; ++bj) { const f32x4 v0 = acc[ai][bj][m][0] * s, v1 = acc[ai][bj][m][1] * s;
                    v4u w; w.x = pg8::cvt_pk_bf16(v0[0], v0[1]); w.y = pg8::cvt_pk_bf16(v0[2], v0[3]); w.z = pg8::cvt_pk_bf16(v1[0], v1[1]); w.w = pg8::cvt_pk_bf16(v1[2], v1[3]);
                    *(v4u*)(rowp + bj * 128) = w; } }
    }
};
constexpr int LRU_XC = 0, LRU_AF = 17408, LRU_BF = 50176, LRU_HF = 82944, LRU_SG = 115712;
template <bool APPLY>
__device__ __forceinline__ void lru_phase(Frame& F) {
    const bf16* XZS = WSP(bf16, WS_BIG);
    const bf16* GWT = WSP(bf16, WS_GWT);
    const float* LS8 = WSP(float, WS_LS8);
    float* SUMM = WSP(float, WS_SUMM); const float* CARRY = WSP(float, WS_CARRY);
    bf16* A2 = WSP(bf16, WS_A2);
    const float* convw = F.in[9]; const float* convb = F.in[10]; const float* gateb = F.in[12];
    const int wr = F.wave >> 2, wc = F.wave & 3, fr = F.lane & 15, fq = F.lane >> 4;
    LAS unsigned char* XC = F.lds + LRU_XC; LAS float* AF = (LAS float*)(F.lds + LRU_AF); LAS float* BF = (LAS float*)(F.lds + LRU_BF); LAS float* HF = (LAS float*)(F.lds + LRU_HF); LAS float* SG = (LAS float*)(F.lds + LRU_SG);
    for (int unit = F.bid; unit < NT_TILES * LRUH; unit += F.G) {
        const int tt = unit >> 4, h = unit & 15;
        const int r0 = tile_row0(tt); int slo, shi; tile_seq(tt, slo, shi);
        f32x4 xcv[2][2];
#pragma unroll
        for (int m = 0; m < 2; ++m)
#pragma unroll
            for (int n = 0; n < 2; ++n) {
                const int t = 32 * wr + 16 * m + fr, c = 32 * wc + 16 * n + 4 * fq, ch = h * 128 + c;
                f32x4 a = *(const f32x4*)(convb + ch);
#pragma unroll
                for (int j = 0; j < 4; ++j) { const int row = r0 + t + j - 1;
                    if (row >= slo && row < shi) { const v2u xv = *(const v2u*)(XZS + (size_t)row * DIN0 + ch); const f32x4 w = *(const f32x4*)(convw + j * DLRU + ch);
                        a.x += w.x * bflo(xv.x); a.y += w.y * bfhi(xv.x); a.z += w.z * bflo(xv.y); a.w += w.w * bfhi(xv.y); } }
                xcv[m][n] = a;
                v2u o; o.x = pk2(a.x, a.y); o.y = pk2(a.z, a.w); *(LAS v2u*)(XC + t * 272 + c * 2) = o;
            }
        __syncthreads();
#pragma unroll 1
        for (int d = 0; d < 2; ++d) {
            f32x4 acc[2][2][2];
#pragma unroll
            for (int g = 0; g < 2; ++g)
#pragma unroll
                for (int m = 0; m < 2; ++m)
#pragma unroll
                    for (int n = 0; n < 2; ++n) acc[g][m][n] = (f32x4){0.f, 0.f, 0.f, 0.f};
#pragma unroll
            for (int ks = 0; ks < 4; ++ks) {
                bf16x8 af[2];
#pragma unroll
                for (int m = 0; m < 2; ++m) af[m] = *(const LAS bf16x8*)(XC + (32 * wr + 16 * m + fr) * 272 + (ks * 32 + fq * 8) * 2);
#pragma unroll
                for (int g = 0; g < 2; ++g)
#pragma unroll
                    for (int n = 0; n < 2; ++n) { const bf16x8 bfv = *(const bf16x8*)(GWT + (size_t)((d * 2 + g) * 16 + h) * 16384 + (32 * wc + 16 * n + fr) * 128 + ks * 32 + fq * 8);
#pragma unroll
                        for (int m = 0; m < 2; ++m) acc[g][m][n] = __builtin_amdgcn_mfma_f32_16x16x32_bf16(bfv, af[m], acc[g][m][n], 0, 0, 0); }
            }
#pragma unroll
            for (int m = 0; m < 2; ++m)
#pragma unroll
                for (int n = 0; n < 2; ++n) {
                    const int t = 32 * wr + 16 * m + fr, c = 32 * wc + 16 * n + 4 * fq, ch = h * 128 + c;
                    const f32x4 b0 = *(const f32x4*)(gateb + (d * 2 + 0) * DLRU + ch), b1 = *(const f32x4*)(gateb + (d * 2 + 1) * DLRU + ch), l8 = *(const f32x4*)(LS8 + d * DLRU + ch);
                    f32x4 av, bv;
#pragma unroll
                    for (int j = 0; j < 4; ++j) { const float r = sigmoidf_(acc[0][m][n][j] + b0[j]), ig = sigmoidf_(acc[1][m][n][j] + b1[j]);
                        const float la = l8[j] * r; av[j] = __expf(la); bv[j] = sqrtf(-expm1f(2.f * la)) * ig * xcv[m][n][j]; }
                    *(LAS f32x4*)(AF + t * 128 + c) = av; *(LAS f32x4*)(BF + t * 128 + c) = bv;
                }
            __syncthreads();
            {
                const int c = F.tid & 127, seg = F.tid >> 7, ch = h * 128 + c;
                const int tb = d == 0 ? 16 * seg : 16 * seg + 15, ts = d == 0 ? 1 : -1;
                float hs = 0.f, P = 1.f;
#pragma unroll
                for (int i = 0; i < 16; ++i) { const int t = tb + ts * i; const float a = AF[t * 128 + c]; hs = a * hs + BF[t * 128 + c]; P *= a; }
                SG[(seg * 2 + 0) * 128 + c] = P; SG[(seg * 2 + 1) * 128 + c] = hs;
                __syncthreads();
                if (!APPLY) {
                    if (seg == 0) { float Pt = 1.f, Ht = 0.f;
#pragma unroll
                        for (int q = 0; q < 4; ++q) { const int sgi = d == 0 ? q : 3 - q; const float Pq = SG[(sgi * 2 + 0) * 128 + c]; Ht = Pq * Ht + SG[(sgi * 2 + 1) * 128 + c]; Pt *= Pq; }
                        SUMM[((size_t)(tt * 2 + d) * 2 + 0) * DLRU + ch] = Pt; SUMM[((size_t)(tt * 2 + d) * 2 + 1) * DLRU + ch] = Ht; }
                } else {
                    float cin = CARRY[(size_t)(tt * 2 + d) * DLRU + ch];
#pragma unroll
                    for (int q = 0; q < 3; ++q) { const int sgi = d == 0 ? q : 3 - q; const bool before = d == 0 ? (sgi < seg) : (sgi > seg);
                        if (before) cin = SG[(sgi * 2 + 0) * 128 + c] * cin + SG[(sgi * 2 + 1) * 128 + c]; }
                    hs = cin;
#pragma unroll
                    for (int i = 0; i < 16; ++i) { const int t = tb + ts * i; hs = AF[t * 128 + c] * hs + BF[t * 128 + c];
                        if (d == 0) HF[t * 128 + c] = hs; else HF[t * 128 + c] += hs; }
                }
            }
            __syncthreads();
        }
        if (APPLY) {
            const int t = F.tid >> 3, cg = (F.tid & 7) * 16; const size_t row = (size_t)(r0 + t);
            const v4u* zp = (const v4u*)(XZS + row * DIN0 + DLRU + h * 128 + cg); v4u* op = (v4u*)(A2 + row * D + h * 128 + cg);
#pragma unroll
            for (int i = 0; i < 2; ++i) { const v4u z = zp[i]; v4u o;
#pragma unroll
                for (int k = 0; k < 4; ++k) { const int cc = cg + i * 8 + 2 * k; o[k] = pk2(HF[t * 128 + cc] * gelu_tanh(bflo(z[k])), HF[t * 128 + cc + 1] * gelu_tanh(bfhi(z[k]))); }
                op[i] = o; }
            __syncthreads();
        }
    }
}

__device__ __forceinline__ void lru_carry(Frame& F) {
    const float* SUMM = WSP(float, WS_SUMM); float* CARRY = WSP(float, WS_CARRY);
    const int gt = F.bid * NTHR + F.tid, NGT = F.G * NTHR;
    for (int i = gt; i < NB * 2 * DLRU; i += NGT) {
        const int ch = i & 2047, d = (i >> 11) & 1, b = i >> 12;
        float st = 0.f;
#pragma unroll 1
        for (int half = 0; half < 2; ++half) {
            float Pv[34], Hv[34];
#pragma unroll
            for (int q = 0; q < 34; ++q) { const int s = half * 34 + q; const int tt = s < 4 ? 128 + 4 * b + (d ? 3 - s : s) : 64 * b + (d ? 63 - (s - 4) : (s - 4));
                Pv[q] = SUMM[((size_t)(tt * 2 + d) * 2 + 0) * DLRU + ch]; Hv[q] = SUMM[((size_t)(tt * 2 + d) * 2 + 1) * DLRU + ch]; }
#pragma unroll
            for (int q = 0; q < 34; ++q) { const int s = half * 34 + q; const int tt = s < 4 ? 128 + 4 * b + (d ? 3 - s : s) : 64 * b + (d ? 63 - (s - 4) : (s - 4));
                CARRY[(size_t)(tt * 2 + d) * DLRU + ch] = st; st = Pv[q] * st + Hv[q]; }
        }
    }
}

__device__ __forceinline__ int pool_w_of(int g) { return 2 << g; }
__device__ __forceinline__ void pool_pass1(Frame& F) {
    const bf16* XZS = WSP(bf16, WS_BIG); float* CM = WSP(float, WS_CM);
    LAS unsigned char* T = F.lds;
    for (int unit = F.bid; unit < NB * 64 * 4; unit += F.G) {
        const int g = unit & 3, gr = (unit >> 2) & 63, b = unit >> 8; const int row0 = b * SEQ + gr * 64, w = pool_w_of(g);
        for (int i = F.tid; i < 64 * 64; i += NTHR) { const int r = i >> 6, cseg = i & 63;
            *(LAS v4u*)(T + r * 1024 + cseg * 16) = *(const v4u*)(XZS + (size_t)(row0 + r) * DIN0 + 2 * DLRU + g * 512 + cseg * 8); }
        __syncthreads();
        const int cp = F.tid & 255, half = F.tid >> 8;
        for (int j = half * 32; j < half * 32 + 32; ++j) {
            const int lo = max(0, j - w / 2), hi = min(64, j + w - w / 2);
            float s0 = 0.f, s1 = 0.f;
            for (int q = lo; q < hi; ++q) { const unsigned v = *(const LAS unsigned*)(T + q * 1024 + cp * 4); s0 += bflo(v); s1 += bfhi(v); }
            const float inv = 1.f / (float)(hi - lo);
            *(f32x2*)(CM + (size_t)(row0 + j) * DPOOL + g * 512 + 2 * cp) = (f32x2){s0 * inv, s1 * inv};
        }
        __syncthreads();
    }
}
__device__ __forceinline__ void pool_pass2(Frame& F) {
    const bf16* XZS = WSP(bf16, WS_BIG); const float* CM = WSP(float, WS_CM); bf16* DP = WSP(bf16, WS_DP);
    LAS float* T = (LAS float*)F.lds;
    for (int unit = F.bid; unit < NB * 64 * 4 * 2; unit += F.G) {
        const int hc = unit & 1, g = (unit >> 1) & 3, gc = (unit >> 3) & 63, b = unit >> 9; const int w = pool_w_of(g), cb = g * 512 + hc * 256;
        for (int i = F.tid; i < 64 * 64; i += NTHR) { const int r = i >> 6, cseg = i & 63;
            *(LAS f32x4*)(T + r * 256 + cseg * 4) = *(const f32x4*)(CM + (size_t)(b * SEQ + r * 64 + gc) * DPOOL + cb + cseg * 4); }
        __syncthreads();
        const int c = F.tid & 255, half = F.tid >> 8;
        for (int r = half * 32; r < half * 32 + 32; ++r) {
            const int lo = max(0, r - w / 2), hi = min(64, r + w - w / 2);
            float s = 0.f;
            for (int q = lo; q < hi; ++q) s += T[q * 256 + c];
            const size_t tok = (size_t)(b * SEQ + r * 64 + gc);
            const float x = bf2f(XZS[tok * DIN0 + 2 * DLRU + cb + c]);
            DP[tok * DPOOL + cb + c] = (bf16)f2bf(s / (float)(hi - lo) - x);
        }
        __syncthreads();
    }
}
__device__ __forceinline__ void pool_ctx(Frame& F) {
    const bf16* XZS = WSP(bf16, WS_BIG); bf16* DP = WSP(bf16, WS_DP);
    const int gt = F.bid * NTHR + F.tid, NGT = F.G * NTHR;
    for (int i = gt; i < MC * DPOOL; i += NGT) {
        const int ch = i & 2047, r = i >> 11, b = r >> 8, t = r & 255; const int w = pool_w_of(ch >> 9);
        const int lo = max(0, t - w / 2), hi = min(CTXL, t + w - w / 2);
        float s = 0.f;
        for (int q = lo; q < hi; ++q) s += bf2f(XZS[(size_t)(ML + b * CTXL + q) * DIN0 + 2 * DLRU + ch]);
        const float x = bf2f(XZS[(size_t)(ML + r) * DIN0 + 2 * DLRU + ch]);
        DP[(size_t)(ML + r) * DPOOL + ch] = (bf16)f2bf(s / (float)(hi - lo) - x);
    }
}
__device__ __forceinline__ void ln_router_phase(Frame& F, int l, int nrows) {
    const int NGW = F.G * 8;
    float* H = WSP(float, WS_H); bf16* U = WSP(bf16, WS_U); const float* mod = WSP(float, WS_MOD) + (size_t)l * 3 * 24576;
    const f32x4* wrt4 = (const f32x4*)(WSP(float, WS_WRT) + (size_t)l * 16 * D); float* AFF = WSP(float, WS_AFF);
    const float* lg = F.in[6] + (size_t)(l * 2 + 0) * D; const float* lb = F.in[7] + (size_t)(l * 2 + 0) * D;
    LAS f32x4* WL = (LAS f32x4*)F.lds;
    for (int it = 0; it * NGW + F.bid * 8 < nrows; ++it) {
        const int row = it * NGW + F.bid * 8 + F.wave; const bool act = row < nrows;
        RowV r;
#pragma unroll
        for (int j = 0; j < 16; ++j) r.v[j] = act ? *(const f32x4*)(H + (size_t)row * D + 4 * (F.lane + 64 * j)) : (f32x4){0.f, 0.f, 0.f, 0.f};
        float mean, rstd; row_stats(r, mean, rstd);
        const float* m = mod + (size_t)row_mod(act ? row : 0) * 24576;
#pragma unroll
        for (int j = 0; j < 16; ++j) { const int c = 4 * (F.lane + 64 * j);
            const f32x4 y = (r.v[j] - mean) * rstd * *(const f32x4*)(lg + c) + *(const f32x4*)(lb + c);
            const f32x4 sh = *(const f32x4*)(m + 3 * D + c), scl = *(const f32x4*)(m + 4 * D + c); const f32x4 u = y * (1.f + scl) + sh;
            if (act) { *(f32x4*)(H + (size_t)row * D + c) = y; v2u o; o.x = pk2(u.x, u.y); o.y = pk2(u.z, u.w); *(v2u*)(U + (size_t)row * D + c) = o; }
            r.v[j] = u; }
        float lgt[16];
#pragma unroll
        for (int e = 0; e < 16; ++e) lgt[e] = 0.f;
#pragma unroll 1
        for (int c = 0; c < 4; ++c) {
            __syncthreads();
            for (int i = F.tid; i < 4096; i += NTHR) WL[i] = wrt4[(i >> 8) * 1024 + c * 256 + (i & 255)];
            f32x4 x0, x1, x2, x3;
            if (c == 0) { x0 = r.v[0]; x1 = r.v[1]; x2 = r.v[2]; x3 = r.v[3]; } else if (c == 1) { x0 = r.v[4]; x1 = r.v[5]; x2 = r.v[6]; x3 = r.v[7]; }
            else if (c == 2) { x0 = r.v[8]; x1 = r.v[9]; x2 = r.v[10]; x3 = r.v[11]; } else { x0 = r.v[12]; x1 = r.v[13]; x2 = r.v[14]; x3 = r.v[15]; }
            __syncthreads();
#pragma unroll
            for (int e = 0; e < 16; ++e) { const f32x4 w0 = WL[e * 256 + F.lane], w1 = WL[e * 256 + F.lane + 64], w2 = WL[e * 256 + F.lane + 128], w3 = WL[e * 256 + F.lane + 192];
                lgt[e] += ((x0.x * w0.x + x0.y * w0.y) + (x0.z * w0.z + x0.w * w0.w)) + ((x1.x * w1.x + x1.y * w1.y) + (x1.z * w1.z + x1.w * w1.w))
                        + ((x2.x * w2.x + x2.y * w2.y) + (x2.z * w2.z + x2.w * w2.w)) + ((x3.x * w3.x + x3.y * w3.y) + (x3.z * w3.z + x3.w * w3.w)); }
        }
        float mylogit = 0.f;
#pragma unroll
        for (int e = 0; e < 16; ++e) { const float sfull = wave_sum(lgt[e]); if (F.lane == e) mylogit = sfull; }
        float v = F.lane < 16 ? mylogit : -3.0e38f;
        const float mx = wave_max(v); const float ex = F.lane < 16 ? __expf(v - mx) : 0.f; const float den = wave_sum(ex);
        if (act && F.lane < 16) { int s, n; if (row < ML) { s = row >> 12; n = row & 4095; } else { s = 2 + ((row - ML) >> 8); n = (row - ML) & 255; }
            AFF[((size_t)s * 16 + F.lane) * SEQ + n] = ex / den; }
    }
    __syncthreads();
}

__device__ __forceinline__ void topk_phase(Frame& F, int nseq) {
    const float* AFF = WSP(float, WS_AFF); int* IDX = WSP(int, WS_IDX); float* GSEL = WSP(float, WS_GSEL); int* INV = WSP(int, WS_INV);
    LAS unsigned long long* key = (LAS unsigned long long*)F.lds;
    for (int p = F.bid; p < nseq * 16; p += F.G) {
        const int s = p >> 4, e = p & 15, n = seq_len(s), cap = n >> 3;
        for (int i = F.tid; i < n; i += NTHR) { const float a = AFF[((size_t)s * 16 + e) * SEQ + i]; key[i] = ((unsigned long long)__builtin_bit_cast(unsigned, a) << 32) | (unsigned long long)(0xFFFFFFFFu - (unsigned)i); }
        __syncthreads();
        for (int k = 2; k <= n; k <<= 1)
            for (int j = k >> 1; j > 0; j >>= 1) {
                for (int i = F.tid; i < n; i += NTHR) { const int ixj = i ^ j;
                    if (ixj > i) { const unsigned long long a = key[i], b = key[ixj]; const bool desc = (i & k) == 0;
                        if (desc ? (a < b) : (a > b)) { key[i] = b; key[ixj] = a; } } }
                __syncthreads();
            }
        const int rbase = seq_row0(s);
        for (int i = F.tid; i < n; i += NTHR) { const unsigned long long kk = key[i]; const int tok = (int)(0xFFFFFFFFu - (unsigned)(kk & 0xFFFFFFFFull));
            if (i < cap) { IDX[(s * 16 + e) * 512 + i] = tok; GSEL[(s * 16 + e) * 512 + i] = __builtin_bit_cast(float, (unsigned)(kk >> 32)); }
            INV[(size_t)(rbase + tok) * 16 + e] = i < cap ? i : -1; }
        __syncthreads();
    }
}

__device__ __forceinline__ bool erow_decode(int r, int& s, int& slot) {
    if (r < 512) { s = 0; slot = r; return true; } if (r < 1024) { s = 1; slot = r - 512; return true; }
    if (r < 1056) { s = 2; slot = r - 1024; return true; } if (r < 1088) { s = 3; slot = r - 1056; return true; } return false;
}
__device__ __forceinline__ int slot_base(int s) { return s == 0 ? 0 : (s == 1 ? 512 : (s == 2 ? 1024 : 1056)); }

__device__ __forceinline__ void gather_phase(Frame& F, int er) {
    const int gw = F.bid * 8 + F.wave, NGW = F.G * 8;
    const bf16* U = WSP(bf16, WS_U); bf16* XE = WSP(bf16, WS_XE); float* GX = WSP(float, WS_GX);
    const int* IDX = WSP(int, WS_IDX); const float* GSEL = WSP(float, WS_GSEL);
    for (int i = gw; i < 16 * er; i += NGW) {
        const int e = i / er, r = i - e * er; int s, slot; const bool ok = erow_decode(r, s, slot);
        v4u* dst = (v4u*)(XE + (size_t)i * D);
        if (ok) { const int tok = IDX[(s * 16 + e) * 512 + slot]; const v4u* src = (const v4u*)(U + (size_t)(seq_row0(s) + tok) * D);
#pragma unroll
            for (int j = 0; j < 8; ++j) dst[F.lane + 64 * j] = src[F.lane + 64 * j];
            if (F.lane == 0) GX[i] = GSEL[(s * 16 + e) * 512 + slot];
        } else {
#pragma unroll
            for (int j = 0; j < 8; ++j) dst[F.lane + 64 * j] = (v4u){0u, 0u, 0u, 0u};
            if (F.lane == 0) GX[i] = 0.f; }
    }
}

template <bool LAST>
__device__ __forceinline__ void combine_phase(Frame& F, int l, int nrows, int er) {
    const int gw = F.bid * 8 + F.wave, NGW = F.G * 8;
    float* H = WSP(float, WS_H); bf16* U = WSP(bf16, WS_U); const float* mod = WSP(float, WS_MOD) + (size_t)l * 3 * 24576; const float* modn = WSP(float, WS_MOD) + (size_t)(l + 1) * 3 * 24576;
    const bf16* YE = WSP(bf16, WS_YE); const int* INV = WSP(int, WS_INV);
    const float* lg = F.in[6] + (size_t)(l * 2 + 1) * D; const float* lb = F.in[7] + (size_t)(l * 2 + 1) * D;
    for (int row = gw; row < nrows; row += NGW) {
        RowV r, ms;
#pragma unroll
        for (int j = 0; j < 16; ++j) { r.v[j] = *(const f32x4*)(H + (size_t)row * D + 4 * (F.lane + 64 * j)); ms.v[j] = (f32x4){0.f, 0.f, 0.f, 0.f}; }
        const int s = row < ML ? (row >> 12) : 2 + ((row - ML) >> 8); const int sb = slot_base(s);
#pragma unroll 1
        for (int e = 0; e < 16; ++e) { const int slot = INV[(size_t)row * 16 + e];
            if (slot >= 0) { const bf16* y = YE + ((size_t)e * er + sb + slot) * D;
#pragma unroll
                for (int j = 0; j < 16; ++j) { const v2u w = *(const v2u*)(y + 4 * (F.lane + 64 * j)); ms.v[j].x += bflo(w.x); ms.v[j].y += bfhi(w.x); ms.v[j].z += bflo(w.y); ms.v[j].w += bfhi(w.y); } } }
        const float* m = mod + (size_t)row_mod(row) * 24576;
#pragma unroll
        for (int j = 0; j < 16; ++j) { const f32x4 g2 = *(const f32x4*)(m + 5 * D + 4 * (F.lane + 64 * j)); r.v[j] = DN_ALPHA * r.v[j] + g2 * ms.v[j]; }
        float mean, rstd; row_stats(r, mean, rstd);
        const float* mn = modn + (size_t)row_mod(row) * 24576;
#pragma unroll
        for (int j = 0; j < 16; ++j) { const int c = 4 * (F.lane + 64 * j);
            const f32x4 y = (r.v[j] - mean) * rstd * *(const f32x4*)(lg + c) + *(const f32x4*)(lb + c);
            if (LAST) { *(f32x4*)(F.out + (size_t)row * D + c) = y; }
            else { *(f32x4*)(H + (size_t)row * D + c) = y;
                const f32x4 sh = *(const f32x4*)(mn + c), scl = *(const f32x4*)(mn + D + c); const f32x4 u = y * (1.f + scl) + sh;
                v2u o; o.x = pk2(u.x, u.y); o.y = pk2(u.z, u.w); *(v2u*)(U + (size_t)row * D + c) = o; } }
    }
}
typedef short v4i16_t __attribute__((ext_vector_type(4)));
__device__ __forceinline__ bf16x8 row_frag(const LAS unsigned char* T, int stride, int r0, int k0, int fr, int fq) { return *(const LAS bf16x8*)(T + (r0 + fr) * stride + (k0 + fq * 8) * 2); }
__device__ __forceinline__ bf16x8 tr_frag(const LAS unsigned char* T, int stride, int k0, int n0, int fr, int fq) {
    const LAS unsigned char* p0 = T + (k0 + 8 * fq + (fr >> 2)) * stride + n0 * 2 + 8 * (fr & 3);
    const v4i16_t lo = __builtin_amdgcn_ds_read_tr16_b64_v4i16((LAS v4i16_t*)p0);
    const v4i16_t hi = __builtin_amdgcn_ds_read_tr16_b64_v4i16((LAS v4i16_t*)(p0 + 4 * stride));
    return (bf16x8){lo[0], lo[1], lo[2], lo[3], hi[0], hi[1], hi[2], hi[3]};
}
#define MFMA16(a, b, c) __builtin_amdgcn_mfma_f32_16x16x32_bf16((a), (b), (c), 0, 0, 0)
constexpr int ML_QS = 0, ML_KS = 33792, ML_VS = 67584, ML_VW = 76800, ML_SP = 86016, ML_CT = 95232, ML_SM = 129024;
constexpr int SM_A = 0, SM_ROWC = 64, SM_EINT = 128, SM_LOW = 192, SM_W = 256, SM_DEN4 = 320, SM_QN = 576, SM_NST = 640, SM_SCAL = 896;
__device__ __forceinline__ v4u scale_bf16x8(v4u v, float s) {
    v4u o;
#pragma unroll
    for (int i = 0; i < 4; ++i) { const unsigned w = v[i]; o[i] = pk2(bflo(w) * s, bfhi(w) * s); }
    return o;
}
__device__ __forceinline__ float mlstm_scalars(LAS float* SM, float ig, float fp, float m_prev, int lane) {
    float bc = logsigmoidf_(fp);
#pragma unroll
    for (int o = 1; o < 64; o <<= 1) { const float t = __shfl_up(bc, o); if (lane >= o) bc += t; }
    const float a = ig - bc; float pm = a;
#pragma unroll
    for (int o = 1; o < 64; o <<= 1) { const float t = __shfl_up(pm, o); if (lane >= o) pm = fmaxf(pm, t); }
    const float mcomb = bc + fmaxf(m_prev, pm);
    const float bend = __shfl(bc, 63), pm63 = __shfl(pm, 63);
    const float m_new = fmaxf(bend + m_prev, bend + pm63);
    SM[SM_A + lane] = a; SM[SM_ROWC + lane] = bc - mcomb; SM[SM_EINT + lane] = __expf(bc + m_prev - mcomb); SM[SM_LOW + lane] = __expf(-mcomb);
    SM[SM_W + lane] = __expf(bend + a - m_new);
    if (lane == 0) SM[SM_SCAL + 0] = __expf(bend + m_prev - m_new);
    return m_new;
}
__device__ __forceinline__ int mlstm_base(int step, int b, int d) { return step < 4 ? ML + b * CTXL + 64 * (d ? 3 - step : step) : b * SEQ + 64 * (d ? 63 - (step - 4) : (step - 4)); }
__device__ __forceinline__ void mlstm_phase(Frame& F) {
    const bf16* QKVO = WSP(bf16, WS_BIG); const float* Gt = WSP(float, WS_G); bf16* HD = WSP(bf16, WS_HD);
    LAS unsigned char* QS = F.lds + ML_QS; LAS unsigned char* KS = F.lds + ML_KS; LAS unsigned char* VS = F.lds + ML_VS; LAS unsigned char* VW = F.lds + ML_VW;
    LAS unsigned char* SP = F.lds + ML_SP; LAS unsigned char* CT = F.lds + ML_CT; LAS float* SM = (LAS float*)(F.lds + ML_SM);
    const int wr = F.wave >> 2, wc = F.wave & 3, fr = F.lane & 15, fq = F.lane >> 4, tid = F.tid;
    for (int unit = F.bid; unit < 256; unit += F.G) {
        const int x = unit & 7, y = unit >> 3; const int combo = x + 8 * (y >> 3), jv = y & 7;
        const int b = combo >> 4, h = (combo >> 1) & 7, d = combo & 1;
        f32x4 accC[2][4];
#pragma unroll
        for (int m = 0; m < 2; ++m)
#pragma unroll
            for (int n = 0; n < 4; ++n) accC[m][n] = (f32x4){0.f, 0.f, 0.f, 0.f};
        float n_reg = 0.f, m_run = 0.f;
        v4u kq[4], qq[4], vv; float g_i = 0.f, g_f = 0.f;
        {
            const int base = mlstm_base(0, b, d);
#pragma unroll
            for (int i = 0; i < 4; ++i) { const int q = tid + 512 * i, r = q >> 5, cs = q & 31; const size_t row = (size_t)(base + (d ? 63 - r : r));
                kq[i] = *(const v4u*)(QKVO + row * DIN1 + 2048 + h * DQK + cs * 8); qq[i] = (v4u){0u, 0u, 0u, 0u}; }
            { const int r = tid >> 3, cs = tid & 7; const size_t row = (size_t)(base + (d ? 63 - r : r)); vv = *(const v4u*)(QKVO + row * DIN1 + 4096 + h * DV + jv * 64 + cs * 8); }
            if (F.wave == 0) { const int row = base + (d ? 63 - F.lane : F.lane); g_i = Gt[(size_t)row * 32 + d * 16 + h]; g_f = Gt[(size_t)row * 32 + d * 16 + 8 + h];
                m_run = mlstm_scalars(SM, g_i, g_f, 0.f, F.lane); }
            if (tid < 256) SM[SM_NST + tid] = 0.f;
        }
#pragma unroll 1
        for (int step = 0; step < 68; ++step) {
            const bool lat = step >= 4;
            const int base = mlstm_base(step, b, d);
#pragma unroll
            for (int i = 0; i < 4; ++i) { const int q = tid + 512 * i, r = q >> 5, cs = q & 31;
                *(LAS v4u*)(KS + r * 528 + cs * 16) = kq[i];
                if (lat) *(LAS v4u*)(QS + r * 528 + cs * 16) = scale_bf16x8(qq[i], 0.0625f); }
            *(LAS v4u*)(VS + (tid >> 3) * 144 + (tid & 7) * 16) = vv;
            __syncthreads();
            const float decay = SM[SM_SCAL + 0];
            *(LAS v4u*)(VW + (tid >> 3) * 144 + (tid & 7) * 16) = scale_bf16x8(vv, SM[SM_W + (tid >> 3)]);
            if (step < 67) {
                const int nb = mlstm_base(step + 1, b, d); const bool nlat = step + 1 >= 4;
#pragma unroll
                for (int i = 0; i < 4; ++i) { const int q = tid + 512 * i, r = q >> 5, cs = q & 31; const size_t row = (size_t)(nb + (d ? 63 - r : r));
                    kq[i] = *(const v4u*)(QKVO + row * DIN1 + 2048 + h * DQK + cs * 8);
                    if (nlat) qq[i] = *(const v4u*)(QKVO + row * DIN1 + h * DQK + cs * 8); }
                { const int r = tid >> 3, cs = tid & 7; const size_t row = (size_t)(nb + (d ? 63 - r : r)); vv = *(const v4u*)(QKVO + row * DIN1 + 4096 + h * DV + jv * 64 + cs * 8); }
                if (F.wave == 0) { const int row = nb + (d ? 63 - F.lane : F.lane); g_i = Gt[(size_t)row * 32 + d * 16 + h]; g_f = Gt[(size_t)row * 32 + d * 16 + 8 + h]; }
            }
            if (lat) {
                {
                    const int t = tid >> 3, part = tid & 7; float s = 0.f;
#pragma unroll
                    for (int i = 0; i < 4; ++i) { const v4u xq = *(const LAS v4u*)(QS + t * 528 + (part * 32 + i * 8) * 2);
#pragma unroll
                        for (int k = 0; k < 4; ++k) s += bflo(xq[k]) * SM[SM_NST + part * 32 + i * 8 + 2 * k] + bfhi(xq[k]) * SM[SM_NST + part * 32 + i * 8 + 2 * k + 1]; }
                    s += __shfl_xor(s, 1); s += __shfl_xor(s, 2); s += __shfl_xor(s, 4);
                    if (part == 0) SM[SM_QN + t] = s;
                }
                f32x4 accS[2]; accS[0] = accS[1] = (f32x4){0.f, 0.f, 0.f, 0.f};
#pragma unroll
                for (int ks = 0; ks < 256; ks += 32) { const bf16x8 kf = row_frag(KS, 528, 16 * wc, ks, fr, fq);
#pragma unroll
                    for (int m = 0; m < 2; ++m) accS[m] = MFMA16(kf, row_frag(QS, 528, 32 * wr + 16 * m, ks, fr, fq), accS[m]); }
#pragma unroll
                for (int m = 0; m < 2; ++m) { const int t = 32 * wr + 16 * m + fr, s0 = 16 * wc + 4 * fq; const float rc = SM[SM_ROWC + t];
                    f32x4 p; float ps = 0.f;
#pragma unroll
                    for (int j = 0; j < 4; ++j) { const int s = s0 + j; p[j] = (s <= t) ? accS[m][j] * __expf(rc + SM[SM_A + s]) : 0.f; ps += p[j]; }
                    ps += __shfl_xor(ps, 16); ps += __shfl_xor(ps, 32);
                    if (fq == 0) SM[SM_DEN4 + t * 4 + wc] = ps;
                    v2u o; o.x = pk2(p[0], p[1]); o.y = pk2(p[2], p[3]); *(LAS v2u*)(SP + t * 144 + s0 * 2) = o; }
            }
            __syncthreads();
            if (lat) {
                f32x4 acc1[2], acc2[2]; acc1[0] = acc1[1] = acc2[0] = acc2[1] = (f32x4){0.f, 0.f, 0.f, 0.f};
#pragma unroll
                for (int ks = 0; ks < 256; ks += 32) { const bf16x8 cf = row_frag(CT, 528, 16 * wc, ks, fr, fq);
#pragma unroll
                    for (int m = 0; m < 2; ++m) acc2[m] = MFMA16(cf, row_frag(QS, 528, 32 * wr + 16 * m, ks, fr, fq), acc2[m]); }
#pragma unroll
                for (int ks = 0; ks < 64; ks += 32) { const bf16x8 vf = tr_frag(VS, 144, ks, 16 * wc, fr, fq);
#pragma unroll
                    for (int m = 0; m < 2; ++m) acc1[m] = MFMA16(vf, row_frag(SP, 144, 32 * wr + 16 * m, ks, fr, fq), acc1[m]); }
#pragma unroll
                for (int m = 0; m < 2; ++m) { const int t = 32 * wr + 16 * m + fr; const float ei = SM[SM_EINT + t];
                    const float den = (SM[SM_DEN4 + t * 4 + 0] + SM[SM_DEN4 + t * 4 + 1]) + (SM[SM_DEN4 + t * 4 + 2] + SM[SM_DEN4 + t * 4 + 3]) + ei * SM[SM_QN + t];
                    const float inv = 1.f / fmaxf(fabsf(den), SM[SM_LOW + t]);
                    const f32x4 hv = (acc1[m] + ei * acc2[m]) * inv;
                    const size_t row = (size_t)(base + (d ? 63 - t : t));
                    v2u o; o.x = pk2(hv[0], hv[1]); o.y = pk2(hv[2], hv[3]);
                    *(v2u*)(HD + ((size_t)d * ML + row) * D + h * DV + jv * 64 + 16 * wc + 4 * fq) = o; }
            }
            if (tid < 256) {
                float s = 0.f;
                for (int q = 0; q < 64; ++q) s += SM[SM_W + q] * bf2f(*(const LAS unsigned short*)(KS + q * 528 + tid * 2));
                n_reg = decay * n_reg + s;
            }
#pragma unroll
            for (int m = 0; m < 2; ++m)
#pragma unroll
                for (int n = 0; n < 4; ++n) accC[m][n] = accC[m][n] * decay;
#pragma unroll
            for (int ks = 0; ks < 64; ks += 32) { bf16x8 vf[2];
#pragma unroll
                for (int m = 0; m < 2; ++m) vf[m] = tr_frag(VW, 144, ks, 32 * wr + 16 * m, fr, fq);
#pragma unroll
                for (int n = 0; n < 4; ++n) { const bf16x8 kf = tr_frag(KS, 528, ks, 64 * wc + 16 * n, fr, fq);
#pragma unroll
                    for (int m = 0; m < 2; ++m) accC[m][n] = MFMA16(kf, vf[m], accC[m][n]); } }
            __syncthreads();
#pragma unroll
            for (int m = 0; m < 2; ++m)
#pragma unroll
                for (int n = 0; n < 4; ++n) { const int v = 32 * wr + 16 * m + fr, dd = 64 * wc + 16 * n + 4 * fq; v2u o; o.x = pk2(accC[m][n][0], accC[m][n][1]); o.y = pk2(accC[m][n][2], accC[m][n][3]);
                    *(LAS v2u*)(CT + v * 528 + dd * 2) = o; }
            if (tid < 256) SM[SM_NST + tid] = n_reg;
            if (F.wave == 0 && step < 67) m_run = mlstm_scalars(SM, g_i, g_f, m_run, F.lane);
        }
        __syncthreads();
    }
}
#undef MFMA16

__device__ __forceinline__ void headnorm_phase(Frame& F) {
    const int gw = F.bid * 8 + F.wave, NGW = F.G * 8;
    const bf16* HD = WSP(bf16, WS_HD); const bf16* QKVO = WSP(bf16, WS_BIG); bf16* A2 = WSP(bf16, WS_A2); const float* ng = F.in[19];
    for (int row = gw; row < ML; row += NGW) {
        float v[64]; const int c0 = F.lane * 64;
        const v4u* p0 = (const v4u*)(HD + (size_t)row * D + c0); const v4u* p1 = (const v4u*)(HD + ((size_t)ML + row) * D + c0);
        float s = 0.f;
#pragma unroll
        for (int i = 0; i < 8; ++i) { const v4u a = p0[i], bq = p1[i];
#pragma unroll
            for (int k = 0; k < 4; ++k) { v[i * 8 + 2 * k] = bflo(a[k]) + bflo(bq[k]); v[i * 8 + 2 * k + 1] = bfhi(a[k]) + bfhi(bq[k]); s += v[i * 8 + 2 * k] + v[i * 8 + 2 * k + 1]; } }
        s += __shfl_xor(s, 1); s += __shfl_xor(s, 2); s += __shfl_xor(s, 4);
        const float mean = s * (1.f / DV); float q = 0.f;
#pragma unroll
        for (int i = 0; i < 64; ++i) { v[i] -= mean; q += v[i] * v[i]; }
        q += __shfl_xor(q, 1); q += __shfl_xor(q, 2); q += __shfl_xor(q, 4);
        const float rstd = 1.f / sqrtf(q * (1.f / DV) + LN_EPS);
        const v4u* po = (const v4u*)(QKVO + (size_t)row * DIN1 + 8192 + c0); v4u* pd = (v4u*)(A2 + (size_t)row * D + c0);
#pragma unroll
        for (int i = 0; i < 8; ++i) { const v4u o = po[i]; v4u w;
#pragma unroll
            for (int k = 0; k < 4; ++k) { const int c = i * 8 + 2 * k; const f32x2 g = *(const f32x2*)(ng + c0 + c);
                w[k] = pk2(sigmoidf_(bflo(o[k])) * v[c] * rstd * g.x, sigmoidf_(bfhi(o[k])) * v[c + 1] * rstd * g.y); }
            pd[i] = w; }
    }
}
#define XB_TMO      128
#define XB_XCNT(j)  (256  + 64 * (j))
#define XB_XSUB(j)  (1280 + 64 * (j))
#define XB_XGEN(j)  (2304 + 64 * (j))
#define XB_TOP      3328
#define XB_TOPGEN   3392
#define XCD_BAR_WORDS 3456
#define XB_SPIN_CAP (1u << 22)

__device__ __forceinline__ unsigned xb_ld(unsigned* p)              { return __hip_atomic_load(p, __ATOMIC_RELAXED, __HIP_MEMORY_SCOPE_AGENT); }
__device__ __forceinline__ unsigned xb_add(unsigned* p, unsigned v) { return __hip_atomic_fetch_add(p, v, __ATOMIC_RELAXED, __HIP_MEMORY_SCOPE_AGENT); }
__device__ __forceinline__ unsigned xb_xcc_id() { return (unsigned)__builtin_amdgcn_s_getreg((3 << 11) | 20) & 0xFu; }
#define XB_SPIN(cond, bar) do { unsigned _sp = 0; while (cond) { __builtin_amdgcn_s_sleep(1); \
    if ((++_sp & 255u) == 0u) { if (xb_ld(&(bar)[XB_TMO])) break; if (_sp > XB_SPIN_CAP) { atomicAdd(&(bar)[XB_TMO], 1u); break; } } } } while (0)

struct XcdBarrier { unsigned* bar; unsigned x; volatile LAS unsigned* st; };

__device__ __forceinline__ XcdBarrier xcd_barrier_post(unsigned* bar, volatile LAS unsigned* st) {
    XcdBarrier b; b.bar = bar; b.x = xb_xcc_id(); b.st = st;
    if (threadIdx.x == 0) (void)xb_add(&bar[XB_XCNT(b.x)], 1u);
    return b;
}
__device__ __forceinline__ void xcd_barrier_complete(unsigned* bar, unsigned x, unsigned& nloc, unsigned& nx) {
    const unsigned G = gridDim.x * gridDim.y * gridDim.z;
    unsigned sum, cnt, mine, sp = 0u;
    for (;;) {
        sum = 0u; cnt = 0u; mine = 0u;
#pragma unroll
        for (unsigned j = 0; j < 16; ++j) { const unsigned c = xb_ld(&bar[XB_XCNT(j)]); sum += c; cnt += (c > 0u) ? 1u : 0u; mine = (j == x) ? c : mine; }
        if (sum == G) break;
        __builtin_amdgcn_s_sleep(1);
        if ((++sp & 255u) == 0u) { if (xb_ld(&bar[XB_TMO])) break; if (sp > XB_SPIN_CAP) { atomicAdd(&bar[XB_TMO], 1u); break; } }
    }
    nloc = mine > 0u ? mine : 1u; nx = cnt > 0u ? cnt : 1u;
}
__device__ __forceinline__ void xcd_barrier(const XcdBarrier& b) {
    asm volatile("s_waitcnt vmcnt(0)" ::: "memory");
    __syncthreads();
    if (threadIdx.x == 0) {
        unsigned* bar = b.bar;
        __builtin_amdgcn_s_waitcnt(0);
        unsigned nloc = b.st[0], nx = b.st[1];
        if (nloc == 0u) { xcd_barrier_complete(bar, b.x, nloc, nx); b.st[0] = nloc; b.st[1] = nx; }
        const unsigned old = xb_add(&bar[XB_XSUB(b.x)], 1u);
        const unsigned gen = old / nloc;
        if (old + 1u == (gen + 1u) * nloc) {
            __builtin_amdgcn_fence(__ATOMIC_RELEASE, "agent");
            asm volatile("s_waitcnt vmcnt(0)" ::: "memory");
            const unsigned og = xb_add(&bar[XB_TOP], 1u);
            const unsigned tg = og / nx;
            if (og + 1u == (tg + 1u) * nx) xb_add(&bar[XB_TOPGEN], 1u);
            else XB_SPIN(xb_ld(&bar[XB_TOPGEN]) == tg, bar);
            __builtin_amdgcn_fence(__ATOMIC_ACQUIRE, "agent");
            xb_add(&bar[XB_XGEN(b.x)], 1u);
            asm volatile("s_waitcnt vmcnt(0)" ::: "memory");
        } else {
            XB_SPIN(xb_ld(&bar[XB_XGEN(b.x)]) == gen, bar);
            __builtin_amdgcn_fence(__ATOMIC_ACQUIRE, "agent");
            asm volatile("s_waitcnt vmcnt(0)" ::: "memory");
        }
    }
    __syncthreads();
}

constexpr int N_PHASES = 23;
struct Args { const float* in[24]; float* out; unsigned char* ws; int ph_lo, ph_hi; };
__global__ void __launch_bounds__(NTHR, 2) fwd_kernel(Args args) {
    extern __shared__ __attribute__((aligned(16))) unsigned char lds_raw[];
    Frame F;
    F.lds = (LAS unsigned char*)lds_raw;
    F.tid = threadIdx.x; F.lane = F.tid & 63; F.wave = __builtin_amdgcn_readfirstlane(F.tid >> 6);
    F.bid = blockIdx.x; F.G = gridDim.x; F.ws = args.ws; F.out = args.out;
#pragma unroll
    for (int i = 0; i < 24; ++i) F.in[i] = args.in[i];
    volatile LAS unsigned* MISC = (volatile LAS unsigned*)(F.lds + MISC_OFF);
    if (F.tid < 64) MISC[F.tid] = 0u;
    __syncthreads();
    const int lo = args.ph_lo, hi = args.ph_hi;
    const bool multi = (hi - lo) > 1;
    unsigned* barw = (unsigned*)(F.ws + WS_CTL) + CW_BAR;
    XcdBarrier bar; bar.bar = barw; bar.x = 0; bar.st = MISC + 8;
    if (multi) bar = xcd_barrier_post(barw, MISC + 8);
#define IN(k) (lo <= (k) && (k) < hi)
#define SEAM(k) do { if (IN(k) && IN((k) + 1)) xcd_barrier(bar); } while (0)
    LAS unsigned char* ring = F.lds;

    if (IN(0)) { p0_convert(F); __syncthreads(); p0_adaln(F); } SEAM(0);
    if (IN(1)) { p1_ln0(F); } SEAM(1);
    if (IN(2)) { pg8::Gemm g{WSP(bf16, WS_U), WSP(bf16, WS_W1T), D, D, D, 0, 0}; pg8::TileOrder S; S.init(1, MT / 256, DIN0 / 256, F.G, F.bid);
        EpiBf16Plain E{WSP(bf16, WS_BIG), DIN0}; pg8::gemm_phase(ring, g, S, E); } SEAM(2);
    if (IN(3)) { lru_phase<false>(F); pool_pass1(F); pool_ctx(F); } SEAM(3);
    if (IN(4)) { lru_carry(F); pool_pass2(F); } SEAM(4);
    if (IN(5)) { lru_phase<true>(F);
        pg8::Gemm g{WSP(bf16, WS_DP), WSP(bf16, WS_PWT), DPOOL, 512, 512, 512 * 2, 512 * 512 * 2}; pg8::TileOrder S; S.init(4, MT / 256, 2, F.G, F.bid);
        EpiPool E{WSP(bf16, WS_A2), F.in[15]}; pg8::gemm_phase(ring, g, S, E); } SEAM(5);
    if (IN(6)) { pg8::Gemm g{WSP(bf16, WS_A2), WSP(bf16, WS_W2T), D, D, D, 0, 0}; pg8::TileOrder S; S.init(1, MT / 256, D / 256, F.G, F.bid);
        EpiResid E{WSP(float, WS_H), WSP(float, WS_MOD), 2 * D}; pg8::gemm_phase(ring, g, S, E); } SEAM(6);
    if (IN(7)) { ln_router_phase(F, 0, MT); } SEAM(7);
    if (IN(8)) { topk_phase(F, 4); } SEAM(8);
    if (IN(9)) { gather_phase(F, ER0); } SEAM(9);
    if (IN(10)) { pg8::Gemm g{WSP(bf16, WS_XE), WSP(bf16, WS_WGU), D, D, D, (size_t)ER0 * D * 2, (size_t)2048 * D * 2}; pg8::TileOrder S; S.init(16, ER0 / 256, 8, F.G, F.bid);
        EpiGU E{WSP(bf16, WS_ACT), ER0}; pg8::gemm_phase(ring, g, S, E); } SEAM(10);
    if (IN(11)) { pg8::Gemm g{WSP(bf16, WS_ACT), WSP(bf16, WS_WDN), DE, DE, DE, (size_t)ER0 * DE * 2, (size_t)D * DE * 2}; pg8::TileOrder S; S.init(16, ER0 / 256, 16, F.G, F.bid);
        EpiDown E{WSP(bf16, WS_YE), WSP(float, WS_GX), ER0}; pg8::gemm_phase(ring, g, S, E); } SEAM(11);
    if (IN(12)) { combine_phase<false>(F, 0, MT, ER0); } SEAM(12);
    if (IN(13)) { pg8::Gemm g{WSP(bf16, WS_U), WSP(bf16, WS_W3T), D, D, D, 0, 0}; pg8::TileOrder S; S.init(1, MT / 256, DIN1P / 256, F.G, F.bid);
        EpiOddIn E{WSP(bf16, WS_BIG), WSP(float, WS_G), F.in[18]}; pg8::gemm_phase(ring, g, S, E); } SEAM(13);
    if (IN(14)) { mlstm_phase(F); } SEAM(14);
    if (IN(15)) { headnorm_phase(F); } SEAM(15);
    if (IN(16)) { pg8::Gemm g{WSP(bf16, WS_A2), WSP(bf16, WS_W4T), D, D, D, 0, 0}; pg8::TileOrder S; S.init(1, ML / 256, D / 256, F.G, F.bid);
        EpiResid E{WSP(float, WS_H), WSP(float, WS_MOD) + 3 * 24576, 2 * D}; pg8::gemm_phase(ring, g, S, E); } SEAM(16);
    if (IN(17)) { ln_router_phase(F, 1, ML); } SEAM(17);
    if (IN(18)) { topk_phase(F, 2); } SEAM(18);
    if (IN(19)) { gather_phase(F, ER1); } SEAM(19);
    if (IN(20)) { pg8::Gemm g{WSP(bf16, WS_XE), WSP(bf16, WS_WGU) + (size_t)16 * 2048 * D, D, D, D, (size_t)ER1 * D * 2, (size_t)2048 * D * 2}; pg8::TileOrder S; S.init(16, ER1 / 256, 8, F.G, F.bid);
        EpiGU E{WSP(bf16, WS_ACT), ER1}; pg8::gemm_phase(ring, g, S, E); } SEAM(20);
    if (IN(21)) { pg8::Gemm g{WSP(bf16, WS_ACT), WSP(bf16, WS_WDN) + (size_t)16 * D * DE, DE, DE, DE, (size_t)ER1 * DE * 2, (size_t)D * DE * 2}; pg8::TileOrder S; S.init(16, ER1 / 256, 16, F.G, F.bid);
        EpiDown E{WSP(bf16, WS_YE), WSP(float, WS_GX), ER1}; pg8::gemm_phase(ring, g, S, E); } SEAM(21);
    if (IN(22)) { combine_phase<true>(F, 1, ML, ER1); }
#undef IN
#undef SEAM
}

#ifndef MK_ONE_LAUNCH
#define MK_ONE_LAUNCH 0
#endif
extern "C" void kernel_launch(void* const* d_in, const int* in_sizes, int n_in, void* d_out, int out_size, void* d_ws, size_t ws_size, hipStream_t stream) {
    static int grid = 0;
    if (grid == 0) {
        if (n_in != 24 || out_size != ML * D || ws_size < WS_END) { fprintf(stderr, "kernel_launch: unexpected shapes (n_in %d, out %d, ws %zu); nothing launched\n", n_in, out_size, ws_size); grid = -1; return; }
        int dev = 0, cus = 0, per_cu = 0;
        if (hipGetDevice(&dev) != hipSuccess || hipDeviceGetAttribute(&cus, hipDeviceAttributeMultiprocessorCount, dev) != hipSuccess) { grid = -1; return; }
        if (hipFuncSetAttribute((const void*)fwd_kernel, hipFuncAttributeMaxDynamicSharedMemorySize, LDS_BYTES) != hipSuccess) { fprintf(stderr, "kernel_launch: hipFuncSetAttribute failed\n"); grid = -1; return; }
        if (hipOccupancyMaxActiveBlocksPerMultiprocessor(&per_cu, (const void*)fwd_kernel, NTHR, LDS_BYTES) != hipSuccess || per_cu < 1) { fprintf(stderr, "kernel_launch: occupancy query says %d\n", per_cu); }
        (void)hipGetLastError();
        grid = cus;
    }
    if (grid < 0) return;
    if (hipMemsetAsync((char*)d_ws + WS_CTL, 0, CTL_ZERO_BYTES, stream) != hipSuccess) return;
    Args a{};
    for (int i = 0; i < 24; ++i) a.in[i] = (const float*)d_in[i];
    a.out = (float*)d_out; a.ws = (unsigned char*)d_ws;
#if MK_ONE_LAUNCH
    a.ph_lo = 0; a.ph_hi = N_PHASES;
    hipLaunchKernelGGL(fwd_kernel, dim3(grid), dim3(NTHR), LDS_BYTES, stream, a);
#else
    for (int p = 0; p < N_PHASES; ++p) { a.ph_lo = p; a.ph_hi = p + 1; hipLaunchKernelGGL(fwd_kernel, dim3(grid), dim3(NTHR), LDS_BYTES, stream, a); }
#endif
}
```

```cpp
#ifndef MK_ONE_LAUNCH
#define MK_ONE_LAUNCH 1
#endif
#ifndef REP_MASK
#define REP_MASK 0u
#endif
#include <hip/hip_runtime.h>
#include <cstdio>
#include <cstdint>
namespace pg8 {
#define PG8_LAS __attribute__((address_space(3)))
typedef unsigned short bf16_t;
typedef short bf16x8 __attribute__((ext_vector_type(8)));
typedef float f32x4 __attribute__((ext_vector_type(4)));
typedef float f32x2 __attribute__((ext_vector_type(2)));
typedef unsigned u32x4 __attribute__((ext_vector_type(4)));
typedef unsigned u32x2 __attribute__((ext_vector_type(2)));
constexpr int BM = 256, BK = 64, HALF = 128, HTB = HALF * BK * 2  , STAGE_BYTES = 8 * HTB, NXCD = 8, WGM = 8;

__host__ __device__ __forceinline__ int lds_byte(int r, int c) { const int st = (r >> 4) * 2 + (c >> 5), rr = r & 15, cc = c & 31, ob = rr * 64 + cc * 2; return st * 1024 + (ob ^ (((ob >> 9) & 1) << 5)); }
__host__ __device__ __forceinline__ void stage_rc(int b, int& R, int& C) { const int st = b / 1024, sb = b % 1024, swz = sb ^ (((sb >> 9) & 1) << 5); R = (st >> 1) * 16 + swz / 64; C = (st & 1) * 32 + (swz % 64) / 2; }
__host__ __device__ __forceinline__ int perm32(int rho) { const int n = rho >> 4, i = rho & 15; return 8 * (i >> 2) + 4 * n + (i & 3); }

struct Unit { int pm, pn, g; };
struct Gemm { const bf16_t* A; const bf16_t* Bt; int lda, ldb, K; size_t gA, gB; const int* rowidx; int grows; };

struct TileOrder {
    int nG, nM, nN, per, nwg, G, c;
    __device__ __forceinline__ void init(int nG_, int nM_, int nN_, int G_, int c_) { nG = nG_; nM = nM_; nN = nN_; per = nM * nN; nwg = nG * per; G = G_; c = c_; }
    __device__ __forceinline__ bool next(int i, Unit& u) const {
        const long L = (long)i * G + c; if (L >= nwg) return false;
        int wgid = (int)L; { const int q = nwg / NXCD, r = nwg % NXCD, xcd = wgid % NXCD, off = wgid / NXCD; wgid = (xcd < r ? xcd * (q + 1) : r * (q + 1) + (xcd - r) * q) + off; }
        u.g = wgid / per; wgid -= u.g * per;
        const int nig = WGM * nN, gid = wgid / nig, fm = gid * WGM, gsz = (nM - fm) < WGM ? (nM - fm) : WGM;
        u.pm = fm + ((wgid % nig) % gsz); u.pn = (wgid % nig) / gsz; return true;
    }
};

__device__ __forceinline__ unsigned cvt_pk_bf16(float lo, float hi) { unsigned r; asm volatile("v_cvt_pk_bf16_f32 %0, %1, %2" : "=v"(r) : "v"(lo), "v"(hi)); return r; }

template <bool GATHER = false, class Epi, class Sched>
__device__ __forceinline__ void gemm_phase(PG8_LAS unsigned char* lds, const Gemm g, const Sched& S, const Epi& E) {
    const int tid = threadIdx.x, wid = __builtin_amdgcn_readfirstlane(tid >> 6), lane = tid & 63, wr = wid >> 2, wc = wid & 3, fr = lane & 15, fq = lane >> 4;
    const int K = g.K, nt = K / BK;
    unsigned voffA[2], voffB[2]; int stR[2], stC[2];
#pragma unroll
    for (int i = 0; i < 2; ++i) { int R, C; stage_rc(tid * 16 + i * 8192, R, C); const int Rb = Epi::PERM ? ((R & ~31) + perm32(R & 31)) : R; stR[i] = R; stC[i] = C;
        voffA[i] = (unsigned)(R * g.lda + C) * 2u; voffB[i] = (unsigned)(Rb * g.ldb + C) * 2u; }
    unsigned vA[2][2], vAn[2][2];
#define PG8_GOFFS(v, u) do { _Pragma("unroll") for (int _h = 0; _h < 2; ++_h) _Pragma("unroll") for (int _i = 0; _i < 2; ++_i) \
        (v)[_h][_i] = (unsigned)(g.rowidx[(size_t)(u).g * g.grows + (u).pm * 256 + _h * 128 + stR[_i]] * g.lda + stC[_i]) * 2u; } while (0)
    const size_t kstep = (size_t)(BK * 2);
    const size_t hstepA = (size_t)HALF * g.lda * 2, hstepB = (size_t)HALF * g.ldb * 2;
    const size_t tstepA = 2 * hstepA, tstepB = 2 * hstepB;
    const unsigned ldsw = (unsigned)wid * 1024u;
    const int aoff = lds_byte(wr * 64 + fr, fq * 8), boff = lds_byte(wc * 32 + fr, fq * 8);
#define PG8_SA(b, h) (((b) * 2 + (h)) * HTB)
#define PG8_SB(b, h) ((4 + (b) * 2 + (h)) * HTB)
#define PG8_STAGE(bufoff, gbase, voff) do { _Pragma("unroll") for (int _i = 0; _i < 2; ++_i) \
        __builtin_amdgcn_global_load_lds((const unsigned*)((const char*)(gbase) + (voff)[_i]), (PG8_LAS unsigned*)(lds + (bufoff) + ldsw + _i * 8192), 16, 0, 0); } while (0)
#define PG8_LDA(dst, b, h) do { _Pragma("unroll") for (int m = 0; m < 4; ++m) _Pragma("unroll") for (int k = 0; k < 2; ++k) dst[m][k] = *(const PG8_LAS bf16x8*)(lds + PG8_SA(b, h) + aoff + m * 2048 + k * 1024); } while (0)
#define PG8_LDB(dst, b, h) do { _Pragma("unroll") for (int n = 0; n < 2; ++n) _Pragma("unroll") for (int k = 0; k < 2; ++k) dst[n][k] = *(const PG8_LAS bf16x8*)(lds + PG8_SB(b, h) + boff + n * 2048 + k * 1024); } while (0)
#define PG8_MMA(ai, bj, At, Bt) do { __builtin_amdgcn_s_setprio(1); _Pragma("unroll") for (int m = 0; m < 4; ++m) _Pragma("unroll") for (int n = 0; n < 2; ++n) _Pragma("unroll") for (int k = 0; k < 2; ++k) \
        acc[ai][bj][m][n] = __builtin_amdgcn_mfma_f32_16x16x32_bf16(Bt[n][k], At[m][k], acc[ai][bj][m][n], 0, 0, 0); __builtin_amdgcn_s_setprio(0); } while (0)
#define PG8_WAIT_V(n) asm volatile("s_waitcnt vmcnt(" #n ")" ::: "memory")
#define PG8_WAIT_L(n) asm volatile("s_waitcnt lgkmcnt(" #n ")" ::: "memory")
#define PG8_BAR __builtin_amdgcn_s_barrier()
#define PG8_SCHED __builtin_amdgcn_sched_barrier(0)
    Unit cur, nxt; int ui = 0;
    if (!S.next(0, cur)) return;
    f32x4 acc[2][2][4][2];
#pragma unroll
    for (int a = 0; a < 2; ++a)
#pragma unroll
        for (int b = 0; b < 2; ++b)
#pragma unroll
            for (int m = 0; m < 4; ++m)
#pragma unroll
                for (int n = 0; n < 2; ++n) acc[a][b][m][n] = (f32x4){0.f, 0.f, 0.f, 0.f};
    bf16x8 At[4][2], B0[2][2], B1[2][2];
    const char* cA = GATHER ? (const char*)g.A : (const char*)g.A + (size_t)cur.g * g.gA + (size_t)cur.pm * tstepA; const char* cB = (const char*)g.Bt + (size_t)cur.g * g.gB + (size_t)cur.pn * tstepB;
    if constexpr (GATHER) { PG8_GOFFS(vA, cur); }
    if constexpr (GATHER) { PG8_STAGE(PG8_SB(0, 0), cB, voffB); PG8_STAGE(PG8_SB(0, 1), cB + hstepB, voffB); PG8_STAGE(PG8_SA(0, 0), cA, vA[0]); PG8_STAGE(PG8_SA(0, 1), cA, vA[1]); }
    else { PG8_STAGE(PG8_SB(0, 0), cB, voffB); PG8_STAGE(PG8_SB(0, 1), cB + hstepB, voffB); PG8_STAGE(PG8_SA(0, 0), cA, voffA); PG8_STAGE(PG8_SA(0, 1), cA + hstepA, voffA); }
    if (wr == 1) PG8_BAR;
    PG8_WAIT_V(2); PG8_BAR;
    if constexpr (GATHER) { PG8_STAGE(PG8_SB(1, 0), cB + kstep, voffB); PG8_STAGE(PG8_SA(1, 0), cA + kstep, vA[0]); PG8_STAGE(PG8_SB(1, 1), cB + hstepB + kstep, voffB); }
    else { PG8_STAGE(PG8_SB(1, 0), cB + kstep, voffB); PG8_STAGE(PG8_SA(1, 0), cA + kstep, voffA); PG8_STAGE(PG8_SB(1, 1), cB + hstepB + kstep, voffB); }
    PG8_WAIT_V(6); PG8_BAR;
    for (;;) {
        const bool has_next = S.next(ui + 1, nxt);
        const char* nA = GATHER ? cA : (has_next ? (const char*)g.A + (size_t)nxt.g * g.gA + (size_t)nxt.pm * tstepA : cA); const char* nB = has_next ? (const char*)g.Bt + (size_t)nxt.g * g.gB + (size_t)nxt.pn * tstepB : cB;
        if constexpr (GATHER) { if (has_next) { PG8_GOFFS(vAn, nxt); } else {
#pragma unroll
                for (int _h = 0; _h < 2; ++_h)
#pragma unroll
                    for (int _i = 0; _i < 2; ++_i) vAn[_h][_i] = vA[_h][_i]; } }
        for (int t = 0; t < nt; t += 2) {
            const bool last = (t == nt - 2);
            const char* a1 = cA + (size_t)(t + 1) * kstep;
            const char* a2 = last ? nA : cA + (size_t)(t + 2) * kstep; const char* b2 = last ? nB : cB + (size_t)(t + 2) * kstep;
            const char* a3 = a2 + kstep; const char* b3 = b2 + kstep;
            unsigned w0[2], w1[2];
            if constexpr (GATHER) {
#pragma unroll
                for (int _i = 0; _i < 2; ++_i) { w0[_i] = last ? vAn[0][_i] : vA[0][_i]; w1[_i] = last ? vAn[1][_i] : vA[1][_i]; } }
            PG8_LDB(B0, 0, 0); PG8_LDB(B1, 0, 1); PG8_SCHED; PG8_LDA(At, 0, 0); if constexpr (GATHER) { PG8_STAGE(PG8_SA(1, 1), a1, vA[1]); } else { PG8_STAGE(PG8_SA(1, 1), a1 + hstepA, voffA); }
            PG8_WAIT_V(8); PG8_WAIT_L(0); PG8_BAR; PG8_MMA(0, 0, At, B0); PG8_MMA(0, 1, At, B1); PG8_BAR; PG8_SCHED;
            PG8_LDA(At, 0, 1); PG8_STAGE(PG8_SB(0, 0), b2, voffB); PG8_STAGE(PG8_SB(0, 1), b2 + hstepB, voffB); if constexpr (GATHER) { PG8_STAGE(PG8_SA(0, 0), a2, w0); } else { PG8_STAGE(PG8_SA(0, 0), a2, voffA); }
            PG8_WAIT_V(8); PG8_WAIT_L(0); PG8_BAR; PG8_MMA(1, 0, At, B0); PG8_MMA(1, 1, At, B1); PG8_BAR; PG8_SCHED;
            PG8_LDB(B0, 1, 0); PG8_LDB(B1, 1, 1); PG8_SCHED; PG8_LDA(At, 1, 0); if constexpr (GATHER) { PG8_STAGE(PG8_SA(0, 1), a2, w1); } else { PG8_STAGE(PG8_SA(0, 1), a2 + hstepA, voffA); }
            PG8_WAIT_V(8); PG8_WAIT_L(0); PG8_BAR; PG8_MMA(0, 0, At, B0); PG8_MMA(0, 1, At, B1); PG8_BAR; PG8_SCHED;
            PG8_LDA(At, 1, 1); PG8_STAGE(PG8_SB(1, 0), b3, voffB); PG8_STAGE(PG8_SB(1, 1), b3 + hstepB, voffB); if constexpr (GATHER) { PG8_STAGE(PG8_SA(1, 0), a3, w0); } else { PG8_STAGE(PG8_SA(1, 0), a3, voffA); }
            PG8_WAIT_V(8); PG8_WAIT_L(0); PG8_BAR; PG8_MMA(1, 0, At, B0); PG8_MMA(1, 1, At, B1); PG8_BAR; PG8_SCHED;
        }
        if (wr == 0) PG8_BAR;
        E(acc, cur, wr, wc, fr, fq);
        if (!has_next) break;
#pragma unroll
        for (int a = 0; a < 2; ++a)
#pragma unroll
            for (int b = 0; b < 2; ++b)
#pragma unroll
                for (int m = 0; m < 4; ++m)
#pragma unroll
                    for (int n = 0; n < 2; ++n) acc[a][b][m][n] = (f32x4){0.f, 0.f, 0.f, 0.f};
        cur = nxt; cA = nA; cB = nB; ++ui;
        if constexpr (GATHER) {
#pragma unroll
            for (int _h = 0; _h < 2; ++_h)
#pragma unroll
                for (int _i = 0; _i < 2; ++_i) vA[_h][_i] = vAn[_h][_i]; }
        if (wr == 1) PG8_BAR;
    }
    PG8_WAIT_V(0);
    PG8_BAR;
#undef PG8_GOFFS
#undef PG8_SA
#undef PG8_SB
#undef PG8_STAGE
#undef PG8_LDA
#undef PG8_LDB
#undef PG8_MMA
#undef PG8_WAIT_V
#undef PG8_WAIT_L
#undef PG8_BAR
#undef PG8_SCHED
}
}
#define GAS __attribute__((address_space(1)))
#define LAS __attribute__((address_space(3)))
typedef unsigned short bf16;
typedef unsigned v4u __attribute__((ext_vector_type(4)));
typedef unsigned v2u __attribute__((ext_vector_type(2)));
typedef float f32x4 __attribute__((ext_vector_type(4)));
typedef float f32x2 __attribute__((ext_vector_type(2)));
typedef short bf16x8 __attribute__((ext_vector_type(8)));

constexpr int D = 4096, NB = 2, SEQ = 4096, CTXL = 256;
constexpr int ML = NB * SEQ, MC = NB * CTXL, MT = ML + MC;
constexpr int DLRU = 2048, LRUH = 16, LRUB = 128, DPOOL = 2048, DIN0 = 6144;
constexpr int MH = 8, DQK = 256, DV = 512, DIN1 = 12288, DIN1P = 12544, CHUNK = 64;
constexpr int NE = 16, DE = 1024;
constexpr int ER0 = 1280, ER1 = 1024;
constexpr float LN_EPS = 1e-5f, DN_ALPHA = 1.41421356237f;
constexpr int NT_TILES = 136;

constexpr size_t WS_CTL = 0ull, CTL_ZERO_BYTES = 1048576ull;
constexpr size_t WS_MOD = 1048576ull;
constexpr size_t WS_WRT = 1638400ull;
constexpr size_t WS_LS8 = 2162688ull;
constexpr size_t WS_W1T = 2179072ull;
constexpr size_t WS_W2T = 52510720ull;
constexpr size_t WS_W3T = 86065152ull;
constexpr size_t WS_W4T = 188825600ull;
constexpr size_t WS_WGU = 222380032ull;
constexpr size_t WS_WDN = 759250944ull;
constexpr size_t WS_GWT = 1027686400ull;
constexpr size_t WS_PWT = 1029783552ull;
constexpr size_t WS_H = 1031880704ull;
constexpr size_t WS_U = 1174487040ull;
constexpr size_t WS_BIG = 1245790208ull;
constexpr size_t WS_A2 = 1459699712ull;
constexpr size_t WS_CM = 1531002880ull;
constexpr size_t WS_DP = 1598111744ull;
constexpr size_t WS_SUMM = 1633763328ull;
constexpr size_t WS_CARRY = 1638219776ull;
constexpr size_t WS_AFF = 1640448000ull;
constexpr size_t WS_IDX = 1641496576ull;
constexpr size_t WS_GSEL = 1641627648ull;
constexpr size_t WS_INV = 1641758720ull;
constexpr size_t WS_GX = 1642315776ull;
constexpr size_t WS_XE = 1642397696ull;
constexpr size_t WS_ACT = 1810169856ull;
constexpr size_t WS_YE = 1852112896ull;
constexpr size_t WS_G = 2019885056ull;
constexpr size_t WS_HD = 2020999168ull;
constexpr size_t WS_END = 2155216896ull;

constexpr int CW_BAR = 4096;
constexpr int LDS_BYTES = 147456;
constexpr int MISC_OFF = 144 * 1024 - 256;
constexpr int NTHR = 512;

__device__ __forceinline__ unsigned f2bf(float f) { unsigned u = __builtin_bit_cast(unsigned, f); return (u + 0x7fffu + ((u >> 16) & 1u)) >> 16; }
__device__ __forceinline__ unsigned pk2(float lo, float hi) { return f2bf(lo) | (f2bf(hi) << 16); }
__device__ __forceinline__ float bf2f(unsigned b) { return __builtin_bit_cast(float, b << 16); }
__device__ __forceinline__ float bflo(unsigned w) { return __builtin_bit_cast(float, w << 16); }
__device__ __forceinline__ float bfhi(unsigned w) { return __builtin_bit_cast(float, w & 0xffff0000u); }
__device__ __forceinline__ float wave_sum(float v) {
#pragma unroll
    for (int o = 1; o < 64; o <<= 1) v += __shfl_xor(v, o);
    return v;
}
__device__ __forceinline__ float wave_max(float v) {
#pragma unroll
    for (int o = 1; o < 64; o <<= 1) v = fmaxf(v, __shfl_xor(v, o));
    return v;
}
__device__ __forceinline__ float rcp_fast(float x) { return __builtin_amdgcn_rcpf(x); }
__device__ __forceinline__ float sigmoidf_(float x) { return rcp_fast(1.f + __expf(-x)); }
__device__ __forceinline__ float siluf_(float x) { return x * rcp_fast(1.f + __expf(-x)); }
__device__ __forceinline__ float logsigmoidf_(float x) { return fminf(x, 0.f) - log1pf(__expf(-fabsf(x))); }
__device__ __forceinline__ float gelu_tanh(float x) { const float u = 0.7978845608028654f * (x + 0.044715f * x * x * x); const float t = 1.f - 2.f * rcp_fast(__expf(2.f * u) + 1.f); return 0.5f * x * (1.f + t); }
__device__ __forceinline__ float expm1_small(float x) {
    float p = 1.f / 720.f; p = p * x + (1.f / 120.f); p = p * x + (1.f / 24.f); p = p * x + (1.f / 6.f); p = p * x + 0.5f; p = p * x + 1.f; p = p * x;
    if (fabsf(x) > 0.5f) p = expm1f(x);
    return p;
}

__device__ __forceinline__ int seq_row0(int s) { return s < 2 ? s * SEQ : ML + (s - 2) * CTXL; }
__device__ __forceinline__ int seq_len(int s) { return s < 2 ? SEQ : CTXL; }
__device__ __forceinline__ int row_mod(int row) { return row < SEQ ? 0 : (row < ML ? 1 : 2); }
__device__ __forceinline__ int tile_row0(int tt) { return tt < 128 ? tt * 64 : ML + (tt - 128) * 64; }
__device__ __forceinline__ void tile_seq(int tt, int& lo, int& hi) { if (tt < 128) { lo = (tt >> 6) * SEQ; hi = lo + SEQ; } else { lo = ML + ((tt - 128) >> 2) * CTXL; hi = lo + CTXL; } }
struct Frame {
    LAS unsigned char* lds;
    int tid, lane, wave;
    int bid, G;
    unsigned char* ws;
    const float* in[24];
    float* out;
};
#define WSP(T, off) ((T*)(F.ws + (off)))

__device__ __forceinline__ void transpose_item(const float* W, int N, bf16* WT, int ldk, int k0, int n0, int drow0, LAS float* scr, int lane) {
    const bool ok = n0 + lane < N; const float* src = W + (size_t)k0 * N + (ok ? n0 + lane : N - 1);
    float v[64];
#pragma unroll
    for (int kk = 0; kk < 64; ++kk) v[kk] = src[(size_t)kk * N];
#pragma unroll
    for (int kk = 0; kk < 64; ++kk) scr[kk * 65 + lane] = ok ? v[kk] : 0.f;
    asm volatile("s_waitcnt lgkmcnt(0)" ::: "memory");
    const int c = lane & 7;
#pragma unroll
    for (int j = 0; j < 8; ++j) { const int n = (lane >> 3) + 8 * j; const LAS float* s = scr + (8 * c) * 65 + n;
        v4u o; o.x = pk2(s[0 * 65], s[1 * 65]); o.y = pk2(s[2 * 65], s[3 * 65]); o.z = pk2(s[4 * 65], s[5 * 65]); o.w = pk2(s[6 * 65], s[7 * 65]);
        *(v4u*)(WT + (size_t)(drow0 + n) * ldk + k0 + 8 * c) = o; }
    asm volatile("s_waitcnt lgkmcnt(0)" ::: "memory");
}

__device__ __forceinline__ void p0_convert(Frame& F) {
    LAS float* scr = (LAS float*)(F.lds + F.wave * 16640);
    const int gw = F.bid * 8 + F.wave, NGW = F.G * 8;
    constexpr int I0 = 64 * 96, I1 = 64 * 64, I2 = 64 * 193, I3 = 64 * 64, I4 = 32 * 2048, I5 = 32 * 1024, I6 = 64 * 4, I7 = 4 * 64;
    constexpr int NITEMS = I0 + I1 + I2 + I3 + I4 + I5 + I6 + I7;
    for (int it = gw; it < NITEMS; it += NGW) {
        int r = it;
        if (r < I0) { const int kb = r / 96, nb = r % 96; transpose_item(F.in[8], DIN0, WSP(bf16, WS_W1T), D, kb * 64, nb * 64, nb * 64, scr, F.lane); continue; } r -= I0;
        if (r < I1) { const int kb = r / 64, nb = r % 64; transpose_item(F.in[16], D, WSP(bf16, WS_W2T), D, kb * 64, nb * 64, nb * 64, scr, F.lane); continue; } r -= I1;
        if (r < I2) { const int kb = r / 193, nb = r % 193; transpose_item(F.in[17], 12320, WSP(bf16, WS_W3T), D, kb * 64, nb * 64, nb * 64, scr, F.lane); continue; } r -= I2;
        if (r < I3) { const int kb = r / 64, nb = r % 64; transpose_item(F.in[20], D, WSP(bf16, WS_W4T), D, kb * 64, nb * 64, nb * 64, scr, F.lane); continue; } r -= I3;
        if (r < I4) { const int mat = r / 2048, q = r % 2048, kb = q / 32, nb = q % 32, n0 = nb * 64;
            const int drow0 = 256 * ((n0 & 1023) >> 7) + 128 * (n0 >> 10) + (n0 & 127);
            transpose_item(F.in[22] + (size_t)mat * D * 2048, 2048, WSP(bf16, WS_WGU) + (size_t)mat * 2048 * D, D, kb * 64, n0, drow0, scr, F.lane); continue; } r -= I4;
        if (r < I5) { const int mat = r / 1024, q = r % 1024, kb = q / 64, nb = q % 64;
            transpose_item(F.in[23] + (size_t)mat * DE * D, D, WSP(bf16, WS_WDN) + (size_t)mat * D * DE, DE, kb * 64, nb * 64, nb * 64, scr, F.lane); continue; } r -= I5;
        if (r < I6) { const int mat = r / 4, q = r % 4, kb = q / 2, nb = q % 2;
            transpose_item(F.in[11] + (size_t)mat * 16384, 128, WSP(bf16, WS_GWT) + (size_t)mat * 16384, 128, kb * 64, nb * 64, nb * 64, scr, F.lane); continue; } r -= I6;
        { const int mat = r / 64, q = r % 64, kb = q / 8, nb = q % 8;
            transpose_item(F.in[14] + (size_t)mat * 262144, 512, WSP(bf16, WS_PWT) + (size_t)mat * 262144, 512, kb * 64, nb * 64, nb * 64, scr, F.lane); }
    }
    const int gt = F.bid * NTHR + F.tid, NGT = F.G * NTHR;
    float* wrt = WSP(float, WS_WRT);
    for (int i = gt; i < 2 * 16 * 4096; i += NGT) { const int l = i >> 16, e = (i >> 12) & 15, k = i & 4095; wrt[i] = F.in[21][(size_t)l * 65536 + k * 16 + e]; }
    float* ls8 = WSP(float, WS_LS8);
    for (int i = gt; i < 2 * DLRU; i += NGT) ls8[i] = 8.0f * logsigmoidf_(F.in[13][i]);
}

__device__ __forceinline__ void p0_adaln(Frame& F) {
    LAS float* sc = (LAS float*)F.lds;
    LAS float* red = (LAS float*)(F.lds + 49152);
    constexpr int NIT = 2 * 384;
    if (F.bid >= NIT) return;
    for (int i = F.tid; i < 3 * D; i += NTHR) { const int r = i >> 12, k = i & 4095; const float v = r < 2 ? F.in[1][r * D + k] : F.in[3][k]; sc[i] = siluf_(v); }
    __syncthreads();
    float* mod = WSP(float, WS_MOD);
    for (int it = F.bid; it < NIT; it += F.G) {
        const int l = it / 384, n0 = (it % 384) * 64;
        const float* W = F.in[4] + (size_t)l * D * 24576 + n0 + F.lane;
        float a0 = 0.f, a1 = 0.f, a2 = 0.f;
        const int kbeg = F.wave * 512;
#pragma unroll 32
        for (int k = kbeg; k < kbeg + 512; ++k) { const float w = W[(size_t)k * 24576]; a0 += sc[k] * w; a1 += sc[D + k] * w; a2 += sc[2 * D + k] * w; }
        red[(F.wave * 3 + 0) * 64 + F.lane] = a0; red[(F.wave * 3 + 1) * 64 + F.lane] = a1; red[(F.wave * 3 + 2) * 64 + F.lane] = a2;
        __syncthreads();
        if (F.tid < 192) { const int r = F.tid >> 6, ln = F.tid & 63; float s = 0.f;
#pragma unroll
            for (int w = 0; w < 8; ++w) s += red[(w * 3 + r) * 64 + ln];
            mod[((size_t)l * 3 + r) * 24576 + n0 + ln] = s + F.in[5][l * 24576 + n0 + ln]; }
        __syncthreads();
    }
}

struct Row8 { f32x4 a[8], b[8]; };
__device__ __forceinline__ void ld_row8(Row8& r, const float* p, int lane) {
#pragma unroll
    for (int j = 0; j < 8; ++j) { const float* q = p + 8 * (lane + 64 * j); r.a[j] = *(const f32x4*)q; r.b[j] = *(const f32x4*)(q + 4); }
}
__device__ __forceinline__ void row8_stats(const Row8& r, float& mean, float& rstd) {
    float s = 0.f;
#pragma unroll
    for (int j = 0; j < 8; ++j) s += ((r.a[j].x + r.a[j].y) + (r.a[j].z + r.a[j].w)) + ((r.b[j].x + r.b[j].y) + (r.b[j].z + r.b[j].w));
    mean = wave_sum(s) * (1.f / D);
    float q = 0.f;
#pragma unroll
    for (int j = 0; j < 8; ++j) { const f32x4 d0 = r.a[j] - mean, d1 = r.b[j] - mean; q += ((d0.x * d0.x + d0.y * d0.y) + (d0.z * d0.z + d0.w * d0.w)) + ((d1.x * d1.x + d1.y * d1.y) + (d1.z * d1.z + d1.w * d1.w)); }
    rstd = 1.f / sqrtf(wave_sum(q) * (1.f / D) + LN_EPS);
}
__device__ __forceinline__ v4u pack8(const f32x4& a, const f32x4& b) { v4u o; o.x = pk2(a.x, a.y); o.y = pk2(a.z, a.w); o.z = pk2(b.x, b.y); o.w = pk2(b.z, b.w); return o; }
__device__ __forceinline__ int group_mod(int g) { return g < 512 ? 0 : (g < 1024 ? 1 : 2); }
__device__ __forceinline__ void stage_vec(LAS float* dst, const float* src, int n, int tid) { for (int i = tid * 4; i < n; i += NTHR * 4) *(LAS f32x4*)(dst + i) = *(const f32x4*)(src + i); }

__device__ __forceinline__ void p1_ln0(Frame& F) {
    float* H = WSP(float, WS_H); bf16* U = WSP(bf16, WS_U); const float* mod = WSP(float, WS_MOD);
    LAS float* SH = (LAS float*)F.lds; LAS float* SC = SH + D;
    int cur_mod = -1; Row8 cur, nxt;
    { const int g0 = F.bid; if (g0 < MT / 8) { const int row = 8 * g0 + F.wave; ld_row8(cur, row < ML ? F.in[0] + (size_t)row * D : F.in[2] + (size_t)(row - ML) * D, F.lane); } }
    for (int g = F.bid; g < MT / 8; g += F.G) {
        const int row = 8 * g + F.wave, mr = group_mod(g);
        if (mr != cur_mod) { __syncthreads(); stage_vec(SH, mod + (size_t)mr * 24576, D, F.tid); stage_vec(SC, mod + (size_t)mr * 24576 + D, D, F.tid); __syncthreads(); cur_mod = mr; }
        const int gn = g + F.G; if (gn < MT / 8) { const int rn = 8 * gn + F.wave; ld_row8(nxt, rn < ML ? F.in[0] + (size_t)rn * D : F.in[2] + (size_t)(rn - ML) * D, F.lane); }
        float mean, rstd; row8_stats(cur, mean, rstd);
#pragma unroll
        for (int j = 0; j < 8; ++j) { const int c = 8 * (F.lane + 64 * j); const f32x4 y0 = (cur.a[j] - mean) * rstd, y1 = (cur.b[j] - mean) * rstd;
            *(f32x4*)(H + (size_t)row * D + c) = y0; *(f32x4*)(H + (size_t)row * D + c + 4) = y1;
            const f32x4 u0 = y0 * (1.f + *(const LAS f32x4*)(SC + c)) + *(const LAS f32x4*)(SH + c), u1 = y1 * (1.f + *(const LAS f32x4*)(SC + c + 4)) + *(const LAS f32x4*)(SH + c + 4);
            *(v4u*)(U + (size_t)row * D + c) = pack8(u0, u1); }
        cur = nxt;
    }
    __syncthreads();
}

using pg8::Unit;
struct EpiBf16Plain {
    static constexpr bool PERM = true;
    bf16* O; int ldc;
    __device__ __forceinline__ void operator()(const f32x4 (&acc)[2][2][4][2], const Unit& u, int wr, int wc, int fr, int fq) const {
        const int row0 = u.pm * 256 + wr * 64 + fr, col0 = u.pn * 256 + wc * 32 + 8 * fq;
#pragma unroll
        for (int ai = 0; ai < 2; ++ai)
#pragma unroll
            for (int m = 0; m < 4; ++m) { bf16* rowp = O + (size_t)(row0 + ai * 128 + m * 16) * ldc + col0;
#pragma unroll
                for (int bj = 0; bj < 2; ++bj) { const f32x4 v0 = acc[ai][bj][m][0], v1 = acc[ai][bj][m][1];
                    v4u w; w.x = pg8::cvt_pk_bf16(v0[0], v0[1]); w.y = pg8::cvt_pk_bf16(v0[2], v0[3]); w.z = pg8::cvt_pk_bf16(v1[0], v1[1]); w.w = pg8::cvt_pk_bf16(v1[2], v1[3]);
                    *(v4u*)(rowp + bj * 128) = w; } }
    }
};
struct EpiOddIn {
    static constexpr bool PERM = true;
    bf16* O; float* Gt; const float* gb;
    __device__ __forceinline__ void operator()(const f32x4 (&acc)[2][2][4][2], const Unit& u, int wr, int wc, int fr, int fq) const {
        const int row0 = u.pm * 256 + wr * 64 + fr;
        if (u.pn < 48) {
            const int col0 = u.pn * 256 + wc * 32 + 8 * fq;
#pragma unroll
            for (int ai = 0; ai < 2; ++ai)
#pragma unroll
                for (int m = 0; m < 4; ++m) { bf16* rowp = O + (size_t)(row0 + ai * 128 + m * 16) * DIN1 + col0;
#pragma unroll
                    for (int bj = 0; bj < 2; ++bj) { const f32x4 v0 = acc[ai][bj][m][0], v1 = acc[ai][bj][m][1];
                        v4u w; w.x = pg8::cvt_pk_bf16(v0[0], v0[1]); w.y = pg8::cvt_pk_bf16(v0[2], v0[3]); w.z = pg8::cvt_pk_bf16(v1[0], v1[1]); w.w = pg8::cvt_pk_bf16(v1[2], v1[3]);
                        *(v4u*)(rowp + bj * 128) = w; } }
        } else if (wc == 0) {
            const int c0 = 8 * fq; const f32x4 b0 = *(const f32x4*)(gb + c0), b1 = *(const f32x4*)(gb + c0 + 4);
#pragma unroll
            for (int ai = 0; ai < 2; ++ai)
#pragma unroll
                for (int m = 0; m < 4; ++m) { float* rowp = Gt + (size_t)(row0 + ai * 128 + m * 16) * 32 + c0;
                    *(f32x4*)(rowp) = acc[ai][0][m][0] + b0; *(f32x4*)(rowp + 4) = acc[ai][0][m][1] + b1; }
        }
    }
};
struct EpiResid {
    static constexpr bool PERM = false;
    float* H; const float* modl;
    int goff;
    __device__ __forceinline__ void operator()(const f32x4 (&acc)[2][2][4][2], const Unit& u, int wr, int wc, int fr, int fq) const {
        const int row0 = u.pm * 256 + wr * 64 + fr, col0 = u.pn * 256 + wc * 32 + 4 * fq;
        const float* gv = modl + (size_t)row_mod(u.pm * 256) * 24576 + goff + col0;
        f32x4 g[2][2];
#pragma unroll
        for (int bj = 0; bj < 2; ++bj)
#pragma unroll
            for (int n = 0; n < 2; ++n) g[bj][n] = *(const f32x4*)(gv + bj * 128 + n * 16);
#pragma unroll
        for (int ai = 0; ai < 2; ++ai)
#pragma unroll
            for (int m = 0; m < 4; ++m) { float* rowp = H + (size_t)(row0 + ai * 128 + m * 16) * D + col0;
#pragma unroll
                for (int bj = 0; bj < 2; ++bj)
#pragma unroll
                    for (int n = 0; n < 2; ++n) { const f32x4 h = *(const f32x4*)(rowp + bj * 128 + n * 16); *(f32x4*)(rowp + bj * 128 + n * 16) = DN_ALPHA * h + g[bj][n] * acc[ai][bj][m][n]; }
                asm volatile("" ::: "memory"); }
    }
};
struct EpiPool {
    static constexpr bool PERM = true;
    bf16* A2; const float* ps;
    __device__ __forceinline__ void operator()(const f32x4 (&acc)[2][2][4][2], const Unit& u, int wr, int wc, int fr, int fq) const {
        const int row0 = u.pm * 256 + wr * 64 + fr, col0 = 512 * u.g + u.pn * 256 + wc * 32 + 8 * fq;
#pragma unroll
        for (int ai = 0; ai < 2; ++ai)
#pragma unroll
            for (int m = 0; m < 4; ++m) { bf16* rowp = A2 + (size_t)(row0 + ai * 128 + m * 16) * D + 2048 + col0;
#pragma unroll
                for (int bj = 0; bj < 2; ++bj) { const f32x4 s0 = *(const f32x4*)(ps + col0 + bj * 128), s1 = *(const f32x4*)(ps + col0 + bj * 128 + 4);
                    const f32x4 v0 = acc[ai][bj][m][0] * s0, v1 = acc[ai][bj][m][1] * s1;
                    v4u w; w.x = pg8::cvt_pk_bf16(v0[0], v0[1]); w.y = pg8::cvt_pk_bf16(v0[2], v0[3]); w.z = pg8::cvt_pk_bf16(v1[0], v1[1]); w.w = pg8::cvt_pk_bf16(v1[2], v1[3]);
                    *(v4u*)(rowp + bj * 128) = w; } }
    }
};
struct EpiGU {
    static constexpr bool PERM = true;
    bf16* ACT; int er;
    __device__ __forceinline__ void operator()(const f32x4 (&acc)[2][2][4][2], const Unit& u, int wr, int wc, int fr, int fq) const {
        const int row0 = u.pm * 256 + wr * 64 + fr, col0 = u.pn * 128 + wc * 32 + 8 * fq;
        bf16* base = ACT + (size_t)u.g * er * DE;
#pragma unroll
        for (int ai = 0; ai < 2; ++ai)
#pragma unroll
            for (int m = 0; m < 4; ++m) { bf16* rowp = base + (size_t)(row0 + ai * 128 + m * 16) * DE + col0;
                f32x4 v0, v1;
#pragma unroll
                for (int j = 0; j < 4; ++j) { v0[j] = siluf_(acc[ai][0][m][0][j]) * acc[ai][1][m][0][j]; v1[j] = siluf_(acc[ai][0][m][1][j]) * acc[ai][1][m][1][j]; }
                v4u w; w.x = pg8::cvt_pk_bf16(v0[0], v0[1]); w.y = pg8::cvt_pk_bf16(v0[2], v0[3]); w.z = pg8::cvt_pk_bf16(v1[0], v1[1]); w.w = pg8::cvt_pk_bf16(v1[2], v1[3]);
                *(v4u*)(rowp) = w; }
    }
};
struct EpiDown {
    static constexpr bool PERM = true;
    bf16* YE; const float* GX; int er;
    __device__ __forceinline__ void operator()(const f32x4 (&acc)[2][2][4][2], const Unit& u, int wr, int wc, int fr, int fq) const {
        const int row0 = u.pm * 256 + wr * 64 + fr, col0 = u.pn * 256 + wc * 32 + 8 * fq;
        bf16* base = YE + (size_t)u.g * er * D; const float* gx = GX + u.g * er;
#pragma unroll
        for (int ai = 0; ai < 2; ++ai)
#pragma unroll
            for (int m = 0; m < 4; ++m) { const int row = row0 + ai * 128 + m * 16; const float s = gx[row]; bf16* rowp = base + (size_t)row * D + col0;
#pragma unroll
                for (int bj = 0; bj < 2; ++bj) { const f32x4 v0 = acc[ai][bj][m][0] * s, v1 = acc[ai][bj][m][1] * s;
                    v4u w; w.x = pg8::cvt_pk_bf16(v0[0], v0[1]); w.y = pg8::cvt_pk_bf16(v0[2], v0[3]); w.z = pg8::cvt_pk_bf16(v1[0], v1[1]); w.w = pg8::cvt_pk_bf16(v1[2], v1[3]);
                    *(v4u*)(rowp + bj * 128) = w; } }
    }
};
constexpr int LRU_XC = 0, LRU_AF = 17408, LRU_BF = 50176, LRU_HF = 82944, LRU_SG = 115712;
template <bool APPLY>
__device__ __forceinline__ void lru_phase(Frame& F) {
    const bf16* XZS = WSP(bf16, WS_BIG);
    const bf16* GWT = WSP(bf16, WS_GWT);
    const float* LS8 = WSP(float, WS_LS8);
    float* SUMM = WSP(float, WS_SUMM); const float* CARRY = WSP(float, WS_CARRY);
    bf16* A2 = WSP(bf16, WS_A2);
    const float* convw = F.in[9]; const float* convb = F.in[10]; const float* gateb = F.in[12];
    const int wr = F.wave >> 2, wc = F.wave & 3, fr = F.lane & 15, fq = F.lane >> 4;
    LAS unsigned char* XC = F.lds + LRU_XC; LAS float* AF = (LAS float*)(F.lds + LRU_AF); LAS float* BF = (LAS float*)(F.lds + LRU_BF); LAS float* HF = (LAS float*)(F.lds + LRU_HF); LAS float* SG = (LAS float*)(F.lds + LRU_SG);
    for (int unit = F.bid; unit < NT_TILES * LRUH; unit += F.G) {
        const int tt = unit >> 4, h = unit & 15;
        const int r0 = tile_row0(tt); int slo, shi; tile_seq(tt, slo, shi);
        f32x4 xcv[2][2];
#pragma unroll
        for (int m = 0; m < 2; ++m)
#pragma unroll
            for (int n = 0; n < 2; ++n) {
                const int t = 32 * wr + 16 * m + fr, c = 32 * wc + 16 * n + 4 * fq, ch = h * 128 + c;
                f32x4 a = *(const f32x4*)(convb + ch);
#pragma unroll
                for (int j = 0; j < 4; ++j) { const int row = r0 + t + j - 1; const bool okr = row >= slo && row < shi;
                    const v2u xv = *(const v2u*)(XZS + (size_t)(okr ? row : r0 + t) * DIN0 + ch); f32x4 w = *(const f32x4*)(convw + j * DLRU + ch); if (!okr) w = (f32x4){0.f, 0.f, 0.f, 0.f};
                    a.x += w.x * bflo(xv.x); a.y += w.y * bfhi(xv.x); a.z += w.z * bflo(xv.y); a.w += w.w * bfhi(xv.y); }
                xcv[m][n] = a;
                v2u o; o.x = pk2(a.x, a.y); o.y = pk2(a.z, a.w); *(LAS v2u*)(XC + t * 272 + c * 2) = o;
            }
        __syncthreads();
#pragma unroll 1
        for (int d = 0; d < 2; ++d) {
            f32x4 acc[2][2][2];
#pragma unroll
            for (int g = 0; g < 2; ++g)
#pragma unroll
                for (int m = 0; m < 2; ++m)
#pragma unroll
                    for (int n = 0; n < 2; ++n) acc[g][m][n] = (f32x4){0.f, 0.f, 0.f, 0.f};
#pragma unroll
            for (int ks = 0; ks < 4; ++ks) {
                bf16x8 af[2];
#pragma unroll
                for (int m = 0; m < 2; ++m) af[m] = *(const LAS bf16x8*)(XC + (32 * wr + 16 * m + fr) * 272 + (ks * 32 + fq * 8) * 2);
#pragma unroll
                for (int g = 0; g < 2; ++g)
#pragma unroll
                    for (int n = 0; n < 2; ++n) { const bf16x8 bfv = *(const bf16x8*)(GWT + (size_t)((d * 2 + g) * 16 + h) * 16384 + (32 * wc + 16 * n + fr) * 128 + ks * 32 + fq * 8);
#pragma unroll
                        for (int m = 0; m < 2; ++m) acc[g][m][n] = __builtin_amdgcn_mfma_f32_16x16x32_bf16(bfv, af[m], acc[g][m][n], 0, 0, 0); }
            }
#pragma unroll
            for (int m = 0; m < 2; ++m)
#pragma unroll
                for (int n = 0; n < 2; ++n) {
                    const int t = 32 * wr + 16 * m + fr, c = 32 * wc + 16 * n + 4 * fq, ch = h * 128 + c;
                    const f32x4 b0 = *(const f32x4*)(gateb + (d * 2 + 0) * DLRU + ch), b1 = *(const f32x4*)(gateb + (d * 2 + 1) * DLRU + ch), l8 = *(const f32x4*)(LS8 + d * DLRU + ch);
                    f32x4 av, bv;
#pragma unroll
                    for (int j = 0; j < 4; ++j) { const float r = sigmoidf_(acc[0][m][n][j] + b0[j]), ig = sigmoidf_(acc[1][m][n][j] + b1[j]);
                        const float la = l8[j] * r, em1 = expm1_small(la); av[j] = 1.f + em1; bv[j] = __builtin_amdgcn_sqrtf(-em1 * (2.f + em1)) * ig * xcv[m][n][j]; }
                    *(LAS f32x4*)(AF + t * 128 + c) = av; *(LAS f32x4*)(BF + t * 128 + c) = bv;
                }
            __syncthreads();
            {
                const int c = F.tid & 127, seg = F.tid >> 7, ch = h * 128 + c;
                const int tb = d == 0 ? 16 * seg : 16 * seg + 15, ts = d == 0 ? 1 : -1;
                float hs = 0.f, P = 1.f;
#pragma unroll
                for (int i = 0; i < 16; ++i) { const int t = tb + ts * i; const float a = AF[t * 128 + c]; hs = a * hs + BF[t * 128 + c]; P *= a; }
                SG[(seg * 2 + 0) * 128 + c] = P; SG[(seg * 2 + 1) * 128 + c] = hs;
                __syncthreads();
                if (!APPLY) {
                    if (seg == 0) { float Pt = 1.f, Ht = 0.f;
#pragma unroll
                        for (int q = 0; q < 4; ++q) { const int sgi = d == 0 ? q : 3 - q; const float Pq = SG[(sgi * 2 + 0) * 128 + c]; Ht = Pq * Ht + SG[(sgi * 2 + 1) * 128 + c]; Pt *= Pq; }
                        SUMM[((size_t)(tt * 2 + d) * 2 + 0) * DLRU + ch] = Pt; SUMM[((size_t)(tt * 2 + d) * 2 + 1) * DLRU + ch] = Ht; }
                } else {
                    float cin = CARRY[(size_t)(tt * 2 + d) * DLRU + ch];
#pragma unroll
                    for (int q = 0; q < 3; ++q) { const int sgi = d == 0 ? q : 3 - q; const bool before = d == 0 ? (sgi < seg) : (sgi > seg);
                        if (before) cin = SG[(sgi * 2 + 0) * 128 + c] * cin + SG[(sgi * 2 + 1) * 128 + c]; }
                    hs = cin;
#pragma unroll
                    for (int i = 0; i < 16; ++i) { const int t = tb + ts * i; hs = AF[t * 128 + c] * hs + BF[t * 128 + c];
                        if (d == 0) HF[t * 128 + c] = hs; else HF[t * 128 + c] += hs; }
                }
            }
            __syncthreads();
        }
        if (APPLY) {
            const int t = F.tid >> 3, cg = (F.tid & 7) * 16; const size_t row = (size_t)(r0 + t);
            const v4u* zp = (const v4u*)(XZS + row * DIN0 + DLRU + h * 128 + cg); v4u* op = (v4u*)(A2 + row * D + h * 128 + cg);
#pragma unroll
            for (int i = 0; i < 2; ++i) { const v4u z = zp[i]; v4u o;
#pragma unroll
                for (int k = 0; k < 4; ++k) { const int cc = cg + i * 8 + 2 * k; o[k] = pk2(HF[t * 128 + cc] * gelu_tanh(bflo(z[k])), HF[t * 128 + cc + 1] * gelu_tanh(bfhi(z[k]))); }
                op[i] = o; }
            __syncthreads();
        }
    }
}

__device__ __forceinline__ void lru_carry(Frame& F) {
    const float* SUMM = WSP(float, WS_SUMM); float* CARRY = WSP(float, WS_CARRY);
    const int gt = F.bid * NTHR + F.tid, NGT = F.G * NTHR;
    for (int i = gt; i < NB * 2 * DLRU; i += NGT) {
        const int ch = i & 2047, d = (i >> 11) & 1, b = i >> 12;
        float st = 0.f;
#pragma unroll 1
        for (int half = 0; half < 2; ++half) {
            float Pv[34], Hv[34];
#pragma unroll
            for (int q = 0; q < 34; ++q) { const int s = half * 34 + q; const int tt = s < 4 ? 128 + 4 * b + (d ? 3 - s : s) : 64 * b + (d ? 63 - (s - 4) : (s - 4));
                Pv[q] = SUMM[((size_t)(tt * 2 + d) * 2 + 0) * DLRU + ch]; Hv[q] = SUMM[((size_t)(tt * 2 + d) * 2 + 1) * DLRU + ch]; }
#pragma unroll
            for (int q = 0; q < 34; ++q) { const int s = half * 34 + q; const int tt = s < 4 ? 128 + 4 * b + (d ? 3 - s : s) : 64 * b + (d ? 63 - (s - 4) : (s - 4));
                CARRY[(size_t)(tt * 2 + d) * DLRU + ch] = st; st = Pv[q] * st + Hv[q]; }
        }
    }
}

__device__ __forceinline__ int pool_w_of(int g) { return 2 << g; }
__device__ __forceinline__ void pool_pass1(Frame& F) {
    const bf16* XZS = WSP(bf16, WS_BIG); float* CM = WSP(float, WS_CM);
    LAS unsigned char* T = F.lds;
    for (int unit = F.bid; unit < NB * 64 * 4; unit += F.G) {
        const int g = unit & 3, gr = (unit >> 2) & 63, b = unit >> 8; const int row0 = b * SEQ + gr * 64, w = pool_w_of(g);
        for (int i = F.tid; i < 64 * 64; i += NTHR) { const int r = i >> 6, cseg = i & 63;
            *(LAS v4u*)(T + r * 1024 + cseg * 16) = *(const v4u*)(XZS + (size_t)(row0 + r) * DIN0 + 2 * DLRU + g * 512 + cseg * 8); }
        __syncthreads();
        const int cp = F.tid & 255, half = F.tid >> 8;
        for (int j = half * 32; j < half * 32 + 32; ++j) {
            const int lo = max(0, j - w / 2), hi = min(64, j + w - w / 2);
            float s0 = 0.f, s1 = 0.f;
            for (int q = lo; q < hi; ++q) { const unsigned v = *(const LAS unsigned*)(T + q * 1024 + cp * 4); s0 += bflo(v); s1 += bfhi(v); }
            const float inv = 1.f / (float)(hi - lo);
            *(f32x2*)(CM + (size_t)(row0 + j) * DPOOL + g * 512 + 2 * cp) = (f32x2){s0 * inv, s1 * inv};
        }
        __syncthreads();
    }
}
__device__ __forceinline__ void pool_pass2(Frame& F) {
    const bf16* XZS = WSP(bf16, WS_BIG); const float* CM = WSP(float, WS_CM); bf16* DP = WSP(bf16, WS_DP);
    LAS float* T = (LAS float*)F.lds;
    for (int unit = F.bid; unit < NB * 64 * 4 * 2; unit += F.G) {
        const int hc = unit & 1, g = (unit >> 1) & 3, gc = (unit >> 3) & 63, b = unit >> 9; const int w = pool_w_of(g), cb = g * 512 + hc * 256;
        for (int i = F.tid; i < 64 * 64; i += NTHR) { const int r = i >> 6, cseg = i & 63;
            *(LAS f32x4*)(T + r * 256 + cseg * 4) = *(const f32x4*)(CM + (size_t)(b * SEQ + r * 64 + gc) * DPOOL + cb + cseg * 4); }
        __syncthreads();
        const int c = F.tid & 255, half = F.tid >> 8;
        float xs[32];
#pragma unroll
        for (int q = 0; q < 32; ++q) xs[q] = bf2f(XZS[(size_t)(b * SEQ + (half * 32 + q) * 64 + gc) * DIN0 + 2 * DLRU + cb + c]);
#pragma unroll
        for (int q = 0; q < 32; ++q) { const int r = half * 32 + q;
            const int lo = max(0, r - w / 2), hi = min(64, r + w - w / 2);
            float sm = 0.f;
            for (int k = lo; k < hi; ++k) sm += T[k * 256 + c];
            DP[(size_t)(b * SEQ + r * 64 + gc) * DPOOL + cb + c] = (bf16)f2bf(sm / (float)(hi - lo) - xs[q]);
        }
        __syncthreads();
    }
}
__device__ __forceinline__ void pool_ctx(Frame& F) {
    const bf16* XZS = WSP(bf16, WS_BIG); bf16* DP = WSP(bf16, WS_DP);
    const int gt = F.bid * NTHR + F.tid, NGT = F.G * NTHR;
    for (int i = gt; i < MC * DPOOL; i += NGT) {
        const int ch = i & 2047, r = i >> 11, b = r >> 8, t = r & 255; const int w = pool_w_of(ch >> 9);
        const int lo = max(0, t - w / 2), hi = min(CTXL, t + w - w / 2);
        float v[16];
#pragma unroll
        for (int q = 0; q < 16; ++q) { const int k = min(lo + q, CTXL - 1); v[q] = bf2f(XZS[(size_t)(ML + b * CTXL + k) * DIN0 + 2 * DLRU + ch]); }
        const float x = bf2f(XZS[(size_t)(ML + r) * DIN0 + 2 * DLRU + ch]);
        float sm = 0.f;
#pragma unroll
        for (int q = 0; q < 16; ++q) sm += (lo + q < hi) ? v[q] : 0.f;
        DP[(size_t)(ML + r) * DPOOL + ch] = (bf16)f2bf(sm / (float)(hi - lo) - x);
    }
}
__device__ __forceinline__ void ln_router_phase(Frame& F, int l, int nrows, bool probe = false) {
    const float* Hin = WSP(float, WS_H); float* H = probe ? WSP(float, WS_XE) : WSP(float, WS_H); bf16* U = probe ? WSP(bf16, WS_YE) : WSP(bf16, WS_U); const float* mod = WSP(float, WS_MOD) + (size_t)l * 3 * 24576;
    const f32x4* wrt4 = (const f32x4*)(WSP(float, WS_WRT) + (size_t)l * 16 * D); float* AFF = probe ? WSP(float, WS_CM) : WSP(float, WS_AFF);
    LAS float* LG = (LAS float*)F.lds; LAS float* LB = LG + D; LAS float* SH = LG + 2 * D; LAS float* SC = LG + 3 * D; LAS f32x4* WL = (LAS f32x4*)(F.lds + 65536);
    const int ngroups = nrows / 8;
    stage_vec(LG, F.in[6] + (size_t)(l * 2 + 0) * D, D, F.tid); stage_vec(LB, F.in[7] + (size_t)(l * 2 + 0) * D, D, F.tid);
    int cur_mod = -1; Row8 cur, nxt;
    if (F.bid < ngroups) ld_row8(cur, Hin + (size_t)(8 * F.bid + F.wave) * D, F.lane);
    for (int g = F.bid; g < ngroups; g += F.G) {
        const int row = 8 * g + F.wave, mr = group_mod(g);
        if (mr != cur_mod) { __syncthreads(); stage_vec(SH, mod + (size_t)mr * 24576 + 3 * D, D, F.tid); stage_vec(SC, mod + (size_t)mr * 24576 + 4 * D, D, F.tid); cur_mod = mr; }
        __syncthreads();
        const int gn = g + F.G; if (gn < ngroups) ld_row8(nxt, Hin + (size_t)(8 * gn + F.wave) * D, F.lane);
        float mean, rstd; row8_stats(cur, mean, rstd);
#pragma unroll
        for (int j = 0; j < 8; ++j) { const int c = 8 * (F.lane + 64 * j);
            const f32x4 y0 = (cur.a[j] - mean) * rstd * *(const LAS f32x4*)(LG + c) + *(const LAS f32x4*)(LB + c), y1 = (cur.b[j] - mean) * rstd * *(const LAS f32x4*)(LG + c + 4) + *(const LAS f32x4*)(LB + c + 4);
            *(f32x4*)(H + (size_t)row * D + c) = y0; *(f32x4*)(H + (size_t)row * D + c + 4) = y1;
            const f32x4 u0 = y0 * (1.f + *(const LAS f32x4*)(SC + c)) + *(const LAS f32x4*)(SH + c), u1 = y1 * (1.f + *(const LAS f32x4*)(SC + c + 4)) + *(const LAS f32x4*)(SH + c + 4);
            *(v4u*)(U + (size_t)row * D + c) = pack8(u0, u1);
            cur.a[j] = u0; cur.b[j] = u1; }
        float lgt[16];
#pragma unroll
        for (int e = 0; e < 16; ++e) lgt[e] = 0.f;
#pragma unroll 1
        for (int c = 0; c < 4; ++c) {
            __syncthreads();
            for (int i = F.tid; i < 4096; i += NTHR) WL[i] = wrt4[(i >> 8) * 1024 + c * 256 + (i & 255)];
            f32x4 x0, x1, x2, x3;
            if (c == 0) { x0 = cur.a[0]; x1 = cur.b[0]; x2 = cur.a[1]; x3 = cur.b[1]; } else if (c == 1) { x0 = cur.a[2]; x1 = cur.b[2]; x2 = cur.a[3]; x3 = cur.b[3]; }
            else if (c == 2) { x0 = cur.a[4]; x1 = cur.b[4]; x2 = cur.a[5]; x3 = cur.b[5]; } else { x0 = cur.a[6]; x1 = cur.b[6]; x2 = cur.a[7]; x3 = cur.b[7]; }
            __syncthreads();
#pragma unroll
            for (int e = 0; e < 16; ++e) { const LAS f32x4* wp = WL + e * 256 + 2 * F.lane; const f32x4 w0 = wp[0], w1 = wp[1], w2 = wp[128], w3 = wp[129];
                lgt[e] += ((x0.x * w0.x + x0.y * w0.y) + (x0.z * w0.z + x0.w * w0.w)) + ((x1.x * w1.x + x1.y * w1.y) + (x1.z * w1.z + x1.w * w1.w))
                        + ((x2.x * w2.x + x2.y * w2.y) + (x2.z * w2.z + x2.w * w2.w)) + ((x3.x * w3.x + x3.y * w3.y) + (x3.z * w3.z + x3.w * w3.w)); }
        }
        float mylogit = 0.f;
#pragma unroll
        for (int e = 0; e < 16; ++e) { const float sfull = wave_sum(lgt[e]); if (F.lane == e) mylogit = sfull; }
        float v = F.lane < 16 ? mylogit : -3.0e38f;
        const float mx = wave_max(v); const float ex = F.lane < 16 ? __expf(v - mx) : 0.f; const float den = wave_sum(ex);
        if (F.lane < 16) { int sq, n; if (row < ML) { sq = row >> 12; n = row & 4095; } else { sq = 2 + ((row - ML) >> 8); n = (row - ML) & 255; }
            AFF[((size_t)sq * 16 + F.lane) * SEQ + n] = ex / den; }
        cur = nxt;
    }
    __syncthreads();
}

__device__ __forceinline__ void topk_phase(Frame& F, int nseq, int er) {
    const float* AFF = WSP(float, WS_AFF); int* XR = WSP(int, WS_IDX); float* GX = WSP(float, WS_GX); int* INV = WSP(int, WS_INV);
    LAS unsigned long long* key = (LAS unsigned long long*)F.lds;
    for (int p = F.bid; p < nseq * 16; p += F.G) {
        const int s = p >> 4, e = p & 15, n = seq_len(s), cap = n >> 3;
        for (int i = F.tid; i < n; i += NTHR) { const float a = AFF[((size_t)s * 16 + e) * SEQ + i]; key[i] = ((unsigned long long)__builtin_bit_cast(unsigned, a) << 32) | (unsigned long long)(0xFFFFFFFFu - (unsigned)i); }
        __syncthreads();
        for (int k = 2; k <= n; k <<= 1)
            for (int j = k >> 1; j > 0; j >>= 1) {
                for (int i = F.tid; i < n; i += NTHR) { const int ixj = i ^ j;
                    if (ixj > i) { const unsigned long long a = key[i], b = key[ixj]; const bool desc = (i & k) == 0;
                        if (desc ? (a < b) : (a > b)) { key[i] = b; key[ixj] = a; } } }
                __syncthreads();
            }
        const int rbase = seq_row0(s), sb = s == 0 ? 0 : (s == 1 ? 512 : (s == 2 ? 1024 : 1056));
        for (int i = F.tid; i < n; i += NTHR) { const unsigned long long kk = key[i]; const int tok = (int)(0xFFFFFFFFu - (unsigned)(kk & 0xFFFFFFFFull));
            if (i < cap) { XR[e * er + sb + i] = rbase + tok; GX[e * er + sb + i] = __builtin_bit_cast(float, (unsigned)(kk >> 32)); }
            INV[(size_t)(rbase + tok) * 16 + e] = i < cap ? i : -1; }
        if (s == 3) for (int i = 1088 + F.tid; i < er; i += NTHR) { XR[e * er + i] = 0; GX[e * er + i] = 0.f; }
        __syncthreads();
    }
}

__device__ __forceinline__ int slot_base(int s) { return s == 0 ? 0 : (s == 1 ? 512 : (s == 2 ? 1024 : 1056)); }

template <bool LAST>
__device__ __forceinline__ void combine_phase(Frame& F, int l, int nrows, int er, bool probe = false) {
    const float* Hin = WSP(float, WS_H); float* H = probe ? WSP(float, WS_XE) : WSP(float, WS_H); bf16* U = probe ? WSP(bf16, WS_A2) : WSP(bf16, WS_U); const float* mod = WSP(float, WS_MOD) + (size_t)l * 3 * 24576; const float* modn = WSP(float, WS_MOD) + (size_t)(l + 1) * 3 * 24576;
    const bf16* YE = WSP(bf16, WS_YE); const int* INV = WSP(int, WS_INV);
    LAS float* LG = (LAS float*)F.lds; LAS float* LB = LG + D; LAS float* G2 = LG + 2 * D; LAS float* SH = LG + 3 * D; LAS float* SC = LG + 4 * D;
    const int ngroups = nrows / 8;
    stage_vec(LG, F.in[6] + (size_t)(l * 2 + 1) * D, D, F.tid); stage_vec(LB, F.in[7] + (size_t)(l * 2 + 1) * D, D, F.tid);
    int cur_mod = -1; Row8 cur, nxt; int slot_c = -1, slot_n = -1;
    if (F.bid < ngroups) { const int row = 8 * F.bid + F.wave; ld_row8(cur, Hin + (size_t)row * D, F.lane); slot_c = INV[(size_t)row * 16 + (F.lane & 15)]; }
    for (int g = F.bid; g < ngroups; g += F.G) {
        const int row = 8 * g + F.wave, mr = group_mod(g);
        if (mr != cur_mod) { __syncthreads(); stage_vec(G2, mod + (size_t)mr * 24576 + 5 * D, D, F.tid);
            if (!LAST) { stage_vec(SH, modn + (size_t)mr * 24576, D, F.tid); stage_vec(SC, modn + (size_t)mr * 24576 + D, D, F.tid); }
            __syncthreads(); cur_mod = mr; }
        const int gn = g + F.G; const int rn = 8 * gn + F.wave; if (gn < ngroups) slot_n = INV[(size_t)rn * 16 + (F.lane & 15)];
#pragma unroll
        for (int j = 0; j < 8; ++j) { cur.a[j] = cur.a[j] * DN_ALPHA; cur.b[j] = cur.b[j] * DN_ALPHA; }
        const int sq = row < ML ? (row >> 12) : 2 + ((row - ML) >> 8); const int sb = slot_base(sq);
        unsigned long long mask = __ballot(slot_c >= 0) & 0xFFFFull;
        while (mask) {
            const int e = __builtin_ctzll(mask); mask &= mask - 1;
            const int slot = __shfl(slot_c, e);
            const bf16* y = YE + ((size_t)e * er + sb + slot) * D;
#pragma unroll
            for (int jh = 0; jh < 8; jh += 2) {
                v4u yv[2];
#pragma unroll
                for (int j = 0; j < 2; ++j) yv[j] = *(const v4u*)(y + 8 * (F.lane + 64 * (jh + j)));
#pragma unroll
                for (int j = 0; j < 2; ++j) { const int c = 8 * (F.lane + 64 * (jh + j)); const f32x4 g0 = *(const LAS f32x4*)(G2 + c), g1 = *(const LAS f32x4*)(G2 + c + 4);
                    cur.a[jh + j] += g0 * (f32x4){bflo(yv[j].x), bfhi(yv[j].x), bflo(yv[j].y), bfhi(yv[j].y)}; cur.b[jh + j] += g1 * (f32x4){bflo(yv[j].z), bfhi(yv[j].z), bflo(yv[j].w), bfhi(yv[j].w)}; }
            }
        }
        if (gn < ngroups) ld_row8(nxt, Hin + (size_t)rn * D, F.lane);
        float mean, rstd; row8_stats(cur, mean, rstd);
#pragma unroll
        for (int j = 0; j < 8; ++j) { const int c = 8 * (F.lane + 64 * j);
            const f32x4 y0 = (cur.a[j] - mean) * rstd * *(const LAS f32x4*)(LG + c) + *(const LAS f32x4*)(LB + c), y1 = (cur.b[j] - mean) * rstd * *(const LAS f32x4*)(LG + c + 4) + *(const LAS f32x4*)(LB + c + 4);
            if (LAST) { *(f32x4*)(F.out + (size_t)row * D + c) = y0; *(f32x4*)(F.out + (size_t)row * D + c + 4) = y1; }
            else { *(f32x4*)(H + (size_t)row * D + c) = y0; *(f32x4*)(H + (size_t)row * D + c + 4) = y1;
                const f32x4 u0 = y0 * (1.f + *(const LAS f32x4*)(SC + c)) + *(const LAS f32x4*)(SH + c), u1 = y1 * (1.f + *(const LAS f32x4*)(SC + c + 4)) + *(const LAS f32x4*)(SH + c + 4);
                *(v4u*)(U + (size_t)row * D + c) = pack8(u0, u1); }
            asm volatile("" ::: "memory"); }
        cur = nxt; slot_c = slot_n;
    }
    __syncthreads();
}
typedef short v4i16_t __attribute__((ext_vector_type(4)));
__device__ __forceinline__ bf16x8 row_frag(const LAS unsigned char* T, int stride, int r0, int k0, int fr, int fq) { return *(const LAS bf16x8*)(T + (r0 + fr) * stride + (k0 + fq * 8) * 2); }
__device__ __forceinline__ bf16x8 tr_frag(const LAS unsigned char* T, int stride, int k0, int n0, int fr, int fq) {
    const LAS unsigned char* p0 = T + (k0 + 8 * fq + (fr >> 2)) * stride + n0 * 2 + 8 * (fr & 3);
    const v4i16_t lo = __builtin_amdgcn_ds_read_tr16_b64_v4i16((LAS v4i16_t*)p0);
    const v4i16_t hi = __builtin_amdgcn_ds_read_tr16_b64_v4i16((LAS v4i16_t*)(p0 + 4 * stride));
    return (bf16x8){lo[0], lo[1], lo[2], lo[3], hi[0], hi[1], hi[2], hi[3]};
}
#define MFMA16(a, b, c) __builtin_amdgcn_mfma_f32_16x16x32_bf16((a), (b), (c), 0, 0, 0)
constexpr int ML_QS = 0, ML_KS = 33792, ML_VS = 67584, ML_VW = 76800, ML_SP = 86016, ML_CT = 95232, ML_SM = 129024;
constexpr int SM_A = 0, SM_ROWC = 64, SM_EINT = 128, SM_LOW = 192, SM_W = 256, SM_DEN4 = 320, SM_QN = 576, SM_NST = 640, SM_SCAL = 896;
__device__ __forceinline__ v4u scale_bf16x8(v4u v, float s) {
    v4u o;
#pragma unroll
    for (int i = 0; i < 4; ++i) { const unsigned w = v[i]; o[i] = pk2(bflo(w) * s, bfhi(w) * s); }
    return o;
}
__device__ __forceinline__ float mlstm_scalars(LAS float* SM, float ig, float fp, float m_prev, int lane) {
    float bc = logsigmoidf_(fp);
#pragma unroll
    for (int o = 1; o < 64; o <<= 1) { const float t = __shfl_up(bc, o); if (lane >= o) bc += t; }
    const float a = ig - bc; float pm = a;
#pragma unroll
    for (int o = 1; o < 64; o <<= 1) { const float t = __shfl_up(pm, o); if (lane >= o) pm = fmaxf(pm, t); }
    const float mcomb = bc + fmaxf(m_prev, pm);
    const float bend = __shfl(bc, 63), pm63 = __shfl(pm, 63);
    const float m_new = fmaxf(bend + m_prev, bend + pm63);
    SM[SM_A + lane] = a; SM[SM_ROWC + lane] = bc - mcomb; SM[SM_EINT + lane] = __expf(bc + m_prev - mcomb); SM[SM_LOW + lane] = __expf(-mcomb);
    SM[SM_W + lane] = __expf(bend + a - m_new);
    if (lane == 0) SM[SM_SCAL + 0] = __expf(bend + m_prev - m_new);
    return m_new;
}
__device__ __forceinline__ int mlstm_base(int step, int b, int d) { return step < 4 ? ML + b * CTXL + 64 * (d ? 3 - step : step) : b * SEQ + 64 * (d ? 63 - (step - 4) : (step - 4)); }
__device__ __forceinline__ void mlstm_phase(Frame& F) {
    const bf16* QKVO = WSP(bf16, WS_BIG); const float* Gt = WSP(float, WS_G); bf16* HD = WSP(bf16, WS_HD);
    LAS unsigned char* QS = F.lds + ML_QS; LAS unsigned char* KS = F.lds + ML_KS; LAS unsigned char* VS = F.lds + ML_VS; LAS unsigned char* VW = F.lds + ML_VW;
    LAS unsigned char* SP = F.lds + ML_SP; LAS unsigned char* CT = F.lds + ML_CT; LAS float* SM = (LAS float*)(F.lds + ML_SM);
    const int wr = F.wave >> 2, wc = F.wave & 3, fr = F.lane & 15, fq = F.lane >> 4, tid = F.tid;
    for (int unit = F.bid; unit < 256; unit += F.G) {
        const int x = unit & 7, y = unit >> 3; const int combo = x + 8 * (y >> 3), jv = y & 7;
        const int b = combo >> 4, h = (combo >> 1) & 7, d = combo & 1;
        f32x4 accC[2][4];
#pragma unroll
        for (int m = 0; m < 2; ++m)
#pragma unroll
            for (int n = 0; n < 4; ++n) accC[m][n] = (f32x4){0.f, 0.f, 0.f, 0.f};
        float n_reg = 0.f, m_run = 0.f;
        v4u kq[4], qq[4], vv; float g_i = 0.f, g_f = 0.f;
        {
            const int base = mlstm_base(0, b, d);
#pragma unroll
            for (int i = 0; i < 4; ++i) { const int q = tid + 512 * i, r = q >> 5, cs = q & 31; const size_t row = (size_t)(base + (d ? 63 - r : r));
                kq[i] = *(const v4u*)(QKVO + row * DIN1 + 2048 + h * DQK + cs * 8); qq[i] = (v4u){0u, 0u, 0u, 0u}; }
            { const int r = tid >> 3, cs = tid & 7; const size_t row = (size_t)(base + (d ? 63 - r : r)); vv = *(const v4u*)(QKVO + row * DIN1 + 4096 + h * DV + jv * 64 + cs * 8); }
            if (F.wave == 0) { const int row = base + (d ? 63 - F.lane : F.lane); g_i = Gt[(size_t)row * 32 + d * 16 + h]; g_f = Gt[(size_t)row * 32 + d * 16 + 8 + h];
                m_run = mlstm_scalars(SM, g_i, g_f, 0.f, F.lane); }
            if (tid < 256) SM[SM_NST + tid] = 0.f;
        }
#pragma unroll 1
        for (int step = 0; step < 68; ++step) {
            const bool lat = step >= 4;
            const int base = mlstm_base(step, b, d);
#pragma unroll
            for (int i = 0; i < 4; ++i) { const int q = tid + 512 * i, r = q >> 5, cs = q & 31;
                *(LAS v4u*)(KS + r * 528 + cs * 16) = kq[i];
                if (lat) *(LAS v4u*)(QS + r * 528 + cs * 16) = scale_bf16x8(qq[i], 0.0625f); }
            *(LAS v4u*)(VS + (tid >> 3) * 144 + (tid & 7) * 16) = vv;
            __syncthreads();
            const float decay = SM[SM_SCAL + 0];
            *(LAS v4u*)(VW + (tid >> 3) * 144 + (tid & 7) * 16) = scale_bf16x8(vv, SM[SM_W + (tid >> 3)]);
            if (step < 67) {
                const int nb = mlstm_base(step + 1, b, d); const bool nlat = step + 1 >= 4;
#pragma unroll
                for (int i = 0; i < 4; ++i) { const int q = tid + 512 * i, r = q >> 5, cs = q & 31; const size_t row = (size_t)(nb + (d ? 63 - r : r));
                    kq[i] = *(const v4u*)(QKVO + row * DIN1 + 2048 + h * DQK + cs * 8);
                    if (nlat) qq[i] = *(const v4u*)(QKVO + row * DIN1 + h * DQK + cs * 8); }
                { const int r = tid >> 3, cs = tid & 7; const size_t row = (size_t)(nb + (d ? 63 - r : r)); vv = *(const v4u*)(QKVO + row * DIN1 + 4096 + h * DV + jv * 64 + cs * 8); }
                if (F.wave == 0) { const int row = nb + (d ? 63 - F.lane : F.lane); g_i = Gt[(size_t)row * 32 + d * 16 + h]; g_f = Gt[(size_t)row * 32 + d * 16 + 8 + h]; }
            }
            if (lat) {
                {
                    const int t = tid >> 3, part = tid & 7; float s = 0.f;
#pragma unroll
                    for (int i = 0; i < 4; ++i) { const v4u xq = *(const LAS v4u*)(QS + t * 528 + (part * 32 + i * 8) * 2);
#pragma unroll
                        for (int k = 0; k < 4; ++k) s += bflo(xq[k]) * SM[SM_NST + part * 32 + i * 8 + 2 * k] + bfhi(xq[k]) * SM[SM_NST + part * 32 + i * 8 + 2 * k + 1]; }
                    s += __shfl_xor(s, 1); s += __shfl_xor(s, 2); s += __shfl_xor(s, 4);
                    if (part == 0) SM[SM_QN + t] = s;
                }
                f32x4 accS[2]; accS[0] = accS[1] = (f32x4){0.f, 0.f, 0.f, 0.f};
#pragma unroll
                for (int ks = 0; ks < 256; ks += 32) { const bf16x8 kf = row_frag(KS, 528, 16 * wc, ks, fr, fq);
#pragma unroll
                    for (int m = 0; m < 2; ++m) accS[m] = MFMA16(kf, row_frag(QS, 528, 32 * wr + 16 * m, ks, fr, fq), accS[m]); }
#pragma unroll
                for (int m = 0; m < 2; ++m) { const int t = 32 * wr + 16 * m + fr, s0 = 16 * wc + 4 * fq; const float rc = SM[SM_ROWC + t];
                    f32x4 p; float ps = 0.f;
#pragma unroll
                    for (int j = 0; j < 4; ++j) { const int s = s0 + j; p[j] = (s <= t) ? accS[m][j] * __expf(rc + SM[SM_A + s]) : 0.f; ps += p[j]; }
                    ps += __shfl_xor(ps, 16); ps += __shfl_xor(ps, 32);
                    if (fq == 0) SM[SM_DEN4 + t * 4 + wc] = ps;
                    v2u o; o.x = pk2(p[0], p[1]); o.y = pk2(p[2], p[3]); *(LAS v2u*)(SP + t * 144 + s0 * 2) = o; }
            }
            __syncthreads();
            if (lat) {
                f32x4 acc1[2], acc2[2]; acc1[0] = acc1[1] = acc2[0] = acc2[1] = (f32x4){0.f, 0.f, 0.f, 0.f};
#pragma unroll
                for (int ks = 0; ks < 256; ks += 32) { const bf16x8 cf = row_frag(CT, 528, 16 * wc, ks, fr, fq);
#pragma unroll
                    for (int m = 0; m < 2; ++m) acc2[m] = MFMA16(cf, row_frag(QS, 528, 32 * wr + 16 * m, ks, fr, fq), acc2[m]); }
#pragma unroll
                for (int ks = 0; ks < 64; ks += 32) { const bf16x8 vf = tr_frag(VS, 144, ks, 16 * wc, fr, fq);
#pragma unroll
                    for (int m = 0; m < 2; ++m) acc1[m] = MFMA16(vf, row_frag(SP, 144, 32 * wr + 16 * m, ks, fr, fq), acc1[m]); }
#pragma unroll
                for (int m = 0; m < 2; ++m) { const int t = 32 * wr + 16 * m + fr; const float ei = SM[SM_EINT + t];
                    const float den = (SM[SM_DEN4 + t * 4 + 0] + SM[SM_DEN4 + t * 4 + 1]) + (SM[SM_DEN4 + t * 4 + 2] + SM[SM_DEN4 + t * 4 + 3]) + ei * SM[SM_QN + t];
                    const float inv = 1.f / fmaxf(fabsf(den), SM[SM_LOW + t]);
                    const f32x4 hv = (acc1[m] + ei * acc2[m]) * inv;
                    const size_t row = (size_t)(base + (d ? 63 - t : t));
                    v2u o; o.x = pk2(hv[0], hv[1]); o.y = pk2(hv[2], hv[3]);
                    *(v2u*)(HD + ((size_t)d * ML + row) * D + h * DV + jv * 64 + 16 * wc + 4 * fq) = o; }
            }
            if (tid < 256) {
                float s = 0.f;
                for (int q = 0; q < 64; ++q) s += SM[SM_W + q] * bf2f(*(const LAS unsigned short*)(KS + q * 528 + tid * 2));
                n_reg = decay * n_reg + s;
            }
#pragma unroll
            for (int m = 0; m < 2; ++m)
#pragma unroll
                for (int n = 0; n < 4; ++n) accC[m][n] = accC[m][n] * decay;
#pragma unroll
            for (int ks = 0; ks < 64; ks += 32) { bf16x8 vf[2];
#pragma unroll
                for (int m = 0; m < 2; ++m) vf[m] = tr_frag(VW, 144, ks, 32 * wr + 16 * m, fr, fq);
#pragma unroll
                for (int n = 0; n < 4; ++n) { const bf16x8 kf = tr_frag(KS, 528, ks, 64 * wc + 16 * n, fr, fq);
#pragma unroll
                    for (int m = 0; m < 2; ++m) accC[m][n] = MFMA16(kf, vf[m], accC[m][n]); } }
            __syncthreads();
#pragma unroll
            for (int m = 0; m < 2; ++m)
#pragma unroll
                for (int n = 0; n < 4; ++n) { const int v = 32 * wr + 16 * m + fr, dd = 64 * wc + 16 * n + 4 * fq; v2u o; o.x = pk2(accC[m][n][0], accC[m][n][1]); o.y = pk2(accC[m][n][2], accC[m][n][3]);
                    *(LAS v2u*)(CT + v * 528 + dd * 2) = o; }
            if (tid < 256) SM[SM_NST + tid] = n_reg;
            if (F.wave == 0 && step < 67) m_run = mlstm_scalars(SM, g_i, g_f, m_run, F.lane);
        }
        __syncthreads();
    }
}
#undef MFMA16

__device__ __forceinline__ void headnorm_phase(Frame& F) {
    const int gw = F.bid * 8 + F.wave, NGW = F.G * 8;
    const bf16* HD = WSP(bf16, WS_HD); const bf16* QKVO = WSP(bf16, WS_BIG); bf16* A2 = WSP(bf16, WS_A2); const float* ng = F.in[19];
    v4u h0[8], h1[8], ov[8], n0[8], n1[8], no[8];
    if (gw < ML) {
#pragma unroll
        for (int j = 0; j < 8; ++j) { const int c = 8 * (F.lane + 64 * j); h0[j] = *(const v4u*)(HD + (size_t)gw * D + c); h1[j] = *(const v4u*)(HD + ((size_t)ML + gw) * D + c); ov[j] = *(const v4u*)(QKVO + (size_t)gw * DIN1 + 8192 + c); } }
    for (int row = gw; row < ML; row += NGW) {
        const int rn = row + NGW;
        if (rn < ML) {
#pragma unroll
            for (int j = 0; j < 8; ++j) { const int c = 8 * (F.lane + 64 * j); n0[j] = *(const v4u*)(HD + (size_t)rn * D + c); n1[j] = *(const v4u*)(HD + ((size_t)ML + rn) * D + c); no[j] = *(const v4u*)(QKVO + (size_t)rn * DIN1 + 8192 + c); } }
#pragma unroll
        for (int j = 0; j < 8; ++j) {
            float v[8];
#pragma unroll
            for (int k = 0; k < 4; ++k) { v[2 * k] = bflo(h0[j][k]) + bflo(h1[j][k]); v[2 * k + 1] = bfhi(h0[j][k]) + bfhi(h1[j][k]); }
            float sm = ((v[0] + v[1]) + (v[2] + v[3])) + ((v[4] + v[5]) + (v[6] + v[7]));
            const float mean = wave_sum(sm) * (1.f / DV); float q = 0.f;
#pragma unroll
            for (int k = 0; k < 8; ++k) { v[k] -= mean; q += v[k] * v[k]; }
            const float rstd = 1.f / sqrtf(wave_sum(q) * (1.f / DV) + LN_EPS);
            const int c = 8 * (F.lane + 64 * j); const f32x4 g0 = *(const f32x4*)(ng + c), g1 = *(const f32x4*)(ng + c + 4);
            v4u w;
            w.x = pk2(sigmoidf_(bflo(ov[j].x)) * v[0] * rstd * g0.x, sigmoidf_(bfhi(ov[j].x)) * v[1] * rstd * g0.y);
            w.y = pk2(sigmoidf_(bflo(ov[j].y)) * v[2] * rstd * g0.z, sigmoidf_(bfhi(ov[j].y)) * v[3] * rstd * g0.w);
            w.z = pk2(sigmoidf_(bflo(ov[j].z)) * v[4] * rstd * g1.x, sigmoidf_(bfhi(ov[j].z)) * v[5] * rstd * g1.y);
            w.w = pk2(sigmoidf_(bflo(ov[j].w)) * v[6] * rstd * g1.z, sigmoidf_(bfhi(ov[j].w)) * v[7] * rstd * g1.w);
            *(v4u*)(A2 + (size_t)row * D + c) = w;
        }
#pragma unroll
        for (int j = 0; j < 8; ++j) { h0[j] = n0[j]; h1[j] = n1[j]; ov[j] = no[j]; }
    }
}
#define XB_TMO      128
#define XB_XCNT(j)  (256  + 64 * (j))
#define XB_XSUB(j)  (1280 + 64 * (j))
#define XB_XGEN(j)  (2304 + 64 * (j))
#define XB_TOP      3328
#define XB_TOPGEN   3392
#define XCD_BAR_WORDS 3456
#define XB_SPIN_CAP (1u << 22)

__device__ __forceinline__ unsigned xb_ld(unsigned* p)              { return __hip_atomic_load(p, __ATOMIC_RELAXED, __HIP_MEMORY_SCOPE_AGENT); }
__device__ __forceinline__ unsigned xb_add(unsigned* p, unsigned v) { return __hip_atomic_fetch_add(p, v, __ATOMIC_RELAXED, __HIP_MEMORY_SCOPE_AGENT); }
__device__ __forceinline__ unsigned xb_xcc_id() { return (unsigned)__builtin_amdgcn_s_getreg((3 << 11) | 20) & 0xFu; }
#define XB_SPIN(cond, bar) do { unsigned _sp = 0; while (cond) { __builtin_amdgcn_s_sleep(1); \
    if ((++_sp & 255u) == 0u) { if (xb_ld(&(bar)[XB_TMO])) break; if (_sp > XB_SPIN_CAP) { atomicAdd(&(bar)[XB_TMO], 1u); break; } } } } while (0)

struct XcdBarrier { unsigned* bar; unsigned x; volatile LAS unsigned* st; };

__device__ __forceinline__ XcdBarrier xcd_barrier_post(unsigned* bar, volatile LAS unsigned* st) {
    XcdBarrier b; b.bar = bar; b.x = xb_xcc_id(); b.st = st;
    if (threadIdx.x == 0) (void)xb_add(&bar[XB_XCNT(b.x)], 1u);
    return b;
}
__device__ __forceinline__ void xcd_barrier_complete(unsigned* bar, unsigned x, unsigned& nloc, unsigned& nx) {
    const unsigned G = gridDim.x * gridDim.y * gridDim.z;
    unsigned sum, cnt, mine, sp = 0u;
    for (;;) {
        sum = 0u; cnt = 0u; mine = 0u;
#pragma unroll
        for (unsigned j = 0; j < 16; ++j) { const unsigned c = xb_ld(&bar[XB_XCNT(j)]); sum += c; cnt += (c > 0u) ? 1u : 0u; mine = (j == x) ? c : mine; }
        if (sum == G) break;
        __builtin_amdgcn_s_sleep(1);
        if ((++sp & 255u) == 0u) { if (xb_ld(&bar[XB_TMO])) break; if (sp > XB_SPIN_CAP) { atomicAdd(&bar[XB_TMO], 1u); break; } }
    }
    nloc = mine > 0u ? mine : 1u; nx = cnt > 0u ? cnt : 1u;
}
__device__ __forceinline__ void xcd_barrier(const XcdBarrier& b) {
    asm volatile("s_waitcnt vmcnt(0)" ::: "memory");
    __syncthreads();
    if (threadIdx.x == 0) {
        unsigned* bar = b.bar;
        __builtin_amdgcn_s_waitcnt(0);
        unsigned nloc = b.st[0], nx = b.st[1];
        if (nloc == 0u) { xcd_barrier_complete(bar, b.x, nloc, nx); b.st[0] = nloc; b.st[1] = nx; }
        const unsigned old = xb_add(&bar[XB_XSUB(b.x)], 1u);
        const unsigned gen = old / nloc;
        if (old + 1u == (gen + 1u) * nloc) {
            __builtin_amdgcn_fence(__ATOMIC_RELEASE, "agent");
            asm volatile("s_waitcnt vmcnt(0)" ::: "memory");
            const unsigned og = xb_add(&bar[XB_TOP], 1u);
            const unsigned tg = og / nx;
            if (og + 1u == (tg + 1u) * nx) xb_add(&bar[XB_TOPGEN], 1u);
            else XB_SPIN(xb_ld(&bar[XB_TOPGEN]) == tg, bar);
            __builtin_amdgcn_fence(__ATOMIC_ACQUIRE, "agent");
            xb_add(&bar[XB_XGEN(b.x)], 1u);
            asm volatile("s_waitcnt vmcnt(0)" ::: "memory");
        } else {
            XB_SPIN(xb_ld(&bar[XB_XGEN(b.x)]) == gen, bar);
            __builtin_amdgcn_fence(__ATOMIC_ACQUIRE, "agent");
            asm volatile("s_waitcnt vmcnt(0)" ::: "memory");
        }
    }
    __syncthreads();
}

constexpr int N_PHASES = 21;
struct Args { const float* in[24]; float* out; unsigned char* ws; int ph_lo, ph_hi; };
__global__ void __launch_bounds__(NTHR, 2) fwd_kernel(Args args) {
    extern __shared__ __attribute__((aligned(16))) unsigned char lds_raw[];
    Frame F;
    F.lds = (LAS unsigned char*)lds_raw;
    F.tid = threadIdx.x; F.lane = F.tid & 63; F.wave = __builtin_amdgcn_readfirstlane(F.tid >> 6);
    F.bid = blockIdx.x; F.G = gridDim.x; F.ws = args.ws; F.out = args.out;
#pragma unroll
    for (int i = 0; i < 24; ++i) F.in[i] = args.in[i];
    volatile LAS unsigned* MISC = (volatile LAS unsigned*)(F.lds + MISC_OFF);
    if (F.tid < 64) MISC[F.tid] = 0u;
    __syncthreads();
    const int lo = args.ph_lo, hi = args.ph_hi;
    const bool multi = (hi - lo) > 1;
    unsigned* barw = (unsigned*)(F.ws + WS_CTL) + CW_BAR;
    XcdBarrier bar; bar.bar = barw; bar.x = 0; bar.st = MISC + 8;
    if (multi) bar = xcd_barrier_post(barw, MISC + 8);
#ifndef REP_MASK
#define REP_MASK 0u
#endif
#define IN(k) (lo <= (k) && (k) < hi)
#define NREP(k) (1 + (int)((REP_MASK >> (k)) & 1u))
#define SEAM(k) do { if (IN(k) && IN((k) + 1)) xcd_barrier(bar); } while (0)
#define RUN(k, ...) _Pragma("unroll") for (int rep_ = 0; rep_ < NREP(k); ++rep_) { __VA_ARGS__ }
    LAS unsigned char* ring = F.lds;

    if (IN(0)) { RUN(0, p0_convert(F); __syncthreads(); p0_adaln(F);) } SEAM(0);
    if (IN(1)) { RUN(1, p1_ln0(F);) } SEAM(1);
    if (IN(2)) { RUN(2, pg8::Gemm g{WSP(bf16, WS_U), WSP(bf16, WS_W1T), D, D, D, 0, 0, nullptr, 0}; pg8::TileOrder S; S.init(1, MT / 256, DIN0 / 256, F.G, F.bid);
        EpiBf16Plain E{WSP(bf16, WS_BIG), DIN0}; pg8::gemm_phase(ring, g, S, E);) } SEAM(2);
    if (IN(3)) { RUN(3, lru_phase<false>(F); pool_pass1(F); pool_ctx(F);) } SEAM(3);
    if (IN(4)) { RUN(4, lru_carry(F); pool_pass2(F);) } SEAM(4);
    if (IN(5)) { RUN(5, lru_phase<true>(F);
        pg8::Gemm g{WSP(bf16, WS_DP), WSP(bf16, WS_PWT), DPOOL, 512, 512, 512 * 2, 512 * 512 * 2, nullptr, 0}; pg8::TileOrder S; S.init(4, MT / 256, 2, F.G, F.bid);
        EpiPool E{WSP(bf16, WS_A2), F.in[15]}; pg8::gemm_phase(ring, g, S, E);) } SEAM(5);
    if (IN(6)) { RUN(6, pg8::Gemm g{WSP(bf16, WS_A2), WSP(bf16, WS_W2T), D, D, D, 0, 0, nullptr, 0}; pg8::TileOrder S; S.init(1, MT / 256, D / 256, F.G, F.bid);
        EpiResid E{WSP(float, WS_H), WSP(float, WS_MOD), 2 * D}; EpiBf16Plain E2{WSP(bf16, WS_YE), D}; if (rep_ == 0) pg8::gemm_phase(ring, g, S, E); else pg8::gemm_phase(ring, g, S, E2);) } SEAM(6);
    if (IN(7)) { RUN(7, ln_router_phase(F, 0, MT, rep_ > 0);) } SEAM(7);
    if (IN(8)) { RUN(8, topk_phase(F, 4, ER0);) } SEAM(8);
    if (IN(9)) { RUN(9, pg8::Gemm g{WSP(bf16, WS_U), WSP(bf16, WS_WGU), D, D, D, 0, (size_t)2048 * D * 2, WSP(int, WS_IDX), ER0}; pg8::TileOrder S; S.init(16, ER0 / 256, 8, F.G, F.bid);
        EpiGU E{WSP(bf16, WS_ACT), ER0}; pg8::gemm_phase<true>(ring, g, S, E);) } SEAM(9);
    if (IN(10)) { RUN(10, pg8::Gemm g{WSP(bf16, WS_ACT), WSP(bf16, WS_WDN), DE, DE, DE, (size_t)ER0 * DE * 2, (size_t)D * DE * 2, nullptr, 0}; pg8::TileOrder S; S.init(16, ER0 / 256, 16, F.G, F.bid);
        EpiDown E{WSP(bf16, WS_YE), WSP(float, WS_GX), ER0}; pg8::gemm_phase(ring, g, S, E);) } SEAM(10);
    if (IN(11)) { RUN(11, combine_phase<false>(F, 0, MT, ER0, rep_ > 0);) } SEAM(11);
    if (IN(12)) { RUN(12, pg8::Gemm g{WSP(bf16, WS_U), WSP(bf16, WS_W3T), D, D, D, 0, 0, nullptr, 0}; pg8::TileOrder S; S.init(1, MT / 256, DIN1P / 256, F.G, F.bid);
        EpiOddIn E{WSP(bf16, WS_BIG), WSP(float, WS_G), F.in[18]}; pg8::gemm_phase(ring, g, S, E);) } SEAM(12);
    if (IN(13)) { RUN(13, mlstm_phase(F);) } SEAM(13);
    if (IN(14)) { RUN(14, headnorm_phase(F);) } SEAM(14);
    if (IN(15)) { RUN(15, pg8::Gemm g{WSP(bf16, WS_A2), WSP(bf16, WS_W4T), D, D, D, 0, 0, nullptr, 0}; pg8::TileOrder S; S.init(1, ML / 256, D / 256, F.G, F.bid);
        EpiResid E{WSP(float, WS_H), WSP(float, WS_MOD) + 3 * 24576, 2 * D}; EpiBf16Plain E2{WSP(bf16, WS_YE), D}; if (rep_ == 0) pg8::gemm_phase(ring, g, S, E); else pg8::gemm_phase(ring, g, S, E2);) } SEAM(15);
    if (IN(16)) { RUN(16, ln_router_phase(F, 1, ML, rep_ > 0);) } SEAM(16);
    if (IN(17)) { RUN(17, topk_phase(F, 2, ER1);) } SEAM(17);
    if (IN(18)) { RUN(18, pg8::Gemm g{WSP(bf16, WS_U), WSP(bf16, WS_WGU) + (size_t)16 * 2048 * D, D, D, D, 0, (size_t)2048 * D * 2, WSP(int, WS_IDX), ER1}; pg8::TileOrder S; S.init(16, ER1 / 256, 8, F.G, F.bid);
        EpiGU E{WSP(bf16, WS_ACT), ER1}; pg8::gemm_phase<true>(ring, g, S, E);) } SEAM(18);
    if (IN(19)) { RUN(19, pg8::Gemm g{WSP(bf16, WS_ACT), WSP(bf16, WS_WDN) + (size_t)16 * D * DE, DE, DE, DE, (size_t)ER1 * DE * 2, (size_t)D * DE * 2, nullptr, 0}; pg8::TileOrder S; S.init(16, ER1 / 256, 16, F.G, F.bid);
        EpiDown E{WSP(bf16, WS_YE), WSP(float, WS_GX), ER1}; pg8::gemm_phase(ring, g, S, E);) } SEAM(19);
    if (IN(20)) { RUN(20, combine_phase<true>(F, 1, ML, ER1);) }
#undef IN
#undef RUN
#undef SEAM
}

#ifndef MK_ONE_LAUNCH
#define MK_ONE_LAUNCH 0
#endif
extern "C" void kernel_launch(void* const* d_in, const int* in_sizes, int n_in, void* d_out, int out_size, void* d_ws, size_t ws_size, hipStream_t stream) {
    static int grid = 0;
    if (grid == 0) {
        if (n_in != 24 || out_size != ML * D || ws_size < WS_END) { fprintf(stderr, "kernel_launch: unexpected shapes (n_in %d, out %d, ws %zu); nothing launched\n", n_in, out_size, ws_size); grid = -1; return; }
        int dev = 0, cus = 0, per_cu = 0;
        if (hipGetDevice(&dev) != hipSuccess || hipDeviceGetAttribute(&cus, hipDeviceAttributeMultiprocessorCount, dev) != hipSuccess) { grid = -1; return; }
        if (hipFuncSetAttribute((const void*)fwd_kernel, hipFuncAttributeMaxDynamicSharedMemorySize, LDS_BYTES) != hipSuccess) { fprintf(stderr, "kernel_launch: hipFuncSetAttribute failed\n"); grid = -1; return; }
        if (hipOccupancyMaxActiveBlocksPerMultiprocessor(&per_cu, (const void*)fwd_kernel, NTHR, LDS_BYTES) != hipSuccess || per_cu < 1) { fprintf(stderr, "kernel_launch: occupancy query says %d\n", per_cu); }
        (void)hipGetLastError();
        grid = cus;
    }
    if (grid < 0) return;
    if (hipMemsetAsync((char*)d_ws + WS_CTL, 0, CTL_ZERO_BYTES, stream) != hipSuccess) return;
    Args a{};
    for (int i = 0; i < 24; ++i) a.in[i] = (const float*)d_in[i];
    a.out = (float*)d_out; a.ws = (unsigned char*)d_ws;
#if MK_ONE_LAUNCH
    a.ph_lo = 0; a.ph_hi = N_PHASES;
    hipLaunchKernelGGL(fwd_kernel, dim3(grid), dim3(NTHR), LDS_BYTES, stream, a);
#else
    for (int p = 0; p < N_PHASES; ++p) { a.ph_lo = p; a.ph_hi = p + 1; hipLaunchKernelGGL(fwd_kernel, dim3(grid), dim3(NTHR), LDS_BYTES, stream, a); }
#endif
}
```

```cpp
#ifndef MK_ONE_LAUNCH
#define MK_ONE_LAUNCH 1
#endif
#ifndef REP_MASK
#define REP_MASK 0u
#endif
#ifndef TSEL
#define TSEL 0u
#endif
#ifndef RSEL
#define RSEL 0
#endif
#include <hip/hip_runtime.h>
#include <cstdio>
#include <cstdint>
namespace pg8 {
__device__ __forceinline__ int fresh_lane() { int l; asm volatile("v_mbcnt_lo_u32_b32 %0, -1, 0\n\tv_mbcnt_hi_u32_b32 %0, -1, %0" : "=v"(l)); return l & 63; }
#define PG8_LAS __attribute__((address_space(3)))
typedef unsigned short bf16_t;
typedef short bf16x8 __attribute__((ext_vector_type(8)));
typedef float f32x4 __attribute__((ext_vector_type(4)));
typedef float f32x2 __attribute__((ext_vector_type(2)));
typedef unsigned u32x4 __attribute__((ext_vector_type(4)));
typedef unsigned u32x2 __attribute__((ext_vector_type(2)));
typedef int i32x4 __attribute__((ext_vector_type(4)));
typedef int i32x8 __attribute__((ext_vector_type(8)));
constexpr int BM = 256, BK = 64, HALF = 128, HTB = HALF * BK * 2  , STAGE_BYTES = 8 * HTB, NXCD = 8, WGM = 8;

__host__ __device__ __forceinline__ int lds_byte(int r, int c) { const int st = (r >> 4) * 2 + (c >> 5), rr = r & 15, cc = c & 31, ob = rr * 64 + cc * 2; return st * 1024 + (ob ^ (((ob >> 9) & 1) << 5)); }
__host__ __device__ __forceinline__ void stage_rc(int b, int& R, int& C) { const int st = b / 1024, sb = b % 1024, swz = sb ^ (((sb >> 9) & 1) << 5); R = (st >> 1) * 16 + swz / 64; C = (st & 1) * 32 + (swz % 64) / 2; }
__host__ __device__ __forceinline__ int perm32(int rho) { const int n = rho >> 4, i = rho & 15; return 8 * (i >> 2) + 4 * n + (i & 3); }

struct Unit { int pm, pn, g, ks, t; };
struct Gemm { const bf16_t* A; const bf16_t* Bt; int lda, ldb, K; size_t gA, gB; const int* rowidx; int grows; size_t kS; };

struct TileOrder {
    int nG, nM, nN, per, nwg, G, c;
    __device__ __forceinline__ void init(int nG_, int nM_, int nN_, int G_, int c_) { nG = nG_; nM = nM_; nN = nN_; per = nM * nN; nwg = nG * per; G = G_; c = c_; }
    __device__ __forceinline__ bool next(int i, Unit& u) const {
        const long L = (long)i * G + c; if (L >= nwg) return false;
        int wgid = (int)L; { const int q = nwg / NXCD, r = nwg % NXCD, xcd = wgid % NXCD, off = wgid / NXCD; wgid = (xcd < r ? xcd * (q + 1) : r * (q + 1) + (xcd - r) * q) + off; }
        u.ks = 0; u.t = 0; u.g = wgid / per; wgid -= u.g * per;
        const int nig = WGM * nN, gid = wgid / nig, fm = gid * WGM, gsz = (nM - fm) < WGM ? (nM - fm) : WGM;
        u.pm = fm + ((wgid % nig) % gsz); u.pn = (wgid % nig) / gsz; return true;
    }
};

struct TailOrder {
    int ntiles, nS, G, c, kind, pm0, nM;
    __device__ __forceinline__ void init(int kind_, int ntiles_, int nS_, int pm0_, int nM_, int G_, int c_) { kind = kind_; ntiles = ntiles_; nS = nS_; pm0 = pm0_; nM = nM_; G = G_; c = c_; }
    __device__ __forceinline__ bool next(int i, Unit& u) const {
        const int nwg = ntiles * nS; const long L = (long)i * G + c; if (L >= nwg) return false;
        int wgid = (int)L; { const int q = nwg / NXCD, r = nwg % NXCD, xcd = wgid % NXCD, off = wgid / NXCD; wgid = (xcd < r ? xcd * (q + 1) : r * (q + 1) + (xcd - r) * q) + off; }
        u.ks = wgid % nS; const int t = wgid / nS; u.t = t; u.g = 0;
        if (kind == 0) { u.pm = pm0 + t % nM; u.pn = t / nM; }
        else if (kind == 1) { u.g = t >> 3; u.pn = t & 7; u.pm = 4; }
        else { if (t < 32) { u.pm = t; u.pn = 48; } else { const int j = t - 32, q = j % 25; u.pm = 32 + j / 25; u.pn = q < 24 ? 8 + q : 48; } }
        return true;
    }
};

__device__ __forceinline__ unsigned cvt_pk_bf16(float lo, float hi) { unsigned r; asm volatile("v_cvt_pk_bf16_f32 %0, %1, %2" : "=v"(r) : "v"(lo), "v"(hi)); return r; }

template <bool GATHER = false, int ES = 2, class Epi, class Sched>
__device__ __forceinline__ void gemm_phase(const int wid  , PG8_LAS unsigned char* lds, const Gemm g, const Sched& S, const Epi& E) {
    const int lane = fresh_lane(), tid = wid * 64 + lane, wr = wid >> 2, wc = wid & 3, fr = lane & 15, fq = lane >> 4;
    const int K = g.K, nt = K * ES / (BK * 2);
    unsigned voffA[2], voffB[2];
#pragma unroll
    for (int i = 0; i < 2; ++i) { int R, C; stage_rc(tid * 16 + i * 8192, R, C); const int Rb = Epi::PERM ? ((R & ~31) + perm32(R & 31)) : R;
        voffA[i] = (unsigned)(R * g.lda * ES + C * 2); voffB[i] = (unsigned)(Rb * g.ldb * ES + C * 2); }
    unsigned vA[2][2], vAn[2][2];
#define PG8_GOFFS(v, u) do { int _t = tid; asm volatile("" : "+v"(_t));     \
        _Pragma("unroll") for (int _i = 0; _i < 2; ++_i) { int _R, _C; stage_rc(_t * 16 + _i * 8192, _R, _C); _Pragma("unroll") for (int _h = 0; _h < 2; ++_h) \
        (v)[_h][_i] = (unsigned)(g.rowidx[(size_t)(u).g * g.grows + (u).pm * 256 + _h * 128 + _R] * g.lda * ES + _C * 2); } } while (0)
    const size_t kstep = (size_t)(BK * 2);
    const size_t hstepA = (size_t)HALF * g.lda * ES, hstepB = (size_t)HALF * g.ldb * ES;
    const size_t tstepA = 2 * hstepA, tstepB = 2 * hstepB;
    const unsigned ldsw = (unsigned)wid * 1024u;
    const int aoff = lds_byte(wr * 64 + fr, fq * 8), boff = lds_byte(wc * 32 + fr, fq * 8);
#define PG8_SA(b, h) (((b) * 2 + (h)) * HTB)
#define PG8_SB(b, h) ((4 + (b) * 2 + (h)) * HTB)
#define PG8_STAGE(bufoff, gbase, voff) do { _Pragma("unroll") for (int _i = 0; _i < 2; ++_i) { unsigned _vo = (voff)[_i]; asm volatile("" : "+v"(_vo));     \
        __builtin_amdgcn_global_load_lds((const unsigned*)((const char*)(gbase) + _vo), (PG8_LAS unsigned*)(lds + (bufoff) + ldsw + _i * 8192), 16, 0, 0); } } while (0)
#define PG8_LDA(dst, b, h) do { if constexpr (ES == 2) { _Pragma("unroll") for (int m = 0; m < 4; ++m) _Pragma("unroll") for (int k = 0; k < 2; ++k) dst[m][k] = *(const PG8_LAS bf16x8*)(lds + PG8_SA(b, h) + aoff + m * 2048 + k * 1024); } \
        else { _Pragma("unroll") for (int m = 0; m < 4; ++m) { dst##8[m].lo = *(const PG8_LAS i32x4*)(lds + PG8_SA(b, h) + aoff + m * 2048); dst##8[m].hi = *(const PG8_LAS i32x4*)(lds + PG8_SA(b, h) + aoff + m * 2048 + 1024); } } } while (0)
#define PG8_LDB(dst, b, h) do { if constexpr (ES == 2) { _Pragma("unroll") for (int n = 0; n < 2; ++n) _Pragma("unroll") for (int k = 0; k < 2; ++k) dst[n][k] = *(const PG8_LAS bf16x8*)(lds + PG8_SB(b, h) + boff + n * 2048 + k * 1024); } \
        else { _Pragma("unroll") for (int n = 0; n < 2; ++n) { dst##8[n].lo = *(const PG8_LAS i32x4*)(lds + PG8_SB(b, h) + boff + n * 2048); dst##8[n].hi = *(const PG8_LAS i32x4*)(lds + PG8_SB(b, h) + boff + n * 2048 + 1024); } } } while (0)
#define PG8_CAT8(x, y) __builtin_shufflevector(__builtin_bit_cast(i32x4, (x)), __builtin_bit_cast(i32x4, (y)), 0, 1, 2, 3, 4, 5, 6, 7)
#define PG8_MMA(ai, bj, At, Bt) do { __builtin_amdgcn_s_setprio(1); \
        if constexpr (ES == 2) { _Pragma("unroll") for (int m = 0; m < 4; ++m) _Pragma("unroll") for (int n = 0; n < 2; ++n) _Pragma("unroll") for (int k = 0; k < 2; ++k) \
            acc[ai][bj][m][n] = __builtin_amdgcn_mfma_f32_16x16x32_bf16(Bt[n][k], At[m][k], acc[ai][bj][m][n], 0, 0, 0); } \
        else { _Pragma("unroll") for (int m = 0; m < 4; ++m) _Pragma("unroll") for (int n = 0; n < 2; ++n) \
            acc[ai][bj][m][n] = __builtin_amdgcn_mfma_scale_f32_16x16x128_f8f6f4(Bt##8[n], At##8[m], acc[ai][bj][m][n], 0, 0, 0, 0, 0, 0); } \
        __builtin_amdgcn_s_setprio(0); } while (0)
#define PG8_WAIT_V(n) asm volatile("s_waitcnt vmcnt(" #n ")" ::: "memory")
#define PG8_WAIT_L(n) asm volatile("s_waitcnt lgkmcnt(" #n ")" ::: "memory")
#define PG8_BAR __builtin_amdgcn_s_barrier()
#define PG8_SCHED __builtin_amdgcn_sched_barrier(0)
    Unit cur, nxt; int ui = 0;
    if (!S.next(0, cur)) return;
    f32x4 acc[2][2][4][2];
#pragma unroll
    for (int a = 0; a < 2; ++a)
#pragma unroll
        for (int b = 0; b < 2; ++b)
#pragma unroll
            for (int m = 0; m < 4; ++m)
#pragma unroll
                for (int n = 0; n < 2; ++n) acc[a][b][m][n] = (f32x4){0.f, 0.f, 0.f, 0.f};
    bf16x8 At[4][2], B0[2][2], B1[2][2];
    i32x8 At8[4], B08[2], B18[2];
    const char* cA = (GATHER ? (const char*)g.A : (const char*)g.A + (size_t)cur.g * g.gA + (size_t)cur.pm * tstepA) + (size_t)cur.ks * g.kS; const char* cB = (const char*)g.Bt + (size_t)cur.g * g.gB + (size_t)cur.pn * tstepB + (size_t)cur.ks * g.kS;
    if constexpr (GATHER) { PG8_GOFFS(vA, cur); }
    if constexpr (GATHER) { PG8_STAGE(PG8_SB(0, 0), cB, voffB); PG8_STAGE(PG8_SB(0, 1), cB + hstepB, voffB); PG8_STAGE(PG8_SA(0, 0), cA, vA[0]); PG8_STAGE(PG8_SA(0, 1), cA, vA[1]); }
    else { PG8_STAGE(PG8_SB(0, 0), cB, voffB); PG8_STAGE(PG8_SB(0, 1), cB + hstepB, voffB); PG8_STAGE(PG8_SA(0, 0), cA, voffA); PG8_STAGE(PG8_SA(0, 1), cA + hstepA, voffA); }
    if (wr == 1) PG8_BAR;
    PG8_WAIT_V(2); PG8_BAR;
    if constexpr (GATHER) { PG8_STAGE(PG8_SB(1, 0), cB + kstep, voffB); PG8_STAGE(PG8_SA(1, 0), cA + kstep, vA[0]); PG8_STAGE(PG8_SB(1, 1), cB + hstepB + kstep, voffB); }
    else { PG8_STAGE(PG8_SB(1, 0), cB + kstep, voffB); PG8_STAGE(PG8_SA(1, 0), cA + kstep, voffA); PG8_STAGE(PG8_SB(1, 1), cB + hstepB + kstep, voffB); }
    PG8_WAIT_V(6); PG8_BAR;
    for (;;) {
        const bool has_next = S.next(ui + 1, nxt);
        const char* nA = !has_next ? cA : (GATHER ? (const char*)g.A : (const char*)g.A + (size_t)nxt.g * g.gA + (size_t)nxt.pm * tstepA) + (size_t)nxt.ks * g.kS; const char* nB = has_next ? (const char*)g.Bt + (size_t)nxt.g * g.gB + (size_t)nxt.pn * tstepB + (size_t)nxt.ks * g.kS : cB;
        if constexpr (GATHER) { if (has_next) { PG8_GOFFS(vAn, nxt); } else {
#pragma unroll
                for (int _h = 0; _h < 2; ++_h)
#pragma unroll
                    for (int _i = 0; _i < 2; ++_i) vAn[_h][_i] = vA[_h][_i]; } }
        for (int t = 0; t < nt; t += 2) {
            const bool last = (t == nt - 2);
            const char* a1 = cA + (size_t)(t + 1) * kstep;
            const char* a2 = last ? nA : cA + (size_t)(t + 2) * kstep; const char* b2 = last ? nB : cB + (size_t)(t + 2) * kstep;
            const char* a3 = a2 + kstep; const char* b3 = b2 + kstep;
            PG8_LDB(B0, 0, 0); PG8_LDB(B1, 0, 1); PG8_SCHED; PG8_LDA(At, 0, 0); if constexpr (GATHER) { PG8_STAGE(PG8_SA(1, 1), a1, vA[1]); } else { PG8_STAGE(PG8_SA(1, 1), a1 + hstepA, voffA); }
            PG8_WAIT_V(8); PG8_WAIT_L(0); PG8_BAR; PG8_MMA(0, 0, At, B0); PG8_MMA(0, 1, At, B1); PG8_BAR; PG8_SCHED;
            if constexpr (GATHER) { if (last) {
#pragma unroll
                    for (int _h = 0; _h < 2; ++_h)
#pragma unroll
                        for (int _i = 0; _i < 2; ++_i) vA[_h][_i] = vAn[_h][_i]; } }
            PG8_LDA(At, 0, 1); PG8_STAGE(PG8_SB(0, 0), b2, voffB); PG8_STAGE(PG8_SB(0, 1), b2 + hstepB, voffB); if constexpr (GATHER) { PG8_STAGE(PG8_SA(0, 0), a2, vA[0]); } else { PG8_STAGE(PG8_SA(0, 0), a2, voffA); }
            PG8_WAIT_V(8); PG8_WAIT_L(0); PG8_BAR; PG8_MMA(1, 0, At, B0); PG8_MMA(1, 1, At, B1); PG8_BAR; PG8_SCHED;
            PG8_LDB(B0, 1, 0); PG8_LDB(B1, 1, 1); PG8_SCHED; PG8_LDA(At, 1, 0); if constexpr (GATHER) { PG8_STAGE(PG8_SA(0, 1), a2, vA[1]); } else { PG8_STAGE(PG8_SA(0, 1), a2 + hstepA, voffA); }
            PG8_WAIT_V(8); PG8_WAIT_L(0); PG8_BAR; PG8_MMA(0, 0, At, B0); PG8_MMA(0, 1, At, B1); PG8_BAR; PG8_SCHED;
            PG8_LDA(At, 1, 1); PG8_STAGE(PG8_SB(1, 0), b3, voffB); PG8_STAGE(PG8_SB(1, 1), b3 + hstepB, voffB); if constexpr (GATHER) { PG8_STAGE(PG8_SA(1, 0), a3, vA[0]); } else { PG8_STAGE(PG8_SA(1, 0), a3, voffA); }
            PG8_WAIT_V(8); PG8_WAIT_L(0); PG8_BAR; PG8_MMA(1, 0, At, B0); PG8_MMA(1, 1, At, B1); PG8_BAR; PG8_SCHED;
        }
        if (wr == 0) PG8_BAR;
        E(acc, cur, wr, wc, fr, fq);
        if (!has_next) break;
#pragma unroll
        for (int a = 0; a < 2; ++a)
#pragma unroll
            for (int b = 0; b < 2; ++b)
#pragma unroll
                for (int m = 0; m < 4; ++m)
#pragma unroll
                    for (int n = 0; n < 2; ++n) acc[a][b][m][n] = (f32x4){0.f, 0.f, 0.f, 0.f};
        cur = nxt; cA = nA; cB = nB; ++ui;
        if (wr == 1) PG8_BAR;
    }
    PG8_WAIT_V(0);
    PG8_BAR;
#undef PG8_GOFFS
#undef PG8_SA
#undef PG8_SB
#undef PG8_STAGE
#undef PG8_LDA
#undef PG8_LDB
#undef PG8_MMA
#undef PG8_CAT8
#undef PG8_WAIT_V
#undef PG8_WAIT_L
#undef PG8_BAR
#undef PG8_SCHED
}
}
#define GAS __attribute__((address_space(1)))
#define LAS __attribute__((address_space(3)))
typedef unsigned short bf16;
typedef unsigned v4u __attribute__((ext_vector_type(4)));
typedef unsigned v2u __attribute__((ext_vector_type(2)));
typedef float f32x4 __attribute__((ext_vector_type(4)));
typedef float f32x2 __attribute__((ext_vector_type(2)));
typedef short bf16x8 __attribute__((ext_vector_type(8)));

constexpr int D = 4096, NB = 2, SEQ = 4096, CTXL = 256;
constexpr int ML = NB * SEQ, MC = NB * CTXL, MT = ML + MC;
constexpr int DLRU = 2048, LRUH = 16, LRUB = 128, DPOOL = 2048, DIN0 = 6144;
constexpr int MH = 8, DQK = 256, DV = 512, DIN1 = 12288, DIN1P = 12544, CHUNK = 64;
constexpr int NE = 16, DE = 1024;
constexpr int ER0 = 1280, ER1 = 1024;
constexpr float LN_EPS = 1e-5f, DN_ALPHA = 1.41421356237f;
constexpr int NT_TILES = 136;

constexpr size_t WS_CTL = 0ull, CTL_ZERO_BYTES = 1048576ull;
constexpr size_t WS_MOD = 1048576ull;
constexpr size_t WS_WRT = 1638400ull;
constexpr size_t WS_LS8 = 2162688ull;
constexpr size_t WS_W1T = 2179072ull;
constexpr size_t WS_W2T = 52510720ull;
constexpr size_t WS_W3T = 86065152ull;
constexpr size_t WS_W4T = 188825600ull;
constexpr size_t WS_WGU = 222380032ull;
constexpr size_t WS_WDN = 759250944ull;
constexpr size_t WS_GWT = 1027686400ull;
constexpr size_t WS_PWT = 1029783552ull;
constexpr size_t WS_H = 1031880704ull;
constexpr size_t WS_U = 1174487040ull;
constexpr size_t WS_BIG = 1245790208ull;
constexpr size_t WS_A2 = 1459699712ull;
constexpr size_t WS_CM = 1531002880ull;
constexpr size_t WS_DP = 1598111744ull;
constexpr size_t WS_SUMM = 1633763328ull;
constexpr size_t WS_CARRY = 1638219776ull;
constexpr size_t WS_AFF = 1640448000ull;
constexpr size_t WS_IDX = 1641496576ull;
constexpr size_t WS_GSEL = 1641627648ull;
constexpr size_t WS_INV = 1641758720ull;
constexpr size_t WS_GX = 1642315776ull;
constexpr size_t WS_XE = 1642397696ull;
constexpr size_t WS_ACT = 1810169856ull;
constexpr size_t WS_YE = 1852112896ull;
constexpr size_t WS_G = 2019885056ull;
constexpr size_t WS_HD = 2020999168ull;
constexpr size_t WS_SLAB = 2155216896ull;
constexpr size_t WS_MSC = 2155216896ull + 67108864ull;
constexpr size_t WS_WRH = WS_MSC + 256ull * 68 * 576 * 4;
constexpr size_t WS_WRL = WS_WRH + 262144ull;
constexpr size_t WS_U8 = WS_WRL + 262144ull;
constexpr size_t WS_DUMP = WS_U8 + 8704ull * 4096;
constexpr size_t WS_END = WS_DUMP + 65536ull;

constexpr int CW_BAR = 4096;
constexpr int LDS_BYTES = 147456;
constexpr int MISC_OFF = 144 * 1024 - 256;
constexpr int NTHR = 512;

typedef __bf16 hwbf16x2 __attribute__((ext_vector_type(2)));
typedef float f32x2_ __attribute__((ext_vector_type(2)));
__device__ __forceinline__ unsigned pk2(float lo, float hi) { const f32x2_ f = {lo, hi}; return __builtin_bit_cast(unsigned, __builtin_convertvector(f, hwbf16x2)); }
__device__ __forceinline__ unsigned f2bf(float f) { return pk2(f, 0.f) & 0xffffu; }
__device__ __forceinline__ float bf2f(unsigned b) { return __builtin_bit_cast(float, b << 16); }
__device__ __forceinline__ float bflo(unsigned w) { return __builtin_bit_cast(float, w << 16); }
__device__ __forceinline__ float bfhi(unsigned w) { return __builtin_bit_cast(float, w & 0xffff0000u); }
template <int CTRL> __device__ __forceinline__ float dppx(float v) { return __builtin_bit_cast(float, __builtin_amdgcn_update_dpp(0, __builtin_bit_cast(int, v), CTRL, 0xF, 0xF, true)); }
__device__ __forceinline__ float rlane(float v, int l) { return __builtin_bit_cast(float, __builtin_amdgcn_readlane(__builtin_bit_cast(int, v), l)); }
__device__ __forceinline__ float wave_sum(float v) {
    v += dppx<0xB1>(v); v += dppx<0x4E>(v); v += dppx<0x141>(v); v += dppx<0x140>(v);
    return (rlane(v, 0) + rlane(v, 16)) + (rlane(v, 32) + rlane(v, 48));
}
__device__ __forceinline__ float wave_max(float v) {
    v = fmaxf(v, dppx<0xB1>(v)); v = fmaxf(v, dppx<0x4E>(v)); v = fmaxf(v, dppx<0x141>(v)); v = fmaxf(v, dppx<0x140>(v));
    return fmaxf(fmaxf(rlane(v, 0), rlane(v, 16)), fmaxf(rlane(v, 32), rlane(v, 48)));
}
__device__ __forceinline__ float rcp_fast(float x) { return __builtin_amdgcn_rcpf(x); }
__device__ __forceinline__ float sigmoidf_(float x) { return rcp_fast(1.f + __expf(-x)); }
__device__ __forceinline__ float siluf_(float x) { return x * rcp_fast(1.f + __expf(-x)); }
__device__ __forceinline__ float logsigmoidf_(float x) { return fminf(x, 0.f) - log1pf(__expf(-fabsf(x))); }
__device__ __forceinline__ float gelu_tanh(float x) { const float u = 0.7978845608028654f * (x + 0.044715f * x * x * x); const float t = 1.f - 2.f * rcp_fast(__expf(2.f * u) + 1.f); return 0.5f * x * (1.f + t); }
__device__ __forceinline__ float expm1_small(float x) {
    float p = 1.f / 720.f; p = p * x + (1.f / 120.f); p = p * x + (1.f / 24.f); p = p * x + (1.f / 6.f); p = p * x + 0.5f; p = p * x + 1.f; p = p * x;
    if (fabsf(x) > 0.5f) p = expm1f(x);
    return p;
}

__device__ __forceinline__ int seq_row0(int s) { return s < 2 ? s * SEQ : ML + (s - 2) * CTXL; }
__device__ __forceinline__ int seq_len(int s) { return s < 2 ? SEQ : CTXL; }
__device__ __forceinline__ int row_mod(int row) { return row < SEQ ? 0 : (row < ML ? 1 : 2); }
__device__ __forceinline__ int tile_row0(int tt) { return tt < 128 ? tt * 64 : ML + (tt - 128) * 64; }
__device__ __forceinline__ void tile_seq(int tt, int& lo, int& hi) { if (tt < 128) { lo = (tt >> 6) * SEQ; hi = lo + SEQ; } else { lo = ML + ((tt - 128) >> 2) * CTXL; hi = lo + CTXL; } }
struct Frame {
    LAS unsigned char* lds;
    int tid, lane, wave;
    int bid, G;
    unsigned char* ws;
    const float* in[24];
    float* out;
};
#define WSP(T, off) ((T*)(F.ws + (off)))

constexpr float W8_SCALE = 256.f, W8_INV = 1.f / 256.f;
struct TItem { const float* src; unsigned char* dst; int N, pitch; bool ok; };
__device__ __forceinline__ TItem t_make(const float* W, int N, void* WT, int ldk, int k0, int n0, int drow0, int lane, bool f8 = false) {
    const int col = n0 + 4 * (lane & 15), kq = lane >> 4;
    TItem t; t.ok = col < N; t.src = W + (size_t)(k0 + 32 * kq) * N + (t.ok ? col : N - 4); const int es = f8 ? 1 : 2;
    t.dst = (unsigned char*)WT + ((size_t)drow0 * ldk + k0) * es; t.N = N; t.pitch = ldk * es; return t;
}
__device__ __forceinline__ unsigned pk4_fp8(float a, float b, float c, float d) { int w = 0; w = __builtin_amdgcn_cvt_pk_fp8_f32(a, b, w, false); w = __builtin_amdgcn_cvt_pk_fp8_f32(c, d, w, true); return (unsigned)w; }
__device__ __forceinline__ TItem t_decode(Frame& F, int it) {
    constexpr int I0 = 32 * 96, I1 = 32 * 64, I2 = 32 * 193, I3 = 32 * 64, I4 = 32 * 1024, I5 = 32 * 512, I6 = 64 * 2;
    int r = it;
    if (r < I0) { const int kb = r / 96, nb = r % 96; return t_make(F.in[8], DIN0, WSP(bf16, WS_W1T), D, kb * 128, nb * 64, nb * 64, F.lane); } r -= I0;
    if (r < I1) { const int kb = r / 64, nb = r % 64; return t_make(F.in[16], D, WSP(bf16, WS_W2T), D, kb * 128, nb * 64, nb * 64, F.lane); } r -= I1;
    if (r < I2) { const int kb = r / 193, nb = r % 193; return t_make(F.in[17], 12320, WSP(bf16, WS_W3T), D, kb * 128, nb * 64, nb * 64, F.lane); } r -= I2;
    if (r < I3) { const int kb = r / 64, nb = r % 64; return t_make(F.in[20], D, WSP(bf16, WS_W4T), D, kb * 128, nb * 64, nb * 64, F.lane); } r -= I3;
    if (r < I4) { const int mat = r / 1024, q = r % 1024, kb = q / 32, nb = q % 32, n0 = nb * 64;
        const int drow0 = 256 * ((n0 & 1023) >> 7) + 128 * (n0 >> 10) + (n0 & 127);
        return t_make(F.in[22] + (size_t)mat * D * 2048, 2048, WSP(unsigned char, WS_WGU) + (size_t)mat * 2048 * D, D, kb * 128, n0, drow0, F.lane, true); } r -= I4;
    if (r < I5) { const int mat = r / 512, q = r % 512, kb = q / 64, nb = q % 64;
        return t_make(F.in[23] + (size_t)mat * DE * D, D, WSP(unsigned char, WS_WDN) + (size_t)mat * D * DE, DE, kb * 128, nb * 64, nb * 64, F.lane, true); } r -= I5;
    if (r < I6) { const int mat = r / 2, nb = r % 2;
        return t_make(F.in[11] + (size_t)mat * 16384, 128, WSP(bf16, WS_GWT) + (size_t)mat * 16384, 128, 0, nb * 64, nb * 64, F.lane); } r -= I6;
    { const int mat = r / 32, q = r % 32, kb = q / 8, nb = q % 8;
        return t_make(F.in[14] + (size_t)mat * 262144, 512, WSP(bf16, WS_PWT) + (size_t)mat * 262144, 512, kb * 128, nb * 64, nb * 64, F.lane); }
}
constexpr int CV_GU0 = 32 * 96 + 32 * 64 + 32 * 193 + 32 * 64;
constexpr int CV_DOWN0 = CV_GU0 + 32 * 1024, CV_DOWN1 = CV_DOWN0 + 16 * 512, CV_DOWN_END = CV_DOWN1 + 16 * 512;
constexpr int CV_NITEMS = CV_DOWN_END + 64 * 2 + 4 * 32;
template <bool F8> __device__ __forceinline__ void convert_items(Frame& F, int lo, int hi, int skip_lo, int skip_hi, int gw, int NGW, int scr_off) {
    constexpr int P = F8 ? 36 : 68, NST = F8 ? 8 : 16;
    LAS unsigned* scr = (LAS unsigned*)(F.lds + scr_off + F.wave * 17408);
    const int n4 = F.lane & 15, kq = F.lane >> 4;
    const int NITEMS = hi - (skip_hi - skip_lo);
#define CV_MAP(i) ((i) >= skip_lo ? (i) + (skip_hi - skip_lo) : (i))
    f32x4 v[32]; TItem cur, nx; nx.ok = false; nx.src = nullptr; nx.dst = nullptr; nx.N = 0; nx.pitch = 0;
    int it = lo + gw;
    if (it < NITEMS) { cur = t_decode(F, CV_MAP(it));
#pragma unroll
        for (int i = 0; i < 32; ++i) v[i] = __builtin_nontemporal_load((const f32x4*)(cur.src + (size_t)i * cur.N));
        unsigned* dump = WSP(unsigned, WS_DUMP) + (gw & 15) * 1024 + F.lane;
#pragma unroll
        for (int j = 0; j < NST; ++j) dump[j * 64] = 0u; }
    while (it < NITEMS) {
#pragma unroll
        for (int r = 0; r < 4; ++r) {
            LAS unsigned* rp = scr + (4 * n4 + r) * P + (F8 ? 8 : 16) * kq;
#define CV_V(i) (cur.ok ? (r == 0 ? v[i].x : (r == 1 ? v[i].y : (r == 2 ? v[i].z : v[i].w))) : 0.f)
            if constexpr (F8) {
#pragma unroll
                for (int q = 0; q < 2; ++q) { v4u w;
                    w.x = pk4_fp8(CV_V(16 * q + 0) * W8_SCALE, CV_V(16 * q + 1) * W8_SCALE, CV_V(16 * q + 2) * W8_SCALE, CV_V(16 * q + 3) * W8_SCALE);
                    w.y = pk4_fp8(CV_V(16 * q + 4) * W8_SCALE, CV_V(16 * q + 5) * W8_SCALE, CV_V(16 * q + 6) * W8_SCALE, CV_V(16 * q + 7) * W8_SCALE);
                    w.z = pk4_fp8(CV_V(16 * q + 8) * W8_SCALE, CV_V(16 * q + 9) * W8_SCALE, CV_V(16 * q + 10) * W8_SCALE, CV_V(16 * q + 11) * W8_SCALE);
                    w.w = pk4_fp8(CV_V(16 * q + 12) * W8_SCALE, CV_V(16 * q + 13) * W8_SCALE, CV_V(16 * q + 14) * W8_SCALE, CV_V(16 * q + 15) * W8_SCALE);
                    *(LAS v4u*)(rp + 4 * q) = w; }
            } else {
#pragma unroll
                for (int q = 0; q < 4; ++q) { v4u w;
                    w.x = pk2(CV_V(8 * q + 0), CV_V(8 * q + 1)); w.y = pk2(CV_V(8 * q + 2), CV_V(8 * q + 3)); w.z = pk2(CV_V(8 * q + 4), CV_V(8 * q + 5)); w.w = pk2(CV_V(8 * q + 6), CV_V(8 * q + 7));
                    *(LAS v4u*)(rp + 4 * q) = w; }
            }
#undef CV_V
        }
        const int nit = it + NGW;
        if (nit < NITEMS) { nx = t_decode(F, CV_MAP(nit));
#pragma unroll
            for (int i = 0; i < 32; ++i) v[i] = __builtin_nontemporal_load((const f32x4*)(nx.src + (size_t)i * nx.N)); }
        asm volatile("s_waitcnt lgkmcnt(0)" ::: "memory");
        if constexpr (F8) { const int c = F.lane & 7;
#pragma unroll
            for (int j = 0; j < 8; ++j) { const int n = (F.lane >> 3) + 8 * j; const v4u o = *(const LAS v4u*)(scr + n * P + 4 * c);
                __builtin_nontemporal_store(o, (v4u*)(cur.dst + (size_t)n * cur.pitch + 16 * c)); }
        } else { const int c = F.lane & 15;
#pragma unroll
            for (int j = 0; j < 16; ++j) { const int n = (F.lane >> 4) + 4 * j; const v4u o = *(const LAS v4u*)(scr + n * P + 4 * c);
                __builtin_nontemporal_store(o, (v4u*)(cur.dst + (size_t)n * cur.pitch + 16 * c)); }
        }
        asm volatile("s_waitcnt lgkmcnt(0)" ::: "memory");
        cur = nx; it = nit;
    }
#undef CV_MAP
}
__device__ __forceinline__ void p0_convert(Frame& F) {
    convert_items<false>(F, 0, CV_NITEMS, CV_GU0, CV_DOWN_END, F.bid * 8 + F.wave, F.G * 8, 0);
    convert_items<true>(F, CV_GU0, CV_DOWN0, 0, 0, F.bid * 8 + F.wave, F.G * 8, 0);
    const int gt = F.bid * NTHR + F.tid, NGT = F.G * NTHR;
    float* wrt = WSP(float, WS_WRT);
    bf16* wrh = WSP(bf16, WS_WRH); bf16* wrl = WSP(bf16, WS_WRL);
    for (int i = gt; i < 2 * 16 * 4096; i += NGT) { const int l = i >> 16, e = (i >> 12) & 15, k = i & 4095; const float w = F.in[21][(size_t)l * 65536 + k * 16 + e]; wrt[i] = w;
        const unsigned hi = f2bf(w); wrh[i] = (bf16)hi; wrl[i] = (bf16)f2bf(w - bf2f(hi)); }
    float* ls8 = WSP(float, WS_LS8);
    for (int i = gt; i < 2 * DLRU; i += NGT) ls8[i] = 8.0f * logsigmoidf_(F.in[13][i]);
}

__device__ __forceinline__ void p0_adaln(Frame& F) {
    LAS float* sc = (LAS float*)F.lds;
    LAS float* red = (LAS float*)(F.lds + 49152);
    constexpr int NIT = 2 * 384;
    if (F.bid >= NIT) return;
    for (int i = F.tid; i < 3 * D; i += NTHR) { const int r = i >> 12, k = i & 4095; const float v = r < 2 ? F.in[1][r * D + k] : F.in[3][k]; sc[i] = siluf_(v); }
    __syncthreads();
    float* mod = WSP(float, WS_MOD);
    for (int it = F.bid; it < NIT; it += F.G) {
        const int l = it / 384, n0 = (it % 384) * 64;
        const float* W = F.in[4] + (size_t)l * D * 24576 + n0 + F.lane;
        float a0 = 0.f, a1 = 0.f, a2 = 0.f;
        const int kbeg = F.wave * 512;
#pragma unroll 64
        for (int k = kbeg; k < kbeg + 512; ++k) { const float w = __builtin_nontemporal_load(W + (size_t)k * 24576); a0 += sc[k] * w; a1 += sc[D + k] * w; a2 += sc[2 * D + k] * w; }
        red[(F.wave * 3 + 0) * 64 + F.lane] = a0; red[(F.wave * 3 + 1) * 64 + F.lane] = a1; red[(F.wave * 3 + 2) * 64 + F.lane] = a2;
        __syncthreads();
        if (F.tid < 192) { const int r = F.tid >> 6, ln = F.tid & 63; float s = 0.f;
#pragma unroll
            for (int w = 0; w < 8; ++w) s += red[(w * 3 + r) * 64 + ln];
            mod[((size_t)l * 3 + r) * 24576 + n0 + ln] = s + F.in[5][l * 24576 + n0 + ln]; }
        __syncthreads();
    }
}

struct Row8 { f32x4 a[8], b[8]; };
__device__ __forceinline__ void ld_row8(Row8& r, const float* p, int lane) {
#pragma unroll
    for (int j = 0; j < 8; ++j) { const float* q = p + 8 * (lane + 64 * j); r.a[j] = *(const f32x4*)q; r.b[j] = *(const f32x4*)(q + 4); }
}
__device__ __forceinline__ void ld_row8_raw(v4u (&h)[8], const bf16* p, int lane) {
#pragma unroll
    for (int j = 0; j < 8; ++j) h[j] = *(const v4u*)(p + 8 * (lane + 64 * j));
}
__device__ __forceinline__ void row8_from_raw(Row8& r, const v4u (&h)[8]) {
#pragma unroll
    for (int j = 0; j < 8; ++j) { r.a[j] = (f32x4){bflo(h[j].x), bfhi(h[j].x), bflo(h[j].y), bfhi(h[j].y)}; r.b[j] = (f32x4){bflo(h[j].z), bfhi(h[j].z), bflo(h[j].w), bfhi(h[j].w)}; }
}
__device__ __forceinline__ void row8_stats(const Row8& r, float& mean, float& rstd) {
    float s = 0.f;
#pragma unroll
    for (int j = 0; j < 8; ++j) s += ((r.a[j].x + r.a[j].y) + (r.a[j].z + r.a[j].w)) + ((r.b[j].x + r.b[j].y) + (r.b[j].z + r.b[j].w));
    mean = wave_sum(s) * (1.f / D);
    float q = 0.f;
#pragma unroll
    for (int j = 0; j < 8; ++j) { const f32x4 d0 = r.a[j] - mean, d1 = r.b[j] - mean; q += ((d0.x * d0.x + d0.y * d0.y) + (d0.z * d0.z + d0.w * d0.w)) + ((d1.x * d1.x + d1.y * d1.y) + (d1.z * d1.z + d1.w * d1.w)); }
    rstd = 1.f / sqrtf(wave_sum(q) * (1.f / D) + LN_EPS);
}
__device__ __forceinline__ v4u pack8(const f32x4& a, const f32x4& b) { v4u o; o.x = pk2(a.x, a.y); o.y = pk2(a.z, a.w); o.z = pk2(b.x, b.y); o.w = pk2(b.z, b.w); return o; }
__device__ __forceinline__ int group_mod(int g) { return g < 512 ? 0 : (g < 1024 ? 1 : 2); }
__device__ __forceinline__ void stage_vec(LAS float* dst, const float* src, int n, int tid) { for (int i = tid * 4; i < n; i += NTHR * 4) *(LAS f32x4*)(dst + i) = *(const f32x4*)(src + i); }

template <int N> __device__ __forceinline__ void prime_stores(Frame& F) {
    unsigned* dump = WSP(unsigned, WS_DUMP) + F.wave * 2048 + F.lane;
#pragma unroll
    for (int j = 0; j < N; ++j) dump[(j & 31) * 64] = 0u;
}
__device__ __forceinline__ void p1_ln0(Frame& F) {
    bf16* H = WSP(bf16, WS_H); bf16* U = WSP(bf16, WS_U); const float* mod = WSP(float, WS_MOD);
    LAS float* SH = (LAS float*)F.lds; LAS float* SC = SH + D;
    int cur_mod = -1; Row8 cur, nxt;
    { const int g0 = F.bid; if (g0 < MT / 8) { const int row = 8 * g0 + F.wave; ld_row8(cur, row < ML ? F.in[0] + (size_t)row * D : F.in[2] + (size_t)(row - ML) * D, F.lane); prime_stores<16>(F); } }
    for (int g = F.bid; g < MT / 8; g += F.G) {
        const int row = 8 * g + F.wave, mr = group_mod(g);
        if (mr != cur_mod) { __syncthreads(); stage_vec(SH, mod + (size_t)mr * 24576, D, F.tid); stage_vec(SC, mod + (size_t)mr * 24576 + D, D, F.tid); __syncthreads(); cur_mod = mr; }
        const int gn = g + F.G; if (gn < MT / 8) { const int rn = 8 * gn + F.wave; ld_row8(nxt, rn < ML ? F.in[0] + (size_t)rn * D : F.in[2] + (size_t)(rn - ML) * D, F.lane); }
        float mean, rstd; row8_stats(cur, mean, rstd);
#pragma unroll
        for (int j = 0; j < 8; ++j) { const int c = 8 * (F.lane + 64 * j); const f32x4 y0 = (cur.a[j] - mean) * rstd, y1 = (cur.b[j] - mean) * rstd;
            *(v4u*)(H + (size_t)row * D + c) = pack8(y0, y1);
            const f32x4 u0 = y0 * (1.f + *(const LAS f32x4*)(SC + c)) + *(const LAS f32x4*)(SH + c), u1 = y1 * (1.f + *(const LAS f32x4*)(SC + c + 4)) + *(const LAS f32x4*)(SH + c + 4);
            *(v4u*)(U + (size_t)row * D + c) = pack8(u0, u1); }
        cur = nxt;
    }
    __syncthreads();
}

using pg8::Unit;
struct EpiBf16Plain {
    static constexpr bool PERM = true;
    bf16* O; int ldc;
    __device__ __forceinline__ void operator()(const f32x4 (&acc)[2][2][4][2], const Unit& u, int wr, int wc, int fr, int fq) const {
        const int row0 = u.pm * 256 + wr * 64 + fr, col0 = u.pn * 256 + wc * 32 + 8 * fq;
#pragma unroll
        for (int ai = 0; ai < 2; ++ai)
#pragma unroll
            for (int m = 0; m < 4; ++m) { bf16* rowp = O + (size_t)(row0 + ai * 128 + m * 16) * ldc + col0;
#pragma unroll
                for (int bj = 0; bj < 2; ++bj) { const f32x4 v0 = acc[ai][bj][m][0], v1 = acc[ai][bj][m][1];
                    v4u w; w.x = pg8::cvt_pk_bf16(v0[0], v0[1]); w.y = pg8::cvt_pk_bf16(v0[2], v0[3]); w.z = pg8::cvt_pk_bf16(v1[0], v1[1]); w.w = pg8::cvt_pk_bf16(v1[2], v1[3]);
                    *(v4u*)(rowp + bj * 128) = w; } }
    }
};
struct EpiOddIn {
    static constexpr bool PERM = true;
    bf16* O; float* Gt; const float* gb;
    __device__ __forceinline__ void operator()(const f32x4 (&acc)[2][2][4][2], const Unit& u, int wr, int wc, int fr, int fq) const {
        const int row0 = u.pm * 256 + wr * 64 + fr;
        if (u.pn < 48) {
            const int col0 = u.pn * 256 + wc * 32 + 8 * fq;
#pragma unroll
            for (int ai = 0; ai < 2; ++ai)
#pragma unroll
                for (int m = 0; m < 4; ++m) { bf16* rowp = O + (size_t)(row0 + ai * 128 + m * 16) * DIN1 + col0;
#pragma unroll
                    for (int bj = 0; bj < 2; ++bj) { const f32x4 v0 = acc[ai][bj][m][0], v1 = acc[ai][bj][m][1];
                        v4u w; w.x = pg8::cvt_pk_bf16(v0[0], v0[1]); w.y = pg8::cvt_pk_bf16(v0[2], v0[3]); w.z = pg8::cvt_pk_bf16(v1[0], v1[1]); w.w = pg8::cvt_pk_bf16(v1[2], v1[3]);
                        *(v4u*)(rowp + bj * 128) = w; } }
        } else if (wc == 0) {
            const int c0 = 8 * fq; const f32x4 b0 = *(const f32x4*)(gb + c0), b1 = *(const f32x4*)(gb + c0 + 4);
#pragma unroll
            for (int ai = 0; ai < 2; ++ai)
#pragma unroll
                for (int m = 0; m < 4; ++m) { float* rowp = Gt + (size_t)(row0 + ai * 128 + m * 16) * 32 + c0;
                    *(f32x4*)(rowp) = acc[ai][0][m][0] + b0; *(f32x4*)(rowp + 4) = acc[ai][0][m][1] + b1; }
        }
    }
};
struct EpiSlab {
    static constexpr bool PERM = false;
    float* slab; int nS;
    __device__ __forceinline__ void operator()(const f32x4 (&acc)[2][2][4][2], const Unit& u, int wr, int wc, int fr, int fq) const {
        float* base = slab + (size_t)(u.t * nS + u.ks) * 65536 + (wr * 64 + fr) * 256 + wc * 32 + 4 * fq;
#pragma unroll
        for (int ai = 0; ai < 2; ++ai)
#pragma unroll
            for (int m = 0; m < 4; ++m)
#pragma unroll
                for (int bj = 0; bj < 2; ++bj)
#pragma unroll
                    for (int n = 0; n < 2; ++n) *(f32x4*)(base + (ai * 128 + m * 16) * 256 + bj * 128 + n * 16) = acc[ai][bj][m][n];
    }
};
struct EpiResid {
    static constexpr bool PERM = false;
    float* H; const float* modl;
    int goff;
    __device__ __forceinline__ void operator()(const f32x4 (&acc)[2][2][4][2], const Unit& u, int wr, int wc, int fr, int fq) const {
        const int row0 = u.pm * 256 + wr * 64 + fr, col0 = u.pn * 256 + wc * 32 + 4 * fq;
        const float* gv = modl + (size_t)row_mod(u.pm * 256) * 24576 + goff + col0;
        f32x4 g[2][2];
#pragma unroll
        for (int bj = 0; bj < 2; ++bj)
#pragma unroll
            for (int n = 0; n < 2; ++n) g[bj][n] = *(const f32x4*)(gv + bj * 128 + n * 16);
#pragma unroll
        for (int ai = 0; ai < 2; ++ai)
#pragma unroll
            for (int m = 0; m < 4; ++m) { float* rowp = H + (size_t)(row0 + ai * 128 + m * 16) * D + col0;
#pragma unroll
                for (int bj = 0; bj < 2; ++bj)
#pragma unroll
                    for (int n = 0; n < 2; ++n) { const f32x4 h = *(const f32x4*)(rowp + bj * 128 + n * 16); *(f32x4*)(rowp + bj * 128 + n * 16) = DN_ALPHA * h + g[bj][n] * acc[ai][bj][m][n]; }
                asm volatile("" ::: "memory"); }
    }
};
struct EpiPool {
    static constexpr bool PERM = true;
    bf16* A2; const float* ps;
    __device__ __forceinline__ void operator()(const f32x4 (&acc)[2][2][4][2], const Unit& u, int wr, int wc, int fr, int fq) const {
        const int row0 = u.pm * 256 + wr * 64 + fr, col0 = 512 * u.g + u.pn * 256 + wc * 32 + 8 * fq;
#pragma unroll
        for (int ai = 0; ai < 2; ++ai)
#pragma unroll
            for (int m = 0; m < 4; ++m) { bf16* rowp = A2 + (size_t)(row0 + ai * 128 + m * 16) * D + 2048 + col0;
#pragma unroll
                for (int bj = 0; bj < 2; ++bj) { const f32x4 s0 = *(const f32x4*)(ps + col0 + bj * 128), s1 = *(const f32x4*)(ps + col0 + bj * 128 + 4);
                    const f32x4 v0 = acc[ai][bj][m][0] * s0, v1 = acc[ai][bj][m][1] * s1;
                    v4u w; w.x = pg8::cvt_pk_bf16(v0[0], v0[1]); w.y = pg8::cvt_pk_bf16(v0[2], v0[3]); w.z = pg8::cvt_pk_bf16(v1[0], v1[1]); w.w = pg8::cvt_pk_bf16(v1[2], v1[3]);
                    *(v4u*)(rowp + bj * 128) = w; } }
    }
};
struct EpiGU {
    static constexpr bool PERM = true;
    unsigned char* ACT; int er;
    __device__ __forceinline__ void operator()(const f32x4 (&acc)[2][2][4][2], const Unit& u, int wr, int wc, int fr, int fq) const {
        const int row0 = u.pm * 256 + wr * 64 + fr, col0 = u.pn * 128 + wc * 32 + 8 * fq;
        unsigned char* base = ACT + (size_t)u.g * er * DE;
#pragma unroll
        for (int ai = 0; ai < 2; ++ai)
#pragma unroll
            for (int m = 0; m < 4; ++m) { unsigned char* rowp = base + (size_t)(row0 + ai * 128 + m * 16) * DE + col0;
                f32x4 v0, v1;
#pragma unroll
                for (int j = 0; j < 4; ++j) { v0[j] = siluf_(acc[ai][0][m][0][j] * W8_INV) * (acc[ai][1][m][0][j] * W8_INV); v1[j] = siluf_(acc[ai][0][m][1][j] * W8_INV) * (acc[ai][1][m][1][j] * W8_INV); }
                v2u w; w.x = pk4_fp8(v0[0], v0[1], v0[2], v0[3]); w.y = pk4_fp8(v1[0], v1[1], v1[2], v1[3]);
                *(v2u*)(rowp) = w; }
    }
};
struct EpiDown {
    static constexpr bool PERM = true;
    bf16* YE; const float* GX; int er;
    __device__ __forceinline__ void operator()(const f32x4 (&acc)[2][2][4][2], const Unit& u, int wr, int wc, int fr, int fq) const {
        const int row0 = u.pm * 256 + wr * 64 + fr, col0 = u.pn * 256 + wc * 32 + 8 * fq;
        bf16* base = YE + (size_t)u.g * er * D; const float* gx = GX + u.g * er;
#pragma unroll
        for (int ai = 0; ai < 2; ++ai)
#pragma unroll
            for (int m = 0; m < 4; ++m) { const int row = row0 + ai * 128 + m * 16; const float s = gx[row] * W8_INV; bf16* rowp = base + (size_t)row * D + col0;
#pragma unroll
                for (int bj = 0; bj < 2; ++bj) { const f32x4 v0 = acc[ai][bj][m][0] * s, v1 = acc[ai][bj][m][1] * s;
                    v4u w; w.x = pg8::cvt_pk_bf16(v0[0], v0[1]); w.y = pg8::cvt_pk_bf16(v0[2], v0[3]); w.z = pg8::cvt_pk_bf16(v1[0], v1[1]); w.w = pg8::cvt_pk_bf16(v1[2], v1[3]);
                    __builtin_nontemporal_store(w, (v4u*)(rowp + bj * 128)); } }
    }
};
constexpr int LRU_XC = 0, LRU_AF = 17408, LRU_BF = 50176, LRU_SG = 82944, LRU_XT = 87040, LRU_CW = 105472;
constexpr size_t WS_LS = WS_XE, WS_LPF = WS_XE + (size_t)MT * DLRU * 2, WS_LPB = WS_XE + (size_t)MT * DLRU * 4;
#ifndef RSEL
#define RSEL 0
#endif
#define RT4(k) do { if (RSEL) { const unsigned long long tn_ = __builtin_amdgcn_s_memrealtime(); if (RSEL == (k)) *racc += tn_ - rprev; rprev = tn_; } } while (0)
__device__ __forceinline__ void lru_phase(Frame& F, unsigned long long* racc = nullptr) {
    unsigned long long rprev = RSEL ? __builtin_amdgcn_s_memrealtime() : 0ull;
    const bf16* XZS = WSP(bf16, WS_BIG);
    const bf16* GWT = WSP(bf16, WS_GWT);
    const float* LS8 = WSP(float, WS_LS8);
    float* SUMM = WSP(float, WS_SUMM);
    bf16* LSb = WSP(bf16, WS_LS); bf16* LPF = WSP(bf16, WS_LPF); bf16* LPB = WSP(bf16, WS_LPB);
    const float* convw = F.in[9]; const float* convb = F.in[10]; const float* gateb = F.in[12];
    const int wr = F.wave >> 2, wc = F.wave & 3, fr = F.lane & 15, fq = F.lane >> 4;
    LAS unsigned char* XC = F.lds + LRU_XC; LAS float* AF = (LAS float*)(F.lds + LRU_AF); LAS float* BF = (LAS float*)(F.lds + LRU_BF); LAS float* SG = (LAS float*)(F.lds + LRU_SG); LAS unsigned char* XT = F.lds + LRU_XT; LAS float* CW = (LAS float*)(F.lds + LRU_CW);
    const bool hfixed = (F.G & 15) == 0;
#pragma unroll 1
    for (int d = 0; d < 2; ++d) {
        bf16x8 bfr[2][2][4];
        f32x4 gb0[2], gb1[2], l8[2];
        int hcur = -1;
        v4u xpre[3];
#define LRU_XLOAD(u_) do { const int tt_ = (u_) >> 4, h_ = (u_) & 15, r0_ = tile_row0(tt_); int lo_, hi_; tile_seq(tt_, lo_, hi_); \
            _Pragma("unroll") for (int i = 0; i < 3; ++i) { const int q = F.tid + NTHR * i, row = r0_ - 1 + (q >> 4); const bool ok = q < 67 * 16 && row >= lo_ && row < hi_; \
                const v4u xv_ = *(const v4u*)(XZS + (size_t)(ok ? row : r0_) * DIN0 + h_ * 128 + (q & 15) * 8); xpre[i] = ok ? xv_ : (v4u){0u, 0u, 0u, 0u}; } } while (0)
        for (int unit = F.bid; unit < NT_TILES * LRUH; unit += F.G) {
            const int tt = unit >> 4, h = unit & 15;
            const int r0 = tile_row0(tt); int slo, shi; tile_seq(tt, slo, shi);
            if (h != hcur) {
                hcur = h;
                __syncthreads();
                for (int i = F.tid; i < 640; i += NTHR) CW[i] = i < 512 ? convw[(i >> 7) * DLRU + h * 128 + (i & 127)] : convb[h * 128 + (i - 512)];
#pragma unroll
                for (int g = 0; g < 2; ++g)
#pragma unroll
                    for (int n = 0; n < 2; ++n)
#pragma unroll
                        for (int ks = 0; ks < 4; ++ks) bfr[g][n][ks] = *(const bf16x8*)(GWT + (size_t)((d * 2 + g) * 16 + h) * 16384 + (32 * wc + 16 * n + fr) * 128 + ks * 32 + fq * 8);
#pragma unroll
                for (int n = 0; n < 2; ++n) { const int ch = h * 128 + 32 * wc + 16 * n + 4 * fq;
                    gb0[n] = *(const f32x4*)(gateb + (d * 2 + 0) * DLRU + ch); gb1[n] = *(const f32x4*)(gateb + (d * 2 + 1) * DLRU + ch); l8[n] = *(const f32x4*)(LS8 + d * DLRU + ch); }
            }
            if (unit == F.bid) { LRU_XLOAD(unit); }
#pragma unroll
            for (int i = 0; i < 3; ++i) { const int q = F.tid + NTHR * i; if (q < 67 * 16) *(LAS v4u*)(XT + (q >> 4) * 272 + (q & 15) * 16) = xpre[i]; }
            __syncthreads();
            if (unit + F.G < NT_TILES * LRUH) { LRU_XLOAD(unit + F.G); }
            f32x4 xcv[2][2];
#pragma unroll
            for (int m = 0; m < 2; ++m)
#pragma unroll
                for (int n = 0; n < 2; ++n) {
                    const int t = 32 * wr + 16 * m + fr, c = 32 * wc + 16 * n + 4 * fq;
                    f32x4 a = *(const LAS f32x4*)(CW + 512 + c);
#pragma unroll
                    for (int j = 0; j < 4; ++j) { const v2u xv = *(const LAS v2u*)(XT + (t + j) * 272 + c * 2); const f32x4 w = *(const LAS f32x4*)(CW + j * 128 + c);
                        a.x += w.x * bflo(xv.x); a.y += w.y * bfhi(xv.x); a.z += w.z * bflo(xv.y); a.w += w.w * bfhi(xv.y); }
                    xcv[m][n] = a;
                    v2u o; o.x = pk2(a.x, a.y); o.y = pk2(a.z, a.w); *(LAS v2u*)(XC + t * 272 + c * 2) = o;
                }
            __syncthreads();
            RT4(12);
            f32x4 acc[2][2][2];
#pragma unroll
            for (int g = 0; g < 2; ++g)
#pragma unroll
                for (int m = 0; m < 2; ++m)
#pragma unroll
                    for (int n = 0; n < 2; ++n) acc[g][m][n] = (f32x4){0.f, 0.f, 0.f, 0.f};
#pragma unroll
            for (int ks = 0; ks < 4; ++ks) {
                bf16x8 af[2];
#pragma unroll
                for (int m = 0; m < 2; ++m) af[m] = *(const LAS bf16x8*)(XC + (32 * wr + 16 * m + fr) * 272 + (ks * 32 + fq * 8) * 2);
#pragma unroll
                for (int g = 0; g < 2; ++g)
#pragma unroll
                    for (int n = 0; n < 2; ++n)
#pragma unroll
                        for (int m = 0; m < 2; ++m) acc[g][m][n] = __builtin_amdgcn_mfma_f32_16x16x32_bf16(bfr[g][n][ks], af[m], acc[g][m][n], 0, 0, 0);
            }
#pragma unroll
            for (int m = 0; m < 2; ++m)
#pragma unroll
                for (int n = 0; n < 2; ++n) {
                    const int t = 32 * wr + 16 * m + fr, c = 32 * wc + 16 * n + 4 * fq;
                    f32x4 av, bv;
#pragma unroll
                    for (int j = 0; j < 4; ++j) { const float r = sigmoidf_(acc[0][m][n][j] + gb0[n][j]), ig = sigmoidf_(acc[1][m][n][j] + gb1[n][j]);
                        const float la = l8[n][j] * r, em1 = expm1_small(la); av[j] = 1.f + em1; bv[j] = __builtin_amdgcn_sqrtf(-em1 * (2.f + em1)) * ig * xcv[m][n][j]; }
                    *(LAS f32x4*)(AF + t * 128 + c) = av; *(LAS f32x4*)(BF + t * 128 + c) = bv;
                }
            __syncthreads();
            RT4(13);
            {
                const int c = F.tid & 127, seg = F.tid >> 7, ch = h * 128 + c;
                const int tb = d == 0 ? 16 * seg : 16 * seg + 15, ts = d == 0 ? 1 : -1;
                float hs = 0.f, P = 1.f;
#pragma unroll
                for (int i = 0; i < 16; ++i) { const int t = tb + ts * i; const float a = AF[t * 128 + c]; hs = a * hs + BF[t * 128 + c]; P *= a; }
                SG[(seg * 2 + 0) * 128 + c] = P; SG[(seg * 2 + 1) * 128 + c] = hs;
                __syncthreads();
                float Pin = 1.f, Hin = 0.f;
#pragma unroll
                for (int q = 0; q < 3; ++q) { const int sgi = d == 0 ? q : 3 - q; const bool before = d == 0 ? (sgi < seg) : (sgi > seg);
                    if (before) { const float Pq = SG[(sgi * 2 + 0) * 128 + c]; Hin = Pq * Hin + SG[(sgi * 2 + 1) * 128 + c]; Pin *= Pq; } }
                hs = Hin; P = Pin;
#pragma unroll
                for (int i = 0; i < 16; ++i) { const int t = tb + ts * i; const float a = AF[t * 128 + c]; hs = a * hs + BF[t * 128 + c]; P *= a; AF[t * 128 + c] = P; BF[t * 128 + c] = hs; }
                if (seg == (d == 0 ? 3 : 0)) { SUMM[((size_t)(tt * 2 + d) * 2 + 0) * DLRU + ch] = P; SUMM[((size_t)(tt * 2 + d) * 2 + 1) * DLRU + ch] = hs; }
            }
            __syncthreads();
            RT4(14);
            {
                const int et = F.tid >> 3, ecg = (F.tid & 7) * 16;
                const size_t go = (size_t)(r0 + et) * DLRU + h * 128 + ecg; f32x4 pv[4], hv[4];
#pragma unroll
                for (int i = 0; i < 4; ++i) { pv[i] = *(const LAS f32x4*)(AF + et * 128 + ecg + 4 * i); hv[i] = *(const LAS f32x4*)(BF + et * 128 + ecg + 4 * i); }
                bf16* pdst = d == 0 ? LPF : LPB;
                *(v4u*)(pdst + go) = pack8(pv[0], pv[1]); *(v4u*)(pdst + go + 8) = pack8(pv[2], pv[3]);
                if (d == 1) { const v4u f0 = *(const v4u*)(LSb + go), f1 = *(const v4u*)(LSb + go + 8);
                    hv[0] += (f32x4){bflo(f0.x), bfhi(f0.x), bflo(f0.y), bfhi(f0.y)}; hv[1] += (f32x4){bflo(f0.z), bfhi(f0.z), bflo(f0.w), bfhi(f0.w)};
                    hv[2] += (f32x4){bflo(f1.x), bfhi(f1.x), bflo(f1.y), bfhi(f1.y)}; hv[3] += (f32x4){bflo(f1.z), bfhi(f1.z), bflo(f1.w), bfhi(f1.w)}; }
                *(v4u*)(LSb + go) = pack8(hv[0], hv[1]); *(v4u*)(LSb + go + 8) = pack8(hv[2], hv[3]);
            }
            __syncthreads();
            RT4(15);
        }
        asm volatile("s_waitcnt vmcnt(0)" ::: "memory");
#undef LRU_XLOAD
    }
}
__device__ __forceinline__ void lru_apply(Frame& F) {
    const bf16* XZS = WSP(bf16, WS_BIG); const float* CARRY = WSP(float, WS_CARRY); bf16* A2 = WSP(bf16, WS_A2);
    const bf16* LSb = WSP(bf16, WS_LS); const bf16* LPF = WSP(bf16, WS_LPF); const bf16* LPB = WSP(bf16, WS_LPB);
    const int gt = F.bid * NTHR + F.tid, NGT = F.G * NTHR;
    for (int i = gt; i < MT * (DLRU / 8); i += NGT) {
        const int row = i >> 8, c = (i & 255) * 8; const int tt = row < ML ? (row >> 6) : 128 + ((row - ML) >> 6);
        const size_t go = (size_t)row * DLRU + c;
        const v4u sv = *(const v4u*)(LSb + go), pf = *(const v4u*)(LPF + go), pb = *(const v4u*)(LPB + go), zv = *(const v4u*)(XZS + (size_t)row * DIN0 + DLRU + c);
        const f32x4 cf0 = *(const f32x4*)(CARRY + (size_t)(tt * 2 + 0) * DLRU + c), cf1 = *(const f32x4*)(CARRY + (size_t)(tt * 2 + 0) * DLRU + c + 4);
        const f32x4 cb0 = *(const f32x4*)(CARRY + (size_t)(tt * 2 + 1) * DLRU + c), cb1 = *(const f32x4*)(CARRY + (size_t)(tt * 2 + 1) * DLRU + c + 4);
        v4u o;
#pragma unroll
        for (int k = 0; k < 4; ++k) { const float fa = k < 2 ? cf0[2 * k] : cf1[2 * k - 4], fb = k < 2 ? cf0[2 * k + 1] : cf1[2 * k - 3], ba = k < 2 ? cb0[2 * k] : cb1[2 * k - 4], bb = k < 2 ? cb0[2 * k + 1] : cb1[2 * k - 3];
            const float v0 = (bflo(sv[k]) + bflo(pf[k]) * fa + bflo(pb[k]) * ba) * gelu_tanh(bflo(zv[k])), v1 = (bfhi(sv[k]) + bfhi(pf[k]) * fb + bfhi(pb[k]) * bb) * gelu_tanh(bfhi(zv[k]));
            o[k] = pk2(v0, v1); }
        *(v4u*)(A2 + (size_t)row * D + c) = o;
    }
}

__device__ __forceinline__ void lru_carry(Frame& F) {
    const float* SUMM = WSP(float, WS_SUMM); float* CARRY = WSP(float, WS_CARRY);
    const int gt = F.bid * NTHR + F.tid, NGT = F.G * NTHR;
    for (int i = gt; i < NB * 2 * DLRU; i += NGT) {
        const int ch = i & 2047, d = (i >> 11) & 1, b = i >> 12;
        float st = 0.f;
#pragma unroll 1
        for (int half = 0; half < 2; ++half) {
            float Pv[34], Hv[34];
#pragma unroll
            for (int q = 0; q < 34; ++q) { const int s = half * 34 + q; const int tt = s < 4 ? 128 + 4 * b + (d ? 3 - s : s) : 64 * b + (d ? 63 - (s - 4) : (s - 4));
                Pv[q] = SUMM[((size_t)(tt * 2 + d) * 2 + 0) * DLRU + ch]; Hv[q] = SUMM[((size_t)(tt * 2 + d) * 2 + 1) * DLRU + ch]; }
#pragma unroll
            for (int q = 0; q < 34; ++q) { const int s = half * 34 + q; const int tt = s < 4 ? 128 + 4 * b + (d ? 3 - s : s) : 64 * b + (d ? 63 - (s - 4) : (s - 4));
                CARRY[(size_t)(tt * 2 + d) * DLRU + ch] = st; st = Pv[q] * st + Hv[q]; }
        }
    }
}

__device__ __forceinline__ int pool_w_of(int g) { return 2 << g; }
__device__ __forceinline__ void pool_pass1(Frame& F) {
    const bf16* XZS = WSP(bf16, WS_BIG); float* CM = WSP(float, WS_CM);
    LAS unsigned char* T = F.lds;
    for (int unit = F.bid; unit < NB * 64 * 4; unit += F.G) {
        const int g = unit & 3, gr = (unit >> 2) & 63, b = unit >> 8; const int row0 = b * SEQ + gr * 64, w = pool_w_of(g);
        for (int i = F.tid; i < 64 * 64; i += NTHR) { const int r = i >> 6, cseg = i & 63;
            *(LAS v4u*)(T + r * 1024 + cseg * 16) = *(const v4u*)(XZS + (size_t)(row0 + r) * DIN0 + 2 * DLRU + g * 512 + cseg * 8); }
        __syncthreads();
        const int c8 = (F.tid & 63) * 8, part = F.tid >> 6;
#pragma unroll 2
        for (int j = part * 8; j < part * 8 + 8; ++j) {
            const int lo = max(0, j - w / 2), hi = min(64, j + w - w / 2);
            f32x4 s0 = (f32x4){0.f, 0.f, 0.f, 0.f}, s1 = s0;
            for (int q = lo; q < hi; ++q) { const v4u v = *(const LAS v4u*)(T + q * 1024 + c8 * 2);
                s0 += (f32x4){bflo(v.x), bfhi(v.x), bflo(v.y), bfhi(v.y)}; s1 += (f32x4){bflo(v.z), bfhi(v.z), bflo(v.w), bfhi(v.w)}; }
            const float inv = 1.f / (float)(hi - lo);
            float* cp_ = CM + (size_t)(row0 + j) * DPOOL + g * 512 + c8;
            *(f32x4*)cp_ = s0 * inv; *(f32x4*)(cp_ + 4) = s1 * inv;
        }
        __syncthreads();
    }
}
__device__ __forceinline__ void pool_pass2(Frame& F) {
    const bf16* XZS = WSP(bf16, WS_BIG); const float* CM = WSP(float, WS_CM); bf16* DP = WSP(bf16, WS_DP);
    LAS float* T = (LAS float*)F.lds;
    for (int unit = F.bid; unit < NB * 64 * 4 * 2; unit += F.G) {
        const int hc = unit & 1, g = (unit >> 1) & 3, gc = (unit >> 3) & 63, b = unit >> 9; const int w = pool_w_of(g), cb = g * 512 + hc * 256;
        for (int i = F.tid; i < 64 * 64; i += NTHR) { const int r = i >> 6, cseg = i & 63;
            *(LAS f32x4*)(T + r * 256 + cseg * 4) = *(const f32x4*)(CM + (size_t)(b * SEQ + r * 64 + gc) * DPOOL + cb + cseg * 4); }
        __syncthreads();
        const int c4 = (F.tid & 63) * 4, part = F.tid >> 6;
        v2u xs[8];
#pragma unroll
        for (int q = 0; q < 8; ++q) xs[q] = *(const v2u*)(XZS + (size_t)(b * SEQ + (part * 8 + q) * 64 + gc) * DIN0 + 2 * DLRU + cb + c4);
#pragma unroll
        for (int q = 0; q < 8; ++q) { const int r = part * 8 + q;
            const int lo = max(0, r - w / 2), hi = min(64, r + w - w / 2);
            f32x4 sm = (f32x4){0.f, 0.f, 0.f, 0.f};
            for (int k = lo; k < hi; ++k) sm += *(const LAS f32x4*)(T + k * 256 + c4);
            const float inv = 1.f / (float)(hi - lo);
            v2u o; o.x = pk2(sm.x * inv - bflo(xs[q].x), sm.y * inv - bfhi(xs[q].x)); o.y = pk2(sm.z * inv - bflo(xs[q].y), sm.w * inv - bfhi(xs[q].y));
            *(v2u*)(DP + (size_t)(b * SEQ + r * 64 + gc) * DPOOL + cb + c4) = o;
        }
        __syncthreads();
    }
}
__device__ __forceinline__ void pool_ctx(Frame& F) {
    const bf16* XZS = WSP(bf16, WS_BIG); bf16* DP = WSP(bf16, WS_DP);
    const int gt = F.bid * NTHR + F.tid, NGT = F.G * NTHR;
    for (int i = gt; i < MC * (DPOOL / 8); i += NGT) {
        const int ch = (i & 255) * 8, r = i >> 8, b = r >> 8, t = r & 255; const int w = pool_w_of(ch >> 9);
        const int lo = max(0, t - w / 2), hi = min(CTXL, t + w - w / 2);
        v4u v[16];
#pragma unroll
        for (int q = 0; q < 16; ++q) { const int k = min(lo + q, CTXL - 1); v[q] = *(const v4u*)(XZS + (size_t)(ML + b * CTXL + k) * DIN0 + 2 * DLRU + ch); }
        const v4u x = *(const v4u*)(XZS + (size_t)(ML + r) * DIN0 + 2 * DLRU + ch);
        f32x4 s0 = (f32x4){0.f, 0.f, 0.f, 0.f}, s1 = s0;
#pragma unroll
        for (int q = 0; q < 16; ++q) { const float m = (lo + q < hi) ? 1.f : 0.f;
            s0 += m * (f32x4){bflo(v[q].x), bfhi(v[q].x), bflo(v[q].y), bfhi(v[q].y)}; s1 += m * (f32x4){bflo(v[q].z), bfhi(v[q].z), bflo(v[q].w), bfhi(v[q].w)}; }
        const float inv = 1.f / (float)(hi - lo);
        const f32x4 o0 = s0 * inv - (f32x4){bflo(x.x), bfhi(x.x), bflo(x.y), bfhi(x.y)}, o1 = s1 * inv - (f32x4){bflo(x.z), bfhi(x.z), bflo(x.w), bfhi(x.w)};
        *(v4u*)(DP + (size_t)(ML + r) * DPOOL + ch) = pack8(o0, o1);
    }
}
#ifndef RSEL
#define RSEL 0
#endif
#define RT(k) do { if (RSEL) { const unsigned long long tn_ = __builtin_amdgcn_s_memrealtime(); if (RSEL == (k)) *racc += tn_ - rprev; rprev = tn_; } } while (0)
__device__ __forceinline__ void ln_router_phase(Frame& F, int l, int nrows, bool probe = false, bool ctx_slab = false, unsigned long long* racc = nullptr) {
    unsigned char* U8 = probe ? WSP(unsigned char, WS_CM) : WSP(unsigned char, WS_U8);
    const bf16* Ymix = WSP(bf16, WS_YE);
    unsigned long long rprev = RSEL ? __builtin_amdgcn_s_memrealtime() : 0ull;
    const bf16* Hin = WSP(bf16, WS_H); bf16* H = probe ? WSP(bf16, WS_XE) : WSP(bf16, WS_H); bf16* U = probe ? WSP(bf16, WS_YE) : WSP(bf16, WS_U); const float* mod = WSP(float, WS_MOD) + (size_t)l * 3 * 24576;
    const f32x4* wrt4 = (const f32x4*)(WSP(float, WS_WRT) + (size_t)l * 16 * D); float* AFF = probe ? WSP(float, WS_CM) : WSP(float, WS_AFF);
    LAS float* LG = (LAS float*)F.lds; LAS float* LB = LG + D; LAS float* SH = LG + 2 * D; LAS float* SC = LG + 3 * D; LAS unsigned char* UH = F.lds + 65536; LAS unsigned char* UL = F.lds + 65536 + 32896; LAS float* RED = (LAS float*)(F.lds + 65536 + 65792);
    const bf16* wrh = WSP(bf16, WS_WRH) + (size_t)l * 16 * D; const bf16* wrl = WSP(bf16, WS_WRL) + (size_t)l * 16 * D;
    const int ngroups = nrows / 8;
    stage_vec(LG, F.in[6] + (size_t)(l * 2 + 0) * D, D, F.tid); stage_vec(LB, F.in[7] + (size_t)(l * 2 + 0) * D, D, F.tid);
    if (ctx_slab) {
        const float* slab = WSP(float, WS_SLAB); const float* gv = mod + (size_t)2 * 24576 + 2 * D; bf16* Hw = WSP(bf16, WS_H);
        for (int g = 1024 + (F.bid + F.G - 1024 % F.G) % F.G; g < ngroups; g += F.G) { const int row = 8 * g + F.wave, r = row - ML;
#pragma unroll 1
            for (int j = 0; j < 8; ++j) { const int c = 8 * (F.lane + 64 * j); const float* sp = slab + (size_t)(((r >> 8) + 2 * (c >> 8)) * 8) * 65536 + (r & 255) * 256 + (c & 255);
                f32x4 s0 = (f32x4){0.f, 0.f, 0.f, 0.f}, s1 = s0;
#pragma unroll
                for (int ks = 0; ks < 8; ++ks) { s0 += *(const f32x4*)(sp + (size_t)ks * 65536); s1 += *(const f32x4*)(sp + (size_t)ks * 65536 + 4); }
                bf16* hp = Hw + (size_t)row * D + c; const v4u hv = *(const v4u*)hp;
                const f32x4 t0 = DN_ALPHA * (f32x4){bflo(hv.x), bfhi(hv.x), bflo(hv.y), bfhi(hv.y)} + *(const f32x4*)(gv + c) * s0, t1 = DN_ALPHA * (f32x4){bflo(hv.z), bfhi(hv.z), bflo(hv.w), bfhi(hv.w)} + *(const f32x4*)(gv + c + 4) * s1;
                *(v4u*)hp = pack8(t0, t1); }
        }
        asm volatile("s_waitcnt vmcnt(0)" ::: "memory");
    }
    int cur_mod = -1; Row8 cur; v4u yrow[8], hraw[8];
#define LNR_LOAD(g_) do { const int row_ = 8 * (g_) + F.wave; ld_row8_raw(hraw, Hin + (size_t)row_ * D, F.lane); { const size_t yr_ = (size_t)((g_) < 1024 ? row_ : 0) * D; _Pragma("unroll") for (int j_ = 0; j_ < 8; ++j_) yrow[j_] = *(const v4u*)(Ymix + yr_ + 8 * (F.lane + 64 * j_)); } } while (0)
    const bool rebal = ctx_slab && F.G == 256 && ngroups == 1088;
#define LNR_GRP(i_) (!rebal ? (F.bid + (i_) * F.G < ngroups ? F.bid + (i_) * F.G : -1) \
        : ((i_) < (F.bid < 64 ? 3 : 4) ? F.bid + 256 * (i_) : ((i_) > (F.bid < 64 ? 3 : 4) ? -1 : (F.bid < 64 ? 1024 + F.bid : (F.bid < 128 ? F.bid + 704 : -1)))))
    int gcur = LNR_GRP(0);
    if (gcur >= 0) { LNR_LOAD(gcur); }
    for (int it = 0; gcur >= 0; ++it) {
        const int g = gcur, gnx = LNR_GRP(it + 1);
        const int row = 8 * g + F.wave, mr = group_mod(g);
        if (mr != cur_mod) { __syncthreads(); stage_vec(SH, mod + (size_t)mr * 24576 + 3 * D, D, F.tid); stage_vec(SC, mod + (size_t)mr * 24576 + 4 * D, D, F.tid); cur_mod = mr; }
        __syncthreads();
        RT(4);
        row8_from_raw(cur, hraw);
        if (g < 1024) {
            const float* gv = mod + (size_t)mr * 24576 + 2 * D;
#pragma unroll
            for (int j = 0; j < 8; ++j) { const int c = 8 * (F.lane + 64 * j); const f32x4 g0 = *(const f32x4*)(gv + c), g1 = *(const f32x4*)(gv + c + 4); const v4u y = yrow[j];
                cur.a[j] = DN_ALPHA * cur.a[j] + g0 * (f32x4){bflo(y.x), bfhi(y.x), bflo(y.y), bfhi(y.y)}; cur.b[j] = DN_ALPHA * cur.b[j] + g1 * (f32x4){bflo(y.z), bfhi(y.z), bflo(y.w), bfhi(y.w)}; if (j & 1) asm volatile("" ::: "memory"); }
        }
        float mean, rstd; row8_stats(cur, mean, rstd);
#pragma unroll
        for (int j = 0; j < 8; ++j) { const int c = 8 * (F.lane + 64 * j);
            const f32x4 y0 = (cur.a[j] - mean) * rstd * *(const LAS f32x4*)(LG + c) + *(const LAS f32x4*)(LB + c), y1 = (cur.b[j] - mean) * rstd * *(const LAS f32x4*)(LG + c + 4) + *(const LAS f32x4*)(LB + c + 4);
            *(v4u*)(H + (size_t)row * D + c) = pack8(y0, y1);
            const f32x4 u0 = y0 * (1.f + *(const LAS f32x4*)(SC + c)) + *(const LAS f32x4*)(SH + c), u1 = y1 * (1.f + *(const LAS f32x4*)(SC + c + 4)) + *(const LAS f32x4*)(SH + c + 4);
            { v2u w8; w8.x = pk4_fp8(u0.x, u0.y, u0.z, u0.w); w8.y = pk4_fp8(u1.x, u1.y, u1.z, u1.w); *(v2u*)(U8 + (size_t)row * D + c) = w8; }
            cur.a[j] = u0; cur.b[j] = u1; }
        RT(1);
        f32x4 racc4 = (f32x4){0.f, 0.f, 0.f, 0.f};
        const int fr = F.lane & 15, fq = F.lane >> 4;
        int opq = 0; asm volatile("" : "+v"(opq));
#pragma unroll
        for (int half = 0; half < 2; ++half) {
            bf16x8 bh[8], bl[8];
#pragma unroll
            for (int ks = 0; ks < 8; ++ks) { const size_t wo = (size_t)(fr * D + 2048 * half + 256 * F.wave + 32 * ks + 8 * fq + opq); bh[ks] = *(const bf16x8*)(wrh + wo); bl[ks] = *(const bf16x8*)(wrl + wo); }
            __syncthreads();
#pragma unroll
            for (int jj = 0; jj < 4; ++jj) { const int j = 4 * half + jj; const f32x4 xa = cur.a[j], xb = cur.b[j];
                const unsigned h0 = pg8::cvt_pk_bf16(xa.x, xa.y), h1 = pg8::cvt_pk_bf16(xa.z, xa.w), h2 = pg8::cvt_pk_bf16(xb.x, xb.y), h3 = pg8::cvt_pk_bf16(xb.z, xb.w);
                v4u hv; hv.x = h0; hv.y = h1; hv.z = h2; hv.w = h3;
                v4u lv; lv.x = pg8::cvt_pk_bf16(xa.x - bflo(h0), xa.y - bfhi(h0)); lv.y = pg8::cvt_pk_bf16(xa.z - bflo(h1), xa.w - bfhi(h1)); lv.z = pg8::cvt_pk_bf16(xb.x - bflo(h2), xb.y - bfhi(h2)); lv.w = pg8::cvt_pk_bf16(xb.z - bflo(h3), xb.w - bfhi(h3));
                const int co = F.wave * 4112 + (8 * (F.lane + 64 * jj)) * 2;
                *(LAS v4u*)(UH + co) = hv; *(LAS v4u*)(UL + co) = lv; }
            __syncthreads();
#pragma unroll
            for (int ks = 0; ks < 8; ++ks) { const int ao = (fr & 7) * 4112 + (256 * F.wave + 32 * ks + 8 * fq) * 2;
                const bf16x8 ah = *(const LAS bf16x8*)(UH + ao), al = *(const LAS bf16x8*)(UL + ao);
                racc4 = __builtin_amdgcn_mfma_f32_16x16x32_bf16(ah, bh[ks], racc4, 0, 0, 0);
                racc4 = __builtin_amdgcn_mfma_f32_16x16x32_bf16(al, bh[ks], racc4, 0, 0, 0);
                racc4 = __builtin_amdgcn_mfma_f32_16x16x32_bf16(ah, bl[ks], racc4, 0, 0, 0); }
        }
        if (fq < 2) {
#pragma unroll
            for (int j = 0; j < 4; ++j) RED[(F.wave * 8 + 4 * fq + j) * 16 + fr] = racc4[j]; }
        __syncthreads();
        float mylogit = 0.f;
        if (F.lane < 16) {
#pragma unroll
            for (int w = 0; w < 8; ++w) mylogit += RED[(w * 8 + F.wave) * 16 + F.lane]; }
        if (gnx >= 0) { LNR_LOAD(gnx); }
        RT(2);
        float v = F.lane < 16 ? mylogit : -3.0e38f;
        const float mx = wave_max(v); const float ex = F.lane < 16 ? __expf(v - mx) : 0.f; const float den = wave_sum(ex);
        if (F.lane < 16) { int sq, n; if (row < ML) { sq = row >> 12; n = row & 4095; } else { sq = 2 + ((row - ML) >> 8); n = (row - ML) & 255; }
            AFF[((size_t)sq * 16 + F.lane) * SEQ + n] = ex / den; }
        RT(3);
        gcur = gnx;
    }
#undef LNR_GRP
#undef LNR_LOAD
    __syncthreads();
}

__device__ __forceinline__ unsigned block_excl_scan(unsigned v, LAS unsigned* wsum, int tid, int lane, int wave, unsigned& tot) {
    unsigned inc = v;
#pragma unroll
    for (int o = 1; o < 64; o <<= 1) { const unsigned t = __shfl_up(inc, o); if (lane >= o) inc += t; }
    __syncthreads();
    if (lane == 63) wsum[wave] = inc;
    __syncthreads();
    unsigned off = 0; tot = 0;
#pragma unroll
    for (int w = 0; w < 8; ++w) { const unsigned x = wsum[w]; if (w < wave) off += x; tot += x; }
    return off + inc - v;
}
template <int SHIFT, int NB>
__device__ __forceinline__ void radix_pass(const unsigned (&key)[8], bool valid, unsigned& prefix, unsigned& pmask, unsigned& need, LAS unsigned* hist, LAS unsigned* wsum, LAS unsigned* bc, int tid, int lane, int wave) {
    constexpr int PER = NB / NTHR;
    __syncthreads();
    for (int i = tid; i < NB; i += NTHR) hist[i] = 0u;
    if (tid == 0) { bc[0] = 0u; bc[1] = 1u; }
    __syncthreads();
    if (valid) {
#pragma unroll
        for (int r = 0; r < 8; ++r) if ((key[r] & pmask) == prefix) __hip_atomic_fetch_add(&hist[(key[r] >> SHIFT) & (unsigned)(NB - 1)], 1u, __ATOMIC_RELAXED, __HIP_MEMORY_SCOPE_WORKGROUP); }
    __syncthreads();
    unsigned c[PER], tot = 0u;
#pragma unroll
    for (int q = 0; q < PER; ++q) { c[q] = hist[NB - 1 - (tid * PER + q)]; tot += c[q]; }
    unsigned dummy; unsigned above = block_excl_scan(tot, wsum, tid, lane, wave, dummy);
#pragma unroll
    for (int q = 0; q < PER; ++q) { if (above < need && above + c[q] >= need) { bc[0] = (unsigned)(NB - 1 - (tid * PER + q)); bc[1] = need - above; } above += c[q]; }
    __syncthreads();
    const unsigned digit = bc[0]; need = bc[1];
    prefix |= digit << SHIFT; pmask |= (unsigned)(NB - 1) << SHIFT;
}
__device__ __forceinline__ void topk_phase(Frame& F, int nseq, int er) {
    const float* AFF = WSP(float, WS_AFF); int* XR = WSP(int, WS_IDX); float* GX = WSP(float, WS_GX); int* INV = WSP(int, WS_INV);
    LAS unsigned* hist = (LAS unsigned*)F.lds; LAS unsigned* wsum = hist + 2048; LAS unsigned* bc = hist + 2048 + 16;
    const int tid = F.tid;
    for (int p = F.bid; p < nseq * 16; p += F.G) {
        const int s = p >> 4, e = p & 15, n = seq_len(s), cap = n >> 3;
        const bool valid = tid * 8 < n;
        unsigned key[8];
        { const float* ap = AFF + ((size_t)s * 16 + e) * SEQ + (valid ? tid * 8 : 0); const v4u k0 = *(const v4u*)ap, k1 = *(const v4u*)(ap + 4);
          key[0] = k0.x; key[1] = k0.y; key[2] = k0.z; key[3] = k0.w; key[4] = k1.x; key[5] = k1.y; key[6] = k1.z; key[7] = k1.w; }
        unsigned prefix = 0u, pmask = 0u, need = (unsigned)cap;
        radix_pass<21, 2048>(key, valid, prefix, pmask, need, hist, wsum, bc, tid, F.lane, F.wave);
        radix_pass<10, 2048>(key, valid, prefix, pmask, need, hist, wsum, bc, tid, F.lane, F.wave);
        radix_pass<0, 1024>(key, valid, prefix, pmask, need, hist, wsum, bc, tid, F.lane, F.wave);
        const unsigned T = prefix;
        unsigned neq = 0u;
#pragma unroll
        for (int r = 0; r < 8; ++r) neq += (valid && key[r] == T) ? 1u : 0u;
        unsigned toteq; unsigned eqrank = block_excl_scan(neq, wsum, tid, F.lane, F.wave, toteq);
        unsigned selm = 0u, nsel = 0u;
#pragma unroll
        for (int r = 0; r < 8; ++r) { const bool eq = valid && key[r] == T; const bool sel = valid && (key[r] > T || (eq && eqrank < need)); if (eq) ++eqrank; if (sel) { selm |= 1u << r; ++nsel; } }
        unsigned totsel; unsigned slot = block_excl_scan(nsel, wsum, tid, F.lane, F.wave, totsel);
        const int rbase = seq_row0(s), sb = s == 0 ? 0 : (s == 1 ? 512 : (s == 2 ? 1024 : 1056));
        if (valid) {
#pragma unroll
            for (int r = 0; r < 8; ++r) { const int tok = tid * 8 + r; const bool sel = (selm >> r) & 1u;
                if (sel && slot < (unsigned)cap) { XR[e * er + sb + (int)slot] = rbase + tok; GX[e * er + sb + (int)slot] = __builtin_bit_cast(float, key[r]); }
                INV[(size_t)(rbase + tok) * 16 + e] = (sel && slot < (unsigned)cap) ? (int)slot : -1;
                if (sel) ++slot; } }
        if (s == 3) for (int i = 1088 + tid; i < er; i += NTHR) { XR[e * er + i] = 0; GX[e * er + i] = 0.f; }
        __syncthreads();
    }
    const int nprob = nseq * 16;
    if (F.bid >= nprob && F.G > nprob) { const int lo = nseq == 4 ? CV_DOWN0 : CV_DOWN1; convert_items<true>(F, lo, lo + 16 * 512, 0, 0, (F.bid - nprob) * 8 + F.wave, (F.G - nprob) * 8, 0); }
    else if (F.G <= nprob) { const int lo = nseq == 4 ? CV_DOWN0 : CV_DOWN1; convert_items<true>(F, lo, lo + 16 * 512, 0, 0, F.bid * 8 + F.wave, F.G * 8, 0); }
}

__device__ __forceinline__ int slot_base(int s) { return s == 0 ? 0 : (s == 1 ? 512 : (s == 2 ? 1024 : 1056)); }

template <bool LAST>
__device__ __forceinline__ void combine_phase(Frame& F, int l, int nrows, int er, bool probe = false) {
    const bf16* Hin = WSP(bf16, WS_H); bf16* H = probe ? WSP(bf16, WS_XE) : WSP(bf16, WS_H); bf16* U = probe ? WSP(bf16, WS_A2) : WSP(bf16, WS_U); const float* mod = WSP(float, WS_MOD) + (size_t)l * 3 * 24576; const float* modn = WSP(float, WS_MOD) + (size_t)(l + 1) * 3 * 24576;
    const bf16* YE = WSP(bf16, WS_YE); const int* INV = WSP(int, WS_INV);
    LAS float* LG = (LAS float*)F.lds; LAS float* LB = LG + D; LAS float* G2 = LG + 2 * D; LAS float* SH = LG + 3 * D; LAS float* SC = LG + 4 * D;
    const int ngroups = nrows / 8;
    stage_vec(LG, F.in[6] + (size_t)(l * 2 + 1) * D, D, F.tid); stage_vec(LB, F.in[7] + (size_t)(l * 2 + 1) * D, D, F.tid);
    int cur_mod = -1; Row8 cur, ms; int slot_c = -1, slot_n = -1;
    if (F.bid < ngroups) slot_c = INV[(size_t)(8 * F.bid + F.wave) * 16 + (F.lane & 15)];
    for (int g = F.bid; g < ngroups; g += F.G) {
        const int row = 8 * g + F.wave, mr = group_mod(g);
        if (mr != cur_mod) { __syncthreads(); stage_vec(G2, mod + (size_t)mr * 24576 + 5 * D, D, F.tid);
            if (!LAST) { stage_vec(SH, modn + (size_t)mr * 24576, D, F.tid); stage_vec(SC, modn + (size_t)mr * 24576 + D, D, F.tid); }
            __syncthreads(); cur_mod = mr; }
        v4u hraw[8]; ld_row8_raw(hraw, Hin + (size_t)row * D, F.lane);
        const int gn = g + F.G; if (gn < ngroups) slot_n = INV[(size_t)(8 * gn + F.wave) * 16 + (F.lane & 15)];
#pragma unroll
        for (int j = 0; j < 8; ++j) { ms.a[j] = (f32x4){0.f, 0.f, 0.f, 0.f}; ms.b[j] = (f32x4){0.f, 0.f, 0.f, 0.f}; }
        const int sq = row < ML ? (row >> 12) : 2 + ((row - ML) >> 8); const int sb = slot_base(sq);
        unsigned long long mask = __ballot(slot_c >= 0) & 0xFFFFull;
        while (mask) {
            const int e = __builtin_ctzll(mask); mask &= mask - 1;
            const int slot = __shfl(slot_c, e);
            const bf16* y = YE + ((size_t)e * er + sb + slot) * D;
            v4u yv[8];
#pragma unroll
            for (int j = 0; j < 8; ++j) yv[j] = *(const v4u*)(y + 8 * (F.lane + 64 * j));
#pragma unroll
            for (int j = 0; j < 8; ++j) { ms.a[j] += (f32x4){bflo(yv[j].x), bfhi(yv[j].x), bflo(yv[j].y), bfhi(yv[j].y)}; ms.b[j] += (f32x4){bflo(yv[j].z), bfhi(yv[j].z), bflo(yv[j].w), bfhi(yv[j].w)}; }
        }
        row8_from_raw(cur, hraw);
#pragma unroll
        for (int j = 0; j < 8; ++j) { const int c = 8 * (F.lane + 64 * j); cur.a[j] = DN_ALPHA * cur.a[j] + *(const LAS f32x4*)(G2 + c) * ms.a[j]; cur.b[j] = DN_ALPHA * cur.b[j] + *(const LAS f32x4*)(G2 + c + 4) * ms.b[j]; }
        float mean, rstd; row8_stats(cur, mean, rstd);
#pragma unroll
        for (int j = 0; j < 8; ++j) { const int c = 8 * (F.lane + 64 * j);
            const f32x4 y0 = (cur.a[j] - mean) * rstd * *(const LAS f32x4*)(LG + c) + *(const LAS f32x4*)(LB + c), y1 = (cur.b[j] - mean) * rstd * *(const LAS f32x4*)(LG + c + 4) + *(const LAS f32x4*)(LB + c + 4);
            if (LAST) { __builtin_nontemporal_store(y0, (f32x4*)(F.out + (size_t)row * D + c)); __builtin_nontemporal_store(y1, (f32x4*)(F.out + (size_t)row * D + c + 4)); }
            else { *(v4u*)(H + (size_t)row * D + c) = pack8(y0, y1);
                const f32x4 u0 = y0 * (1.f + *(const LAS f32x4*)(SC + c)) + *(const LAS f32x4*)(SH + c), u1 = y1 * (1.f + *(const LAS f32x4*)(SC + c + 4)) + *(const LAS f32x4*)(SH + c + 4);
                *(v4u*)(U + (size_t)row * D + c) = pack8(u0, u1); }
            asm volatile("" ::: "memory"); }
        slot_c = slot_n;
    }
    __syncthreads();
}

__device__ __forceinline__ void reduce_xzs_ctx(Frame& F) {
    const float* slab = WSP(float, WS_SLAB); bf16* XZS = WSP(bf16, WS_BIG);
    const int gt = F.bid * NTHR + F.tid, NGT = F.G * NTHR;
    for (int i = gt; i < MC * (DIN0 / 8); i += NGT) { const int r = i / (DIN0 / 8), c = (i % (DIN0 / 8)) * 8;
        const float* sp = slab + (size_t)(((r >> 8) + 2 * (c >> 8)) * 4) * 65536 + (r & 255) * 256 + (c & 255);
        f32x4 s0 = (f32x4){0.f, 0.f, 0.f, 0.f}, s1 = s0;
#pragma unroll
        for (int ks = 0; ks < 4; ++ks) { s0 += *(const f32x4*)(sp + (size_t)ks * 65536); s1 += *(const f32x4*)(sp + (size_t)ks * 65536 + 4); }
        *(v4u*)(XZS + (size_t)(ML + r) * DIN0 + c) = pack8(s0, s1); }
}
__device__ __forceinline__ void reduce_act_ctx(Frame& F) {
    const float* slab = WSP(float, WS_SLAB); unsigned char* ACT = WSP(unsigned char, WS_ACT);
    const int gt = F.bid * NTHR + F.tid, NGT = F.G * NTHR;
    for (int i = gt; i < 16 * 256 * 128; i += NGT) { const int e = i >> 15, r = (i >> 7) & 255, chn = i & 127, pn = chn >> 4, cc = (chn & 15) * 8;
        const float* sp = slab + (size_t)((e * 8 + pn) * 2) * 65536 + r * 256 + cc;
        const f32x4 g0 = *(const f32x4*)(sp) + *(const f32x4*)(sp + 65536), g1 = *(const f32x4*)(sp + 4) + *(const f32x4*)(sp + 65536 + 4);
        const f32x4 u0 = *(const f32x4*)(sp + 128) + *(const f32x4*)(sp + 65536 + 128), u1 = *(const f32x4*)(sp + 132) + *(const f32x4*)(sp + 65536 + 132);
        f32x4 a0, a1;
#pragma unroll
        for (int k = 0; k < 4; ++k) { a0[k] = siluf_(g0[k] * W8_INV) * (u0[k] * W8_INV); a1[k] = siluf_(g1[k] * W8_INV) * (u1[k] * W8_INV); }
        v2u w; w.x = pk4_fp8(a0[0], a0[1], a0[2], a0[3]); w.y = pk4_fp8(a1[0], a1[1], a1[2], a1[3]); *(v2u*)(ACT + ((size_t)e * ER0 + 1024 + r) * DE + pn * 128 + cc) = w; }
}
__device__ __forceinline__ void reduce_odd_tail(Frame& F) {
    const float* slab = WSP(float, WS_SLAB); bf16* QKVO = WSP(bf16, WS_BIG); float* Gt = WSP(float, WS_G); const float* gb = F.in[18];
    const int gt = F.bid * NTHR + F.tid, NGT = F.G * NTHR;
    for (int i = gt; i < 82 * 256 * 32; i += NGT) { const int t = i >> 13, r = (i >> 5) & 255, chn = i & 31;
        int pm, pn; if (t < 32) { pm = t; pn = 48; } else { const int j = t - 32, q = j % 25; pm = 32 + j / 25; pn = q < 24 ? 8 + q : 48; }
        if (pn == 48 && chn >= 4) continue;
        const float* sp = slab + (size_t)(t * 2) * 65536 + r * 256 + chn * 8;
        const f32x4 s0 = *(const f32x4*)(sp) + *(const f32x4*)(sp + 65536), s1 = *(const f32x4*)(sp + 4) + *(const f32x4*)(sp + 65536 + 4);
        const size_t row = (size_t)pm * 256 + r;
        if (pn == 48) { *(f32x4*)(Gt + row * 32 + chn * 8) = s0 + *(const f32x4*)(gb + chn * 8); *(f32x4*)(Gt + row * 32 + chn * 8 + 4) = s1 + *(const f32x4*)(gb + chn * 8 + 4); }
        else *(v4u*)(QKVO + row * DIN1 + pn * 256 + chn * 8) = pack8(s0, s1); }
}
typedef short v4i16_t __attribute__((ext_vector_type(4)));
__device__ __forceinline__ bf16x8 row_frag(const LAS unsigned char* T, int stride, int r0, int k0, int fr, int fq) { return *(const LAS bf16x8*)(T + (r0 + fr) * stride + (k0 + fq * 8) * 2); }
__device__ __forceinline__ bf16x8 tr_frag(const LAS unsigned char* T, int stride, int k0, int n0, int fr, int fq) {
    const LAS unsigned char* p0 = T + (k0 + 8 * fq + (fr >> 2)) * stride + n0 * 2 + 8 * (fr & 3);
    const v4i16_t lo = __builtin_amdgcn_ds_read_tr16_b64_v4i16((LAS v4i16_t*)p0);
    const v4i16_t hi = __builtin_amdgcn_ds_read_tr16_b64_v4i16((LAS v4i16_t*)(p0 + 4 * stride));
    return (bf16x8){lo[0], lo[1], lo[2], lo[3], hi[0], hi[1], hi[2], hi[3]};
}
#define MFMA16(a, b, c) __builtin_amdgcn_mfma_f32_16x16x32_bf16((a), (b), (c), 0, 0, 0)
constexpr int ML_QS = 0, ML_KS = 33792, ML_VS = 67584, ML_VW = 76800, ML_SP = 86016, ML_CT = 95232, ML_SM = 129024;
constexpr int SM_A = 0, SM_ROWC = 64, SM_EINT = 128, SM_LOW = 192, SM_W = 256, SM_DEN4 = 320, SM_QN = 576, SM_NST = 640, SM_SCAL = 896, SM_NPART = 904;
__device__ __forceinline__ v4u scale_bf16x8(v4u v, float s) {
    v4u o;
#pragma unroll
    for (int i = 0; i < 4; ++i) { const unsigned w = v[i]; o[i] = pk2(bflo(w) * s, bfhi(w) * s); }
    return o;
}
constexpr int MSC_STRIDE = 576;
__device__ __forceinline__ int mlstm_base(int step, int b, int d) { return step < 4 ? ML + b * CTXL + 64 * (d ? 3 - step : step) : b * SEQ + 64 * (d ? 63 - (step - 4) : (step - 4)); }
__device__ __forceinline__ void mlstm_phase(Frame& F, unsigned long long* racc = nullptr) {
    unsigned long long rprev = RSEL ? __builtin_amdgcn_s_memrealtime() : 0ull;
    const bf16* QKVO = WSP(bf16, WS_BIG); const float* Gt = WSP(float, WS_G); bf16* HD = WSP(bf16, WS_HD);
    LAS unsigned char* QS = F.lds + ML_QS; LAS unsigned char* KS = F.lds + ML_KS; LAS unsigned char* VS = F.lds + ML_VS; LAS unsigned char* VW = F.lds + ML_VW;
    LAS unsigned char* SP = F.lds + ML_SP; LAS unsigned char* CT = F.lds + ML_CT; LAS float* SM = (LAS float*)(F.lds + ML_SM);
    const int wr = F.wave >> 2, wc = F.wave & 3, fr = F.lane & 15, fq = F.lane >> 4, tid = F.tid;
    for (int unit = F.bid; unit < 256; unit += F.G) {
        const int x = unit & 7, y = unit >> 3; const int combo = x + 8 * (y >> 3), jv = y & 7;
        const int b = combo >> 4, h = (combo >> 1) & 7, d = combo & 1;
        f32x4 accC[2][4];
#pragma unroll
        for (int m = 0; m < 2; ++m)
#pragma unroll
            for (int n = 0; n < 4; ++n) accC[m][n] = (f32x4){0.f, 0.f, 0.f, 0.f};
        float n_reg = 0.f;
        v4u kq[4], qq[4], vv;
        {
            const int base = mlstm_base(0, b, d);
#pragma unroll
            for (int i = 0; i < 4; ++i) { const int q = tid + 512 * i, r = q >> 5, cs = q & 31; const size_t row = (size_t)(base + (d ? 63 - r : r));
                kq[i] = *(const v4u*)(QKVO + row * DIN1 + 2048 + h * DQK + cs * 8); qq[i] = (v4u){0u, 0u, 0u, 0u}; }
            { const int r = tid >> 3, cs = tid & 7; const size_t row = (size_t)(base + (d ? 63 - r : r)); vv = *(const v4u*)(QKVO + row * DIN1 + 4096 + h * DV + jv * 64 + cs * 8); }
            if (tid < 256) SM[SM_NST + tid] = 0.f;
        }
        float* msc = WSP(float, WS_MSC) + (size_t)unit * 68 * MSC_STRIDE;
        {
            LAS float* BE = SM + SM_DEN4; LAS float* PMX = SM + SM_DEN4 + 68; LAS float* MP = SM + SM_DEN4 + 136;
            for (int k = F.wave; k < 68; k += 8) {
                const int row = mlstm_base(k, b, d) + (d ? 63 - F.lane : F.lane);
                const float ig = Gt[(size_t)row * 32 + d * 16 + h], fp = Gt[(size_t)row * 32 + d * 16 + 8 + h];
                float bc = logsigmoidf_(fp);
#pragma unroll
                for (int o = 1; o < 64; o <<= 1) { const float t = __shfl_up(bc, o); if (F.lane >= o) bc += t; }
                const float a = ig - bc; float pm = a;
#pragma unroll
                for (int o = 1; o < 64; o <<= 1) { const float t = __shfl_up(pm, o); if (F.lane >= o) pm = fmaxf(pm, t); }
                float* sl = msc + (size_t)k * MSC_STRIDE; sl[F.lane] = a; sl[384 + F.lane] = bc; sl[448 + F.lane] = pm;
                if (F.lane == 63) { BE[k] = bc; PMX[k] = pm; }
            }
            __syncthreads();
            if (tid == 0) { float m = 0.f; for (int k = 0; k < 68; ++k) { MP[k] = m; const float be = BE[k]; m = fmaxf(be + m, be + PMX[k]); } }
            __syncthreads();
            for (int k = F.wave; k < 68; k += 8) {
                float* sl = msc + (size_t)k * MSC_STRIDE; const float a = sl[F.lane], bc = sl[384 + F.lane], pm = sl[448 + F.lane];
                const float m_prev = MP[k], bend = BE[k], m_new = fmaxf(bend + m_prev, bend + PMX[k]);
                const float mcomb = bc + fmaxf(m_prev, pm);
                sl[64 + F.lane] = bc - mcomb - 2.772588722239781f; sl[128 + F.lane] = 0.0625f * __expf(bc + m_prev - mcomb); sl[192 + F.lane] = __expf(-mcomb); sl[256 + F.lane] = __expf(bend + a - m_new);
                if (F.lane == 0) sl[320] = __expf(bend + m_prev - m_new);
            }
            asm volatile("s_waitcnt vmcnt(0)" ::: "memory");
            __syncthreads();
            if (F.wave == 0) { const float* sl = msc;
                SM[SM_A + F.lane] = sl[F.lane]; SM[SM_ROWC + F.lane] = sl[64 + F.lane]; SM[SM_EINT + F.lane] = sl[128 + F.lane]; SM[SM_LOW + F.lane] = sl[192 + F.lane]; SM[SM_W + F.lane] = sl[256 + F.lane];
                if (F.lane == 0) SM[SM_SCAL + 0] = sl[320]; }
        }
        float sc_a = 0.f, sc_r = 0.f, sc_e = 0.f, sc_l = 0.f, sc_w = 0.f, sc_d = 0.f;
#pragma unroll 1
        for (int step = 0; step < 68; ++step) {
            const bool lat = step >= 4;
            const int base = mlstm_base(step, b, d);
#pragma unroll
            for (int i = 0; i < 4; ++i) { const int q = tid + 512 * i, r = q >> 5, cs = q & 31;
                *(LAS v4u*)(KS + r * 528 + cs * 16) = kq[i];
                if (lat) *(LAS v4u*)(QS + r * 528 + cs * 16) = qq[i]; }
            *(LAS v4u*)(VS + (tid >> 3) * 144 + (tid & 7) * 16) = vv;
            RT(5);
            __syncthreads();
            RT(6);
            const float decay = SM[SM_SCAL + 0];
            *(LAS v4u*)(VW + (tid >> 3) * 144 + (tid & 7) * 16) = scale_bf16x8(vv, SM[SM_W + (tid >> 3)]);
            if (step < 67) {
                const int nb = mlstm_base(step + 1, b, d); const bool nlat = step + 1 >= 4;
#pragma unroll
                for (int i = 0; i < 4; ++i) { const int q = tid + 512 * i, r = q >> 5, cs = q & 31; const size_t row = (size_t)(nb + (d ? 63 - r : r));
                    kq[i] = *(const v4u*)(QKVO + row * DIN1 + 2048 + h * DQK + cs * 8);
                    if (nlat) qq[i] = *(const v4u*)(QKVO + row * DIN1 + h * DQK + cs * 8); }
                { const int r = tid >> 3, cs = tid & 7; const size_t row = (size_t)(nb + (d ? 63 - r : r)); vv = *(const v4u*)(QKVO + row * DIN1 + 4096 + h * DV + jv * 64 + cs * 8); }
                if (F.wave == 0) { const float* sl = msc + (size_t)(step + 1) * MSC_STRIDE; sc_a = sl[F.lane]; sc_r = sl[64 + F.lane]; sc_e = sl[128 + F.lane]; sc_l = sl[192 + F.lane]; sc_w = sl[256 + F.lane]; sc_d = sl[320]; }
            }
            if (lat) {
                {
                    const int t = tid >> 3, part = tid & 7; float s = 0.f;
#pragma unroll
                    for (int i = 0; i < 4; ++i) { const v4u xq = *(const LAS v4u*)(QS + t * 528 + (part * 32 + i * 8) * 2);
#pragma unroll
                        for (int k = 0; k < 4; ++k) s += bflo(xq[k]) * SM[SM_NST + part * 32 + i * 8 + 2 * k] + bfhi(xq[k]) * SM[SM_NST + part * 32 + i * 8 + 2 * k + 1]; }
                    s += __shfl_xor(s, 1); s += __shfl_xor(s, 2); s += __shfl_xor(s, 4);
                    if (part == 0) SM[SM_QN + t] = s;
                }
                f32x4 accS[2]; accS[0] = accS[1] = (f32x4){0.f, 0.f, 0.f, 0.f};
#pragma unroll
                for (int ks = 0; ks < 256; ks += 32) { const bf16x8 kf = row_frag(KS, 528, 16 * wc, ks, fr, fq);
#pragma unroll
                    for (int m = 0; m < 2; ++m) accS[m] = MFMA16(kf, row_frag(QS, 528, 32 * wr + 16 * m, ks, fr, fq), accS[m]); }
#pragma unroll
                for (int m = 0; m < 2; ++m) { const int t = 32 * wr + 16 * m + fr, s0 = 16 * wc + 4 * fq; const float rc = SM[SM_ROWC + t];
                    f32x4 p; float ps = 0.f;
#pragma unroll
                    for (int j = 0; j < 4; ++j) { const int s = s0 + j; const float arg = (s <= t) ? rc + SM[SM_A + s] : -100.f; p[j] = accS[m][j] * __expf(arg); ps += p[j]; }
                    ps += __shfl_xor(ps, 16); ps += __shfl_xor(ps, 32);
                    if (fq == 0) SM[SM_DEN4 + t * 4 + wc] = ps;
                    v2u o; o.x = pk2(p[0], p[1]); o.y = pk2(p[2], p[3]); *(LAS v2u*)(SP + t * 144 + s0 * 2) = o; }
            }
            RT(7);
            __syncthreads();
            RT(8);
            if (lat) {
                f32x4 acc1[2], acc2[2]; acc1[0] = acc1[1] = acc2[0] = acc2[1] = (f32x4){0.f, 0.f, 0.f, 0.f};
#pragma unroll
                for (int ks = 0; ks < 256; ks += 32) { const bf16x8 cf = row_frag(CT, 528, 16 * wc, ks, fr, fq);
#pragma unroll
                    for (int m = 0; m < 2; ++m) acc2[m] = MFMA16(cf, row_frag(QS, 528, 32 * wr + 16 * m, ks, fr, fq), acc2[m]); }
#pragma unroll
                for (int ks = 0; ks < 64; ks += 32) { const bf16x8 vf = tr_frag(VS, 144, ks, 16 * wc, fr, fq);
#pragma unroll
                    for (int m = 0; m < 2; ++m) acc1[m] = MFMA16(vf, row_frag(SP, 144, 32 * wr + 16 * m, ks, fr, fq), acc1[m]); }
#pragma unroll
                for (int m = 0; m < 2; ++m) { const int t = 32 * wr + 16 * m + fr; const float ei = SM[SM_EINT + t];
                    const float den = (SM[SM_DEN4 + t * 4 + 0] + SM[SM_DEN4 + t * 4 + 1]) + (SM[SM_DEN4 + t * 4 + 2] + SM[SM_DEN4 + t * 4 + 3]) + ei * SM[SM_QN + t];
                    const float inv = 1.f / fmaxf(fabsf(den), SM[SM_LOW + t]);
                    const f32x4 hv = (acc1[m] + ei * acc2[m]) * inv;
                    const size_t row = (size_t)(base + (d ? 63 - t : t));
                    v2u o; o.x = pk2(hv[0], hv[1]); o.y = pk2(hv[2], hv[3]);
                    *(v2u*)(HD + ((size_t)d * ML + row) * D + h * DV + jv * 64 + 16 * wc + 4 * fq) = o; }
            }
            float npart = 0.f;
            { const int dd = tid & 255, q0 = (tid >> 8) * 32;
#pragma unroll 8
                for (int q = q0; q < q0 + 32; ++q) npart += SM[SM_W + q] * bf2f(*(const LAS unsigned short*)(KS + q * 528 + dd * 2));
                if (tid >= 256) SM[SM_NPART + dd] = npart; }
#pragma unroll
            for (int m = 0; m < 2; ++m)
#pragma unroll
                for (int n = 0; n < 4; ++n) accC[m][n] = accC[m][n] * decay;
#pragma unroll
            for (int ks = 0; ks < 64; ks += 32) { bf16x8 vf[2];
#pragma unroll
                for (int m = 0; m < 2; ++m) vf[m] = tr_frag(VW, 144, ks, 32 * wr + 16 * m, fr, fq);
#pragma unroll
                for (int n = 0; n < 4; ++n) { const bf16x8 kf = tr_frag(KS, 528, ks, 64 * wc + 16 * n, fr, fq);
#pragma unroll
                    for (int m = 0; m < 2; ++m) accC[m][n] = MFMA16(kf, vf[m], accC[m][n]); } }
            RT(9);
            __syncthreads();
            RT(10);
#pragma unroll
            for (int m = 0; m < 2; ++m)
#pragma unroll
                for (int n = 0; n < 4; ++n) { const int v = 32 * wr + 16 * m + fr, dd = 64 * wc + 16 * n + 4 * fq; v2u o; o.x = pk2(accC[m][n][0], accC[m][n][1]); o.y = pk2(accC[m][n][2], accC[m][n][3]);
                    *(LAS v2u*)(CT + v * 528 + dd * 2) = o; }
            if (tid < 256) { n_reg = decay * n_reg + npart + SM[SM_NPART + tid]; SM[SM_NST + tid] = n_reg; }
            if (F.wave == 0 && step < 67) { SM[SM_A + F.lane] = sc_a; SM[SM_ROWC + F.lane] = sc_r; SM[SM_EINT + F.lane] = sc_e; SM[SM_LOW + F.lane] = sc_l; SM[SM_W + F.lane] = sc_w; if (F.lane == 0) SM[SM_SCAL + 0] = sc_d; }
            RT(11);
        }
        __syncthreads();
    }
}
#undef MFMA16

__device__ __forceinline__ void headnorm_phase(Frame& F) {
    const int gw = F.bid * 8 + F.wave, NGW = F.G * 8;
    const bf16* HD = WSP(bf16, WS_HD); const bf16* QKVO = WSP(bf16, WS_BIG); bf16* A2 = WSP(bf16, WS_A2); const float* ng = F.in[19];
    v4u h0[8], h1[8], ov[8], n0[8], n1[8], no[8];
    if (gw < ML) {
#pragma unroll
        for (int j = 0; j < 8; ++j) { const int c = 8 * (F.lane + 64 * j); h0[j] = *(const v4u*)(HD + (size_t)gw * D + c); h1[j] = *(const v4u*)(HD + ((size_t)ML + gw) * D + c); ov[j] = *(const v4u*)(QKVO + (size_t)gw * DIN1 + 8192 + c); } }
    for (int row = gw; row < ML; row += NGW) {
        const int rn = row + NGW;
        if (rn < ML) {
#pragma unroll
            for (int j = 0; j < 8; ++j) { const int c = 8 * (F.lane + 64 * j); n0[j] = *(const v4u*)(HD + (size_t)rn * D + c); n1[j] = *(const v4u*)(HD + ((size_t)ML + rn) * D + c); no[j] = *(const v4u*)(QKVO + (size_t)rn * DIN1 + 8192 + c); } }
#pragma unroll
        for (int j = 0; j < 8; ++j) {
            float v[8];
#pragma unroll
            for (int k = 0; k < 4; ++k) { v[2 * k] = bflo(h0[j][k]) + bflo(h1[j][k]); v[2 * k + 1] = bfhi(h0[j][k]) + bfhi(h1[j][k]); }
            float sm = ((v[0] + v[1]) + (v[2] + v[3])) + ((v[4] + v[5]) + (v[6] + v[7]));
            const float mean = wave_sum(sm) * (1.f / DV); float q = 0.f;
#pragma unroll
            for (int k = 0; k < 8; ++k) { v[k] -= mean; q += v[k] * v[k]; }
            const float rstd = 1.f / sqrtf(wave_sum(q) * (1.f / DV) + LN_EPS);
            const int c = 8 * (F.lane + 64 * j); const f32x4 g0 = *(const f32x4*)(ng + c), g1 = *(const f32x4*)(ng + c + 4);
            v4u w;
            w.x = pk2(sigmoidf_(bflo(ov[j].x)) * v[0] * rstd * g0.x, sigmoidf_(bfhi(ov[j].x)) * v[1] * rstd * g0.y);
            w.y = pk2(sigmoidf_(bflo(ov[j].y)) * v[2] * rstd * g0.z, sigmoidf_(bfhi(ov[j].y)) * v[3] * rstd * g0.w);
            w.z = pk2(sigmoidf_(bflo(ov[j].z)) * v[4] * rstd * g1.x, sigmoidf_(bfhi(ov[j].z)) * v[5] * rstd * g1.y);
            w.w = pk2(sigmoidf_(bflo(ov[j].w)) * v[6] * rstd * g1.z, sigmoidf_(bfhi(ov[j].w)) * v[7] * rstd * g1.w);
            *(v4u*)(A2 + (size_t)row * D + c) = w;
        }
#pragma unroll
        for (int j = 0; j < 8; ++j) { h0[j] = n0[j]; h1[j] = n1[j]; ov[j] = no[j]; }
    }
}
#define XB_TMO      128
#define XB_XCNT(j)  (256  + 64 * (j))
#define XB_XSUB(j)  (1280 + 64 * (j))
#define XB_XGEN(j)  (2304 + 64 * (j))
#define XB_TOP      3328
#define XB_TOPGEN   3392
#define XCD_BAR_WORDS 3456
#define XB_SPIN_CAP (1u << 22)

__device__ __forceinline__ unsigned xb_ld(unsigned* p)              { return __hip_atomic_load(p, __ATOMIC_RELAXED, __HIP_MEMORY_SCOPE_AGENT); }
__device__ __forceinline__ unsigned xb_add(unsigned* p, unsigned v) { return __hip_atomic_fetch_add(p, v, __ATOMIC_RELAXED, __HIP_MEMORY_SCOPE_AGENT); }
__device__ __forceinline__ unsigned xb_xcc_id() { return (unsigned)__builtin_amdgcn_s_getreg((3 << 11) | 20) & 0xFu; }
#define XB_SPIN(cond, bar) do { unsigned _sp = 0; while (cond) { __builtin_amdgcn_s_sleep(1); \
    if ((++_sp & 255u) == 0u) { if (xb_ld(&(bar)[XB_TMO])) break; if (_sp > XB_SPIN_CAP) { atomicAdd(&(bar)[XB_TMO], 1u); break; } } } } while (0)

struct XcdBarrier { unsigned* bar; unsigned x; volatile LAS unsigned* st; };

__device__ __forceinline__ XcdBarrier xcd_barrier_post(unsigned* bar, volatile LAS unsigned* st) {
    XcdBarrier b; b.bar = bar; b.x = xb_xcc_id(); b.st = st;
    if (threadIdx.x == 0) (void)xb_add(&bar[XB_XCNT(b.x)], 1u);
    return b;
}
__device__ __forceinline__ void xcd_barrier_complete(unsigned* bar, unsigned x, unsigned& nloc, unsigned& nx) {
    const unsigned G = gridDim.x * gridDim.y * gridDim.z;
    unsigned sum, cnt, mine, sp = 0u;
    for (;;) {
        sum = 0u; cnt = 0u; mine = 0u;
#pragma unroll
        for (unsigned j = 0; j < 16; ++j) { const unsigned c = xb_ld(&bar[XB_XCNT(j)]); sum += c; cnt += (c > 0u) ? 1u : 0u; mine = (j == x) ? c : mine; }
        if (sum == G) break;
        __builtin_amdgcn_s_sleep(1);
        if ((++sp & 255u) == 0u) { if (xb_ld(&bar[XB_TMO])) break; if (sp > XB_SPIN_CAP) { atomicAdd(&bar[XB_TMO], 1u); break; } }
    }
    nloc = mine > 0u ? mine : 1u; nx = cnt > 0u ? cnt : 1u;
}
__device__ __forceinline__ void xcd_barrier(const int tid, const XcdBarrier& b) {
    asm volatile("s_waitcnt vmcnt(0)" ::: "memory");
    __syncthreads();
    if (tid == 0) {
        unsigned* bar = b.bar;
        __builtin_amdgcn_s_waitcnt(0);
        unsigned nloc = b.st[0], nx = b.st[1];
        if (nloc == 0u) { xcd_barrier_complete(bar, b.x, nloc, nx); b.st[0] = nloc; b.st[1] = nx; }
        const unsigned old = xb_add(&bar[XB_XSUB(b.x)], 1u);
        const unsigned gen = old / nloc;
        if (old + 1u == (gen + 1u) * nloc) {
            __builtin_amdgcn_fence(__ATOMIC_RELEASE, "agent");
            asm volatile("s_waitcnt vmcnt(0)" ::: "memory");
            const unsigned og = xb_add(&bar[XB_TOP], 1u);
            const unsigned tg = og / nx;
            if (og + 1u == (tg + 1u) * nx) xb_add(&bar[XB_TOPGEN], 1u);
            else XB_SPIN(xb_ld(&bar[XB_TOPGEN]) == tg, bar);
            __builtin_amdgcn_fence(__ATOMIC_ACQUIRE, "agent");
            xb_add(&bar[XB_XGEN(b.x)], 1u);
            asm volatile("s_waitcnt vmcnt(0)" ::: "memory");
        } else {
            XB_SPIN(xb_ld(&bar[XB_XGEN(b.x)]) == gen, bar);
            __builtin_amdgcn_fence(__ATOMIC_ACQUIRE, "agent");
            asm volatile("s_waitcnt vmcnt(0)" ::: "memory");
        }
    }
    __syncthreads();
}

constexpr int N_PHASES = 24;
struct Args { const float* in[24]; float* out; unsigned char* ws; int ph_lo, ph_hi; };
__global__ void __launch_bounds__(NTHR, 2) fwd_kernel(Args args) {
    extern __shared__ __attribute__((aligned(16))) unsigned char lds_raw[];
    Frame F;
    F.lds = (LAS unsigned char*)lds_raw;
    F.wave = __builtin_amdgcn_readfirstlane((int)threadIdx.x >> 6) & 7; F.lane = pg8::fresh_lane(); F.tid = F.wave * 64 + F.lane;
    F.bid = blockIdx.x; F.G = gridDim.x; F.ws = args.ws; F.out = args.out;
#pragma unroll
    for (int i = 0; i < 24; ++i) F.in[i] = args.in[i];
    volatile LAS unsigned* MISC = (volatile LAS unsigned*)(F.lds + MISC_OFF);
    if (F.tid < 64) MISC[F.tid] = 0u;
    __syncthreads();
    const int lo = args.ph_lo, hi = args.ph_hi;
    const bool multi = (hi - lo) > 1;
    unsigned* barw = (unsigned*)(F.ws + WS_CTL) + CW_BAR;
    XcdBarrier bar; bar.bar = barw; bar.x = 0; bar.st = MISC + 8;
    if (multi) bar = xcd_barrier_post(barw, MISC + 8);
#ifndef REP_MASK
#define REP_MASK 0u
#endif
#define IN(k) (lo <= (k) && (k) < hi)
#define NREP(k) (1 + (int)((REP_MASK >> (k)) & 1u))
#ifndef TSEL
#define TSEL 0u
#endif
#ifndef TAMP
#define TAMP 4
#endif
    unsigned long long t_prev = TSEL ? __builtin_amdgcn_s_memrealtime() : 0ull, t_acc = 0ull;
#define TMARK(k) do { if (TSEL) { const unsigned long long t_now = __builtin_amdgcn_s_memrealtime(); if ((TSEL >> (k)) & 1u) t_acc += t_now - t_prev; t_prev = t_now; } } while (0)
#define SEAM(k) do { if (IN(k) && IN((k) + 1)) xcd_barrier(F.tid, bar); TMARK(k); F.lane = pg8::fresh_lane(); F.tid = F.wave * 64 + F.lane; } while (0)
#define RUN(k, ...) _Pragma("unroll") for (int rep_ = 0; rep_ < NREP(k); ++rep_) { __VA_ARGS__ }
    LAS unsigned char* ring = F.lds;

    if (IN(0)) { RUN(0, p0_convert(F); __syncthreads(); p0_adaln(F);) } SEAM(0);
    if (IN(1)) { RUN(1, p1_ln0(F);) } SEAM(1);
    if (IN(2)) { RUN(2, { pg8::Gemm g{WSP(bf16, WS_U), WSP(bf16, WS_W1T), D, D, D, 0, 0, nullptr, 0, 0}; pg8::TileOrder S; S.init(1, ML / 256, DIN0 / 256, F.G, F.bid);
            EpiBf16Plain E{WSP(bf16, WS_BIG), DIN0}; pg8::gemm_phase(F.wave, ring, g, S, E); }
        { pg8::Gemm g{WSP(bf16, WS_U), WSP(bf16, WS_W1T), D, D, 1024, 0, 0, nullptr, 0, 2048}; pg8::TailOrder S; S.init(0, 48, 4, 32, 2, F.G, F.bid);
            EpiSlab E{WSP(float, WS_SLAB), 4}; pg8::gemm_phase(F.wave, ring, g, S, E); }) } SEAM(2);
    if (IN(3)) { RUN(3, reduce_xzs_ctx(F);) } SEAM(3);
    if (IN(4)) { RUN(4, lru_phase(F, &t_acc); pool_pass1(F); pool_ctx(F);) } SEAM(4);
    if (IN(5)) { RUN(5, lru_carry(F); pool_pass2(F);) } SEAM(5);
    if (IN(6)) { RUN(6, lru_apply(F);
        pg8::Gemm g{WSP(bf16, WS_DP), WSP(bf16, WS_PWT), DPOOL, 512, 512, 512 * 2, 512 * 512 * 2, nullptr, 0, 0}; pg8::TileOrder S; S.init(4, MT / 256, 2, F.G, F.bid);
        EpiPool E{WSP(bf16, WS_A2), F.in[15]}; pg8::gemm_phase(F.wave, ring, g, S, E);) } SEAM(6);
    if (IN(7)) { RUN(7, { pg8::Gemm g{WSP(bf16, WS_A2), WSP(bf16, WS_W2T), D, D, D, 0, 0, nullptr, 0, 0}; pg8::TileOrder S; S.init(1, ML / 256, D / 256, F.G, F.bid);
            EpiBf16Plain E{WSP(bf16, WS_YE), D}; pg8::gemm_phase(F.wave, ring, g, S, E); }
        { pg8::Gemm g{WSP(bf16, WS_A2), WSP(bf16, WS_W2T), D, D, 512, 0, 0, nullptr, 0, 1024}; pg8::TailOrder S; S.init(0, 32, 8, 32, 2, F.G, F.bid);
            EpiSlab E{WSP(float, WS_SLAB), 8}; pg8::gemm_phase(F.wave, ring, g, S, E); }) } SEAM(7);
    if (IN(8)) { RUN(8, ln_router_phase(F, 0, MT, rep_ > 0, true, &t_acc);) } SEAM(8);
    if (IN(9)) { RUN(9, topk_phase(F, 4, ER0);) } SEAM(9);
    if (IN(10)) { RUN(10, { pg8::Gemm g{WSP(bf16, WS_U8), WSP(bf16, WS_WGU), D, D, D, 0, (size_t)2048 * D, WSP(int, WS_IDX), ER0, 0}; pg8::TileOrder S; S.init(16, 4, 8, F.G, F.bid);
            EpiGU E{WSP(unsigned char, WS_ACT), ER0}; pg8::gemm_phase<true, 1>(F.wave, ring, g, S, E); }
        { pg8::Gemm g{WSP(bf16, WS_U8), WSP(bf16, WS_WGU), D, D, 2048, 0, (size_t)2048 * D, WSP(int, WS_IDX), ER0, 2048}; pg8::TailOrder S; S.init(1, 128, 2, 4, 1, F.G, F.bid);
            EpiSlab E{WSP(float, WS_SLAB), 2}; pg8::gemm_phase<true, 1>(F.wave, ring, g, S, E); }) } SEAM(10);
    if (IN(11)) { RUN(11, reduce_act_ctx(F);) } SEAM(11);
    if (IN(12)) { RUN(12, pg8::Gemm g{WSP(bf16, WS_ACT), WSP(bf16, WS_WDN), DE, DE, DE, (size_t)ER0 * DE, (size_t)D * DE, nullptr, 0, 0}; pg8::TileOrder S; S.init(16, ER0 / 256, 16, F.G, F.bid);
        EpiDown E{WSP(bf16, WS_YE), WSP(float, WS_GX), ER0}; pg8::gemm_phase<false, 1>(F.wave, ring, g, S, E);) } SEAM(12);
    if (IN(13)) { RUN(13, combine_phase<false>(F, 0, MT, ER0, rep_ > 0);) } SEAM(13);
    if (IN(14)) { RUN(14, { pg8::Gemm g{WSP(bf16, WS_U), WSP(bf16, WS_W3T), D, D, D, 0, 0, nullptr, 0, 0}; pg8::TileOrder S; S.init(1, ML / 256, DIN1 / 256, F.G, F.bid);
            EpiOddIn E{WSP(bf16, WS_BIG), WSP(float, WS_G), F.in[18]}; pg8::gemm_phase(F.wave, ring, g, S, E); }
        { pg8::Gemm g{WSP(bf16, WS_U), WSP(bf16, WS_W3T), D, D, 2048, 0, 0, nullptr, 0, 4096}; pg8::TailOrder S; S.init(2, 82, 2, 0, 0, F.G, F.bid);
            EpiSlab E{WSP(float, WS_SLAB), 2}; pg8::gemm_phase(F.wave, ring, g, S, E); }) } SEAM(14);
    if (IN(15)) { RUN(15, reduce_odd_tail(F);) } SEAM(15);
    if (IN(16)) { RUN(16, mlstm_phase(F, &t_acc);) } SEAM(16);
    if (IN(17)) { RUN(17, headnorm_phase(F);) } SEAM(17);
    if (IN(18)) { RUN(18, pg8::Gemm g{WSP(bf16, WS_A2), WSP(bf16, WS_W4T), D, D, D, 0, 0, nullptr, 0, 0}; pg8::TileOrder S; S.init(1, ML / 256, D / 256, F.G, F.bid);
        EpiBf16Plain E{WSP(bf16, WS_YE), D}; pg8::gemm_phase(F.wave, ring, g, S, E);) } SEAM(18);
    if (IN(19)) { RUN(19, ln_router_phase(F, 1, ML, rep_ > 0, false, &t_acc);) } SEAM(19);
    if (IN(20)) { RUN(20, topk_phase(F, 2, ER1);) } SEAM(20);
    if (IN(21)) { RUN(21, pg8::Gemm g{WSP(bf16, WS_U8), (const bf16*)(WSP(unsigned char, WS_WGU) + (size_t)16 * 2048 * D), D, D, D, 0, (size_t)2048 * D, WSP(int, WS_IDX), ER1, 0}; pg8::TileOrder S; S.init(16, ER1 / 256, 8, F.G, F.bid);
        EpiGU E{WSP(unsigned char, WS_ACT), ER1}; pg8::gemm_phase<true, 1>(F.wave, ring, g, S, E);) } SEAM(21);
    if (IN(22)) { RUN(22, pg8::Gemm g{WSP(bf16, WS_ACT), (const bf16*)(WSP(unsigned char, WS_WDN) + (size_t)16 * D * DE), DE, DE, DE, (size_t)ER1 * DE, (size_t)D * DE, nullptr, 0, 0}; pg8::TileOrder S; S.init(16, ER1 / 256, 16, F.G, F.bid);
        EpiDown E{WSP(bf16, WS_YE), WSP(float, WS_GX), ER1}; pg8::gemm_phase<false, 1>(F.wave, ring, g, S, E);) } SEAM(22);
    if (IN(23)) { RUN(23, combine_phase<true>(F, 1, ML, ER1);) }
    TMARK(23);
    if (TSEL && blockIdx.x == 0) { const unsigned long long t_end = __builtin_amdgcn_s_memrealtime(); while (__builtin_amdgcn_s_memrealtime() - t_end < (unsigned long long)TAMP * t_acc) __builtin_amdgcn_s_sleep(8); }
#undef IN
#undef RUN
#undef SEAM
}

#ifndef MK_ONE_LAUNCH
#define MK_ONE_LAUNCH 0
#endif
extern "C" void kernel_launch(void* const* d_in, const int* in_sizes, int n_in, void* d_out, int out_size, void* d_ws, size_t ws_size, hipStream_t stream) {
    static int grid = 0;
    if (grid == 0) {
        if (n_in != 24 || out_size != ML * D || ws_size < WS_END) { fprintf(stderr, "kernel_launch: unexpected shapes (n_in %d, out %d, ws %zu); nothing launched\n", n_in, out_size, ws_size); grid = -1; return; }
        int dev = 0, cus = 0, per_cu = 0;
        if (hipGetDevice(&dev) != hipSuccess || hipDeviceGetAttribute(&cus, hipDeviceAttributeMultiprocessorCount, dev) != hipSuccess) { grid = -1; return; }
        if (hipFuncSetAttribute((const void*)fwd_kernel, hipFuncAttributeMaxDynamicSharedMemorySize, LDS_BYTES) != hipSuccess) { fprintf(stderr, "kernel_launch: hipFuncSetAttribute failed\n"); grid = -1; return; }
        if (hipOccupancyMaxActiveBlocksPerMultiprocessor(&per_cu, (const void*)fwd_kernel, NTHR, LDS_BYTES) != hipSuccess || per_cu < 1) { fprintf(stderr, "kernel_launch: occupancy query says %d\n", per_cu); }
        (void)hipGetLastError();
        grid = cus;
    }
    if (grid < 0) return;
    if (hipMemsetAsync((char*)d_ws + WS_CTL, 0, CTL_ZERO_BYTES, stream) != hipSuccess) return;
    Args a{};
    for (int i = 0; i < 24; ++i) a.in[i] = (const float*)d_in[i];
    a.out = (float*)d_out; a.ws = (unsigned char*)d_ws;
#if MK_ONE_LAUNCH
    a.ph_lo = 0; a.ph_hi = N_PHASES;
    hipLaunchKernelGGL(fwd_kernel, dim3(grid), dim3(NTHR), LDS_BYTES, stream, a);
#else
    for (int p = 0; p < N_PHASES; ++p) { a.ph_lo = p; a.ph_hi = p + 1; hipLaunchKernelGGL(fwd_kernel, dim3(grid), dim3(NTHR), LDS_BYTES, stream, a); }
#endif
}
```

```cpp
#ifndef MK_ONE_LAUNCH
#define MK_ONE_LAUNCH 1
#endif
#ifndef REP_MASK
#define REP_MASK 0u
#endif
#ifndef TSEL
#define TSEL 0u
#endif
#ifndef RSEL
#define RSEL 0
#endif
#include <hip/hip_runtime.h>
#include <cstdio>
#include <cstdint>
namespace pg8 {
__device__ __forceinline__ int fresh_lane() { int l; asm volatile("v_mbcnt_lo_u32_b32 %0, -1, 0\n\tv_mbcnt_hi_u32_b32 %0, -1, %0" : "=v"(l)); return l & 63; }
#define PG8_LAS __attribute__((address_space(3)))
typedef unsigned short bf16_t;
typedef short bf16x8 __attribute__((ext_vector_type(8)));
typedef float f32x4 __attribute__((ext_vector_type(4)));
typedef float f32x2 __attribute__((ext_vector_type(2)));
typedef unsigned u32x4 __attribute__((ext_vector_type(4)));
typedef unsigned u32x2 __attribute__((ext_vector_type(2)));
typedef int i32x4 __attribute__((ext_vector_type(4)));
typedef int i32x8 __attribute__((ext_vector_type(8)));
constexpr int BM = 256, BK = 64, HALF = 128, HTB = HALF * BK * 2  , STAGE_BYTES = 8 * HTB, NXCD = 8, WGM = 8;

__host__ __device__ __forceinline__ int lds_byte(int r, int c) { const int st = (r >> 4) * 2 + (c >> 5), rr = r & 15, cc = c & 31, ob = rr * 64 + cc * 2; return st * 1024 + (ob ^ (((ob >> 9) & 1) << 5)); }
__host__ __device__ __forceinline__ void stage_rc(int b, int& R, int& C) { const int st = b / 1024, sb = b % 1024, swz = sb ^ (((sb >> 9) & 1) << 5); R = (st >> 1) * 16 + swz / 64; C = (st & 1) * 32 + (swz % 64) / 2; }
__host__ __device__ __forceinline__ int perm32(int rho) { const int n = rho >> 4, i = rho & 15; return 8 * (i >> 2) + 4 * n + (i & 3); }

struct Unit { int pm, pn, g, ks, t; };
struct Gemm { const bf16_t* A; const bf16_t* Bt; int lda, ldb, K; size_t gA, gB; const int* rowidx; int grows; size_t kS; };

struct TileOrder {
    int nG, nM, nN, per, nwg, G, c;
    __device__ __forceinline__ void init(int nG_, int nM_, int nN_, int G_, int c_) { nG = nG_; nM = nM_; nN = nN_; per = nM * nN; nwg = nG * per; G = G_; c = c_; }
    __device__ __forceinline__ bool next(int i, Unit& u) const {
        const long L = (long)i * G + c; if (L >= nwg) return false;
        int wgid = (int)L; { const int q = nwg / NXCD, r = nwg % NXCD, xcd = wgid % NXCD, off = wgid / NXCD; wgid = (xcd < r ? xcd * (q + 1) : r * (q + 1) + (xcd - r) * q) + off; }
        u.ks = 0; u.t = 0; u.g = wgid / per; wgid -= u.g * per;
        const int nig = WGM * nN, gid = wgid / nig, fm = gid * WGM, gsz = (nM - fm) < WGM ? (nM - fm) : WGM;
        u.pm = fm + ((wgid % nig) % gsz); u.pn = (wgid % nig) / gsz; return true;
    }
};

struct TailOrder {
    int ntiles, nS, G, c, kind, pm0, nM;
    __device__ __forceinline__ void init(int kind_, int ntiles_, int nS_, int pm0_, int nM_, int G_, int c_) { kind = kind_; ntiles = ntiles_; nS = nS_; pm0 = pm0_; nM = nM_; G = G_; c = c_; }
    __device__ __forceinline__ bool next(int i, Unit& u) const {
        const int nwg = ntiles * nS; const long L = (long)i * G + c; if (L >= nwg) return false;
        int wgid = (int)L; { const int q = nwg / NXCD, r = nwg % NXCD, xcd = wgid % NXCD, off = wgid / NXCD; wgid = (xcd < r ? xcd * (q + 1) : r * (q + 1) + (xcd - r) * q) + off; }
        u.ks = wgid % nS; const int t = wgid / nS; u.t = t; u.g = 0;
        if (kind == 0) { u.pm = pm0 + t % nM; u.pn = t / nM; }
        else if (kind == 1) { u.g = t >> 3; u.pn = t & 7; u.pm = 4; }
        else { if (t < 32) { u.pm = t; u.pn = 48; } else { const int j = t - 32, q = j % 25; u.pm = 32 + j / 25; u.pn = q < 24 ? 8 + q : 48; } }
        return true;
    }
};

__device__ __forceinline__ unsigned cvt_pk_bf16(float lo, float hi) { unsigned r; asm volatile("v_cvt_pk_bf16_f32 %0, %1, %2" : "=v"(r) : "v"(lo), "v"(hi)); return r; }

template <bool GATHER = false, int ES = 2, class Epi, class Sched>
__device__ __forceinline__ void gemm_phase(const int wid  , PG8_LAS unsigned char* lds, const Gemm g, const Sched& S, const Epi& E) {
    const int lane = fresh_lane(), tid = wid * 64 + lane, wr = wid >> 2, wc = wid & 3, fr = lane & 15, fq = lane >> 4;
    const int K = g.K, nt = K * ES / (BK * 2);
    unsigned voffA[2], voffB[2];
#pragma unroll
    for (int i = 0; i < 2; ++i) { int R, C; stage_rc(tid * 16 + i * 8192, R, C); const int Rb = Epi::PERM ? ((R & ~31) + perm32(R & 31)) : R;
        voffA[i] = (unsigned)(R * g.lda * ES + C * 2); voffB[i] = (unsigned)(Rb * g.ldb * ES + C * 2); }
    unsigned vA[2][2], vAn[2][2];
#define PG8_GOFFS(v, u) do { int _t = tid; asm volatile("" : "+v"(_t));     \
        _Pragma("unroll") for (int _i = 0; _i < 2; ++_i) { int _R, _C; stage_rc(_t * 16 + _i * 8192, _R, _C); _Pragma("unroll") for (int _h = 0; _h < 2; ++_h) \
        (v)[_h][_i] = (unsigned)(g.rowidx[(size_t)(u).g * g.grows + (u).pm * 256 + _h * 128 + _R] * g.lda * ES + _C * 2); } } while (0)
    const size_t kstep = (size_t)(BK * 2);
    const size_t hstepA = (size_t)HALF * g.lda * ES, hstepB = (size_t)HALF * g.ldb * ES;
    const size_t tstepA = 2 * hstepA, tstepB = 2 * hstepB;
    const unsigned ldsw = (unsigned)wid * 1024u;
    const int aoff = lds_byte(wr * 64 + fr, fq * 8), boff = lds_byte(wc * 32 + fr, fq * 8);
#define PG8_SA(b, h) (((b) * 2 + (h)) * HTB)
#define PG8_SB(b, h) ((4 + (b) * 2 + (h)) * HTB)
#define PG8_STAGE(bufoff, gbase, voff) do { _Pragma("unroll") for (int _i = 0; _i < 2; ++_i) { unsigned _vo = (voff)[_i]; asm volatile("" : "+v"(_vo));     \
        __builtin_amdgcn_global_load_lds((const unsigned*)((const char*)(gbase) + _vo), (PG8_LAS unsigned*)(lds + (bufoff) + ldsw + _i * 8192), 16, 0, 0); } } while (0)
#define PG8_LDA(dst, b, h) do { if constexpr (ES == 2) { _Pragma("unroll") for (int m = 0; m < 4; ++m) _Pragma("unroll") for (int k = 0; k < 2; ++k) dst[m][k] = *(const PG8_LAS bf16x8*)(lds + PG8_SA(b, h) + aoff + m * 2048 + k * 1024); } \
        else { _Pragma("unroll") for (int m = 0; m < 4; ++m) { dst##8[m].lo = *(const PG8_LAS i32x4*)(lds + PG8_SA(b, h) + aoff + m * 2048); dst##8[m].hi = *(const PG8_LAS i32x4*)(lds + PG8_SA(b, h) + aoff + m * 2048 + 1024); } } } while (0)
#define PG8_LDB(dst, b, h) do { if constexpr (ES == 2) { _Pragma("unroll") for (int n = 0; n < 2; ++n) _Pragma("unroll") for (int k = 0; k < 2; ++k) dst[n][k] = *(const PG8_LAS bf16x8*)(lds + PG8_SB(b, h) + boff + n * 2048 + k * 1024); } \
        else { _Pragma("unroll") for (int n = 0; n < 2; ++n) { dst##8[n].lo = *(const PG8_LAS i32x4*)(lds + PG8_SB(b, h) + boff + n * 2048); dst##8[n].hi = *(const PG8_LAS i32x4*)(lds + PG8_SB(b, h) + boff + n * 2048 + 1024); } } } while (0)
#define PG8_CAT8(x, y) __builtin_shufflevector(__builtin_bit_cast(i32x4, (x)), __builtin_bit_cast(i32x4, (y)), 0, 1, 2, 3, 4, 5, 6, 7)
#define PG8_MMA(ai, bj, At, Bt) do { __builtin_amdgcn_s_setprio(1); \
        if constexpr (ES == 2) { _Pragma("unroll") for (int m = 0; m < 4; ++m) _Pragma("unroll") for (int n = 0; n < 2; ++n) _Pragma("unroll") for (int k = 0; k < 2; ++k) \
            acc[ai][bj][m][n] = __builtin_amdgcn_mfma_f32_16x16x32_bf16(Bt[n][k], At[m][k], acc[ai][bj][m][n], 0, 0, 0); } \
        else { _Pragma("unroll") for (int m = 0; m < 4; ++m) _Pragma("unroll") for (int n = 0; n < 2; ++n) \
            acc[ai][bj][m][n] = __builtin_amdgcn_mfma_scale_f32_16x16x128_f8f6f4(Bt##8[n], At##8[m], acc[ai][bj][m][n], 0, 0, 0, 0, 0, 0); } \
        __builtin_amdgcn_s_setprio(0); } while (0)
#define PG8_WAIT_V(n) asm volatile("s_waitcnt vmcnt(" #n ")" ::: "memory")
#define PG8_WAIT_L(n) asm volatile("s_waitcnt lgkmcnt(" #n ")" ::: "memory")
#define PG8_BAR __builtin_amdgcn_s_barrier()
#define PG8_SCHED __builtin_amdgcn_sched_barrier(0)
    Unit cur, nxt; int ui = 0;
    if (!S.next(0, cur)) return;
    f32x4 acc[2][2][4][2];
#pragma unroll
    for (int a = 0; a < 2; ++a)
#pragma unroll
        for (int b = 0; b < 2; ++b)
#pragma unroll
            for (int m = 0; m < 4; ++m)
#pragma unroll
                for (int n = 0; n < 2; ++n) acc[a][b][m][n] = (f32x4){0.f, 0.f, 0.f, 0.f};
    bf16x8 At[4][2], B0[2][2], B1[2][2];
    i32x8 At8[4], B08[2], B18[2];
    const char* cA = (GATHER ? (const char*)g.A : (const char*)g.A + (size_t)cur.g * g.gA + (size_t)cur.pm * tstepA) + (size_t)cur.ks * g.kS; const char* cB = (const char*)g.Bt + (size_t)cur.g * g.gB + (size_t)cur.pn * tstepB + (size_t)cur.ks * g.kS;
    if constexpr (GATHER) { PG8_GOFFS(vA, cur); }
    if constexpr (GATHER) { PG8_STAGE(PG8_SB(0, 0), cB, voffB); PG8_STAGE(PG8_SB(0, 1), cB + hstepB, voffB); PG8_STAGE(PG8_SA(0, 0), cA, vA[0]); PG8_STAGE(PG8_SA(0, 1), cA, vA[1]); }
    else { PG8_STAGE(PG8_SB(0, 0), cB, voffB); PG8_STAGE(PG8_SB(0, 1), cB + hstepB, voffB); PG8_STAGE(PG8_SA(0, 0), cA, voffA); PG8_STAGE(PG8_SA(0, 1), cA + hstepA, voffA); }
    if (wr == 1) PG8_BAR;
    PG8_WAIT_V(2); PG8_BAR;
    if constexpr (GATHER) { PG8_STAGE(PG8_SB(1, 0), cB + kstep, voffB); PG8_STAGE(PG8_SA(1, 0), cA + kstep, vA[0]); PG8_STAGE(PG8_SB(1, 1), cB + hstepB + kstep, voffB); }
    else { PG8_STAGE(PG8_SB(1, 0), cB + kstep, voffB); PG8_STAGE(PG8_SA(1, 0), cA + kstep, voffA); PG8_STAGE(PG8_SB(1, 1), cB + hstepB + kstep, voffB); }
    PG8_WAIT_V(6); PG8_BAR;
    for (;;) {
        const bool has_next = S.next(ui + 1, nxt);
        const char* nA = !has_next ? cA : (GATHER ? (const char*)g.A : (const char*)g.A + (size_t)nxt.g * g.gA + (size_t)nxt.pm * tstepA) + (size_t)nxt.ks * g.kS; const char* nB = has_next ? (const char*)g.Bt + (size_t)nxt.g * g.gB + (size_t)nxt.pn * tstepB + (size_t)nxt.ks * g.kS : cB;
        if constexpr (GATHER) { if (has_next) { PG8_GOFFS(vAn, nxt); } else {
#pragma unroll
                for (int _h = 0; _h < 2; ++_h)
#pragma unroll
                    for (int _i = 0; _i < 2; ++_i) vAn[_h][_i] = vA[_h][_i]; } }
        for (int t = 0; t < nt; t += 2) {
            const bool last = (t == nt - 2);
            const char* a1 = cA + (size_t)(t + 1) * kstep;
            const char* a2 = last ? nA : cA + (size_t)(t + 2) * kstep; const char* b2 = last ? nB : cB + (size_t)(t + 2) * kstep;
            const char* a3 = a2 + kstep; const char* b3 = b2 + kstep;
            PG8_LDB(B0, 0, 0); PG8_LDB(B1, 0, 1); PG8_SCHED; PG8_LDA(At, 0, 0); if constexpr (GATHER) { PG8_STAGE(PG8_SA(1, 1), a1, vA[1]); } else { PG8_STAGE(PG8_SA(1, 1), a1 + hstepA, voffA); }
            PG8_WAIT_V(8); PG8_WAIT_L(0); PG8_BAR; PG8_MMA(0, 0, At, B0); PG8_MMA(0, 1, At, B1); PG8_BAR; PG8_SCHED;
            if constexpr (GATHER) { if (last) {
#pragma unroll
                    for (int _h = 0; _h < 2; ++_h)
#pragma unroll
                        for (int _i = 0; _i < 2; ++_i) vA[_h][_i] = vAn[_h][_i]; } }
            PG8_LDA(At, 0, 1); PG8_STAGE(PG8_SB(0, 0), b2, voffB); PG8_STAGE(PG8_SB(0, 1), b2 + hstepB, voffB); if constexpr (GATHER) { PG8_STAGE(PG8_SA(0, 0), a2, vA[0]); } else { PG8_STAGE(PG8_SA(0, 0), a2, voffA); }
            PG8_WAIT_V(8); PG8_WAIT_L(0); PG8_BAR; PG8_MMA(1, 0, At, B0); PG8_MMA(1, 1, At, B1); PG8_BAR; PG8_SCHED;
            PG8_LDB(B0, 1, 0); PG8_LDB(B1, 1, 1); PG8_SCHED; PG8_LDA(At, 1, 0); if constexpr (GATHER) { PG8_STAGE(PG8_SA(0, 1), a2, vA[1]); } else { PG8_STAGE(PG8_SA(0, 1), a2 + hstepA, voffA); }
            PG8_WAIT_V(8); PG8_WAIT_L(0); PG8_BAR; PG8_MMA(0, 0, At, B0); PG8_MMA(0, 1, At, B1); PG8_BAR; PG8_SCHED;
            PG8_LDA(At, 1, 1); PG8_STAGE(PG8_SB(1, 0), b3, voffB); PG8_STAGE(PG8_SB(1, 1), b3 + hstepB, voffB); if constexpr (GATHER) { PG8_STAGE(PG8_SA(1, 0), a3, vA[0]); } else { PG8_STAGE(PG8_SA(1, 0), a3, voffA); }
            PG8_WAIT_V(8); PG8_WAIT_L(0); PG8_BAR; PG8_MMA(1, 0, At, B0); PG8_MMA(1, 1, At, B1); PG8_BAR; PG8_SCHED;
        }
        if (wr == 0) PG8_BAR;
        E(acc, cur, wr, wc, fr, fq);
        if (!has_next) break;
#pragma unroll
        for (int a = 0; a < 2; ++a)
#pragma unroll
            for (int b = 0; b < 2; ++b)
#pragma unroll
                for (int m = 0; m < 4; ++m)
#pragma unroll
                    for (int n = 0; n < 2; ++n) acc[a][b][m][n] = (f32x4){0.f, 0.f, 0.f, 0.f};
        cur = nxt; cA = nA; cB = nB; ++ui;
        if (wr == 1) PG8_BAR;
    }
    PG8_WAIT_V(0);
    PG8_BAR;
#undef PG8_GOFFS
#undef PG8_SA
#undef PG8_SB
#undef PG8_STAGE
#undef PG8_LDA
#undef PG8_LDB
#undef PG8_MMA
#undef PG8_CAT8
#undef PG8_WAIT_V
#undef PG8_WAIT_L
#undef PG8_BAR
#undef PG8_SCHED
}
}
#define GAS __attribute__((address_space(1)))
#define LAS __attribute__((address_space(3)))
typedef unsigned short bf16;
typedef unsigned v4u __attribute__((ext_vector_type(4)));
typedef unsigned v2u __attribute__((ext_vector_type(2)));
typedef float f32x4 __attribute__((ext_vector_type(4)));
typedef float f32x2 __attribute__((ext_vector_type(2)));
typedef short bf16x8 __attribute__((ext_vector_type(8)));

constexpr int D = 4096, NB = 2, SEQ = 4096, CTXL = 256;
constexpr int ML = NB * SEQ, MC = NB * CTXL, MT = ML + MC;
constexpr int DLRU = 2048, LRUH = 16, LRUB = 128, DPOOL = 2048, DIN0 = 6144;
constexpr int MH = 8, DQK = 256, DV = 512, DIN1 = 12288, DIN1P = 12544, CHUNK = 64;
constexpr int NE = 16, DE = 1024;
constexpr int ER0 = 1280, ER1 = 1024;
constexpr float LN_EPS = 1e-5f, DN_ALPHA = 1.41421356237f;
constexpr int NT_TILES = 136;

constexpr size_t WS_CTL = 0ull, CTL_ZERO_BYTES = 1048576ull;
constexpr size_t WS_MOD = 1048576ull;
constexpr size_t WS_WRT = 1638400ull;
constexpr size_t WS_LS8 = 2162688ull;
constexpr size_t WS_W1T = 2179072ull;
constexpr size_t WS_W2T = 52510720ull;
constexpr size_t WS_W3T = 86065152ull;
constexpr size_t WS_W4T = 188825600ull;
constexpr size_t WS_WGU = 222380032ull;
constexpr size_t WS_WDN = 759250944ull;
constexpr size_t WS_GWT = 1027686400ull;
constexpr size_t WS_PWT = 1029783552ull;
constexpr size_t WS_H = 1031880704ull;
constexpr size_t WS_U = 1174487040ull;
constexpr size_t WS_BIG = 1245790208ull;
constexpr size_t WS_A2 = 1459699712ull;
constexpr size_t WS_CM = 1531002880ull;
constexpr size_t WS_DP = 1598111744ull;
constexpr size_t WS_SUMM = 1633763328ull;
constexpr size_t WS_CARRY = 1638219776ull;
constexpr size_t WS_AFF = 1640448000ull;
constexpr size_t WS_IDX = 1641496576ull;
constexpr size_t WS_GSEL = 1641627648ull;
constexpr size_t WS_INV = 1641758720ull;
constexpr size_t WS_GX = 1642315776ull;
constexpr size_t WS_XE = 1642397696ull;
constexpr size_t WS_ACT = 1810169856ull;
constexpr size_t WS_YE = 1852112896ull;
constexpr size_t WS_G = 2019885056ull;
constexpr size_t WS_HD = 2020999168ull;
constexpr size_t WS_SLAB = 2155216896ull;
constexpr size_t WS_MSC = 2155216896ull + 67108864ull;
constexpr size_t WS_WRH = WS_MSC + 256ull * 68 * 576 * 4;
constexpr size_t WS_WRL = WS_WRH + 262144ull;
constexpr size_t WS_U8 = WS_WRL + 262144ull;
constexpr size_t WS_DUMP = WS_U8 + 8704ull * 4096;
constexpr size_t WS_END = WS_DUMP + 65536ull;

constexpr int CW_BAR = 4096;
constexpr int LDS_BYTES = 147456;
constexpr int MISC_OFF = 144 * 1024 - 256;
constexpr int NTHR = 512;

typedef __bf16 hwbf16x2 __attribute__((ext_vector_type(2)));
typedef float f32x2_ __attribute__((ext_vector_type(2)));
__device__ __forceinline__ unsigned pk2(float lo, float hi) { const f32x2_ f = {lo, hi}; return __builtin_bit_cast(unsigned, __builtin_convertvector(f, hwbf16x2)); }
__device__ __forceinline__ unsigned f2bf(float f) { return pk2(f, 0.f) & 0xffffu; }
__device__ __forceinline__ float bf2f(unsigned b) { return __builtin_bit_cast(float, b << 16); }
__device__ __forceinline__ float bflo(unsigned w) { return __builtin_bit_cast(float, w << 16); }
__device__ __forceinline__ float bfhi(unsigned w) { return __builtin_bit_cast(float, w & 0xffff0000u); }
template <int CTRL> __device__ __forceinline__ float dppx(float v) { return __builtin_bit_cast(float, __builtin_amdgcn_update_dpp(0, __builtin_bit_cast(int, v), CTRL, 0xF, 0xF, true)); }
__device__ __forceinline__ float rlane(float v, int l) { return __builtin_bit_cast(float, __builtin_amdgcn_readlane(__builtin_bit_cast(int, v), l)); }
__device__ __forceinline__ float wave_sum(float v) {
    v += dppx<0xB1>(v); v += dppx<0x4E>(v); v += dppx<0x141>(v); v += dppx<0x140>(v);
    return (rlane(v, 0) + rlane(v, 16)) + (rlane(v, 32) + rlane(v, 48));
}
__device__ __forceinline__ float wave_max(float v) {
    v = fmaxf(v, dppx<0xB1>(v)); v = fmaxf(v, dppx<0x4E>(v)); v = fmaxf(v, dppx<0x141>(v)); v = fmaxf(v, dppx<0x140>(v));
    return fmaxf(fmaxf(rlane(v, 0), rlane(v, 16)), fmaxf(rlane(v, 32), rlane(v, 48)));
}
__device__ __forceinline__ float rcp_fast(float x) { return __builtin_amdgcn_rcpf(x); }
__device__ __forceinline__ float sigmoidf_(float x) { return rcp_fast(1.f + __expf(-x)); }
__device__ __forceinline__ float siluf_(float x) { return x * rcp_fast(1.f + __expf(-x)); }
__device__ __forceinline__ float logsigmoidf_(float x) { return fminf(x, 0.f) - log1pf(__expf(-fabsf(x))); }
__device__ __forceinline__ float gelu_tanh(float x) { const float u = 0.7978845608028654f * (x + 0.044715f * x * x * x); const float t = 1.f - 2.f * rcp_fast(__expf(2.f * u) + 1.f); return 0.5f * x * (1.f + t); }
__device__ __forceinline__ float expm1_small(float x) {
    float p = 1.f / 720.f; p = p * x + (1.f / 120.f); p = p * x + (1.f / 24.f); p = p * x + (1.f / 6.f); p = p * x + 0.5f; p = p * x + 1.f; p = p * x;
    if (fabsf(x) > 0.5f) p = expm1f(x);
    return p;
}

__device__ __forceinline__ int seq_row0(int s) { return s < 2 ? s * SEQ : ML + (s - 2) * CTXL; }
__device__ __forceinline__ int seq_len(int s) { return s < 2 ? SEQ : CTXL; }
__device__ __forceinline__ int row_mod(int row) { return row < SEQ ? 0 : (row < ML ? 1 : 2); }
__device__ __forceinline__ int tile_row0(int tt) { return tt < 128 ? tt * 64 : ML + (tt - 128) * 64; }
__device__ __forceinline__ void tile_seq(int tt, int& lo, int& hi) { if (tt < 128) { lo = (tt >> 6) * SEQ; hi = lo + SEQ; } else { lo = ML + ((tt - 128) >> 2) * CTXL; hi = lo + CTXL; } }
struct Frame {
    LAS unsigned char* lds;
    int tid, lane, wave;
    int bid, G;
    unsigned char* ws;
    const float* in[24];
    float* out;
};
#define WSP(T, off) ((T*)(F.ws + (off)))

constexpr float W8_SCALE = 256.f, W8_INV = 1.f / 256.f;
struct TItem { const float* src; unsigned char* dst; int N, pitch; bool ok; };
__device__ __forceinline__ TItem t_make(const float* W, int N, void* WT, int ldk, int k0, int n0, int drow0, int lane, bool f8 = false) {
    const int col = n0 + 4 * (lane & 15), kq = lane >> 4;
    TItem t; t.ok = col < N; t.src = W + (size_t)(k0 + 32 * kq) * N + (t.ok ? col : N - 4); const int es = f8 ? 1 : 2;
    t.dst = (unsigned char*)WT + ((size_t)drow0 * ldk + k0) * es; t.N = N; t.pitch = ldk * es; return t;
}
__device__ __forceinline__ unsigned pk4_fp8(float a, float b, float c, float d) { int w = 0; w = __builtin_amdgcn_cvt_pk_fp8_f32(a, b, w, false); w = __builtin_amdgcn_cvt_pk_fp8_f32(c, d, w, true); return (unsigned)w; }
__device__ __forceinline__ TItem t_decode(Frame& F, int it) {
    constexpr int I0 = 32 * 96, I1 = 32 * 64, I2 = 32 * 193, I3 = 32 * 64, I4 = 32 * 1024, I5 = 32 * 512, I6 = 64 * 2;
    int r = it;
    if (r < I0) { const int kb = r / 96, nb = r % 96; return t_make(F.in[8], DIN0, WSP(bf16, WS_W1T), D, kb * 128, nb * 64, nb * 64, F.lane); } r -= I0;
    if (r < I1) { const int kb = r / 64, nb = r % 64; return t_make(F.in[16], D, WSP(bf16, WS_W2T), D, kb * 128, nb * 64, nb * 64, F.lane); } r -= I1;
    if (r < I2) { const int kb = r / 193, nb = r % 193; return t_make(F.in[17], 12320, WSP(bf16, WS_W3T), D, kb * 128, nb * 64, nb * 64, F.lane); } r -= I2;
    if (r < I3) { const int kb = r / 64, nb = r % 64; return t_make(F.in[20], D, WSP(bf16, WS_W4T), D, kb * 128, nb * 64, nb * 64, F.lane); } r -= I3;
    if (r < I4) { const int mat = r / 1024, q = r % 1024, kb = q / 32, nb = q % 32, n0 = nb * 64;
        const int drow0 = 256 * ((n0 & 1023) >> 7) + 128 * (n0 >> 10) + (n0 & 127);
        return t_make(F.in[22] + (size_t)mat * D * 2048, 2048, WSP(unsigned char, WS_WGU) + (size_t)mat * 2048 * D, D, kb * 128, n0, drow0, F.lane, true); } r -= I4;
    if (r < I5) { const int mat = r / 512, q = r % 512, kb = q / 64, nb = q % 64;
        return t_make(F.in[23] + (size_t)mat * DE * D, D, WSP(unsigned char, WS_WDN) + (size_t)mat * D * DE, DE, kb * 128, nb * 64, nb * 64, F.lane, true); } r -= I5;
    if (r < I6) { const int mat = r / 2, nb = r % 2;
        return t_make(F.in[11] + (size_t)mat * 16384, 128, WSP(bf16, WS_GWT) + (size_t)mat * 16384, 128, 0, nb * 64, nb * 64, F.lane); } r -= I6;
    { const int mat = r / 32, q = r % 32, kb = q / 8, nb = q % 8;
        return t_make(F.in[14] + (size_t)mat * 262144, 512, WSP(bf16, WS_PWT) + (size_t)mat * 262144, 512, kb * 128, nb * 64, nb * 64, F.lane); }
}
constexpr int CV_GU0 = 32 * 96 + 32 * 64 + 32 * 193 + 32 * 64;
constexpr int CV_DOWN0 = CV_GU0 + 32 * 1024, CV_DOWN1 = CV_DOWN0 + 16 * 512, CV_DOWN_END = CV_DOWN1 + 16 * 512;
constexpr int CV_NITEMS = CV_DOWN_END + 64 * 2 + 4 * 32;
template <bool F8> __device__ __forceinline__ void convert_items(Frame& F, int lo, int hi, int skip_lo, int skip_hi, int gw, int NGW, int scr_off) {
    constexpr int P = F8 ? 36 : 68, NST = F8 ? 8 : 16;
    LAS unsigned* scr = (LAS unsigned*)(F.lds + scr_off + F.wave * 17408);
    const int n4 = F.lane & 15, kq = F.lane >> 4;
    const int NITEMS = hi - (skip_hi - skip_lo);
#define CV_MAP(i) ((i) >= skip_lo ? (i) + (skip_hi - skip_lo) : (i))
    f32x4 v[32]; TItem cur, nx; nx.ok = false; nx.src = nullptr; nx.dst = nullptr; nx.N = 0; nx.pitch = 0;
    int it = lo + gw;
    if (it < NITEMS) { cur = t_decode(F, CV_MAP(it));
#pragma unroll
        for (int i = 0; i < 32; ++i) v[i] = __builtin_nontemporal_load((const f32x4*)(cur.src + (size_t)i * cur.N));
        unsigned* dump = WSP(unsigned, WS_DUMP) + (gw & 15) * 1024 + F.lane;
#pragma unroll
        for (int j = 0; j < NST; ++j) dump[j * 64] = 0u; }
    while (it < NITEMS) {
#pragma unroll
        for (int r = 0; r < 4; ++r) {
            LAS unsigned* rp = scr + (4 * n4 + r) * P + (F8 ? 8 : 16) * kq;
#define CV_V(i) (cur.ok ? (r == 0 ? v[i].x : (r == 1 ? v[i].y : (r == 2 ? v[i].z : v[i].w))) : 0.f)
            if constexpr (F8) {
#pragma unroll
                for (int q = 0; q < 2; ++q) { v4u w;
                    w.x = pk4_fp8(CV_V(16 * q + 0) * W8_SCALE, CV_V(16 * q + 1) * W8_SCALE, CV_V(16 * q + 2) * W8_SCALE, CV_V(16 * q + 3) * W8_SCALE);
                    w.y = pk4_fp8(CV_V(16 * q + 4) * W8_SCALE, CV_V(16 * q + 5) * W8_SCALE, CV_V(16 * q + 6) * W8_SCALE, CV_V(16 * q + 7) * W8_SCALE);
                    w.z = pk4_fp8(CV_V(16 * q + 8) * W8_SCALE, CV_V(16 * q + 9) * W8_SCALE, CV_V(16 * q + 10) * W8_SCALE, CV_V(16 * q + 11) * W8_SCALE);
                    w.w = pk4_fp8(CV_V(16 * q + 12) * W8_SCALE, CV_V(16 * q + 13) * W8_SCALE, CV_V(16 * q + 14) * W8_SCALE, CV_V(16 * q + 15) * W8_SCALE);
                    *(LAS v4u*)(rp + 4 * q) = w; }
            } else {
#pragma unroll
                for (int q = 0; q < 4; ++q) { v4u w;
                    w.x = pk2(CV_V(8 * q + 0), CV_V(8 * q + 1)); w.y = pk2(CV_V(8 * q + 2), CV_V(8 * q + 3)); w.z = pk2(CV_V(8 * q + 4), CV_V(8 * q + 5)); w.w = pk2(CV_V(8 * q + 6), CV_V(8 * q + 7));
                    *(LAS v4u*)(rp + 4 * q) = w; }
            }
#undef CV_V
        }
        const int nit = it + NGW;
        if (nit < NITEMS) { nx = t_decode(F, CV_MAP(nit));
#pragma unroll
            for (int i = 0; i < 32; ++i) v[i] = __builtin_nontemporal_load((const f32x4*)(nx.src + (size_t)i * nx.N)); }
        asm volatile("s_waitcnt lgkmcnt(0)" ::: "memory");
        if constexpr (F8) { const int c = F.lane & 7;
#pragma unroll
            for (int j = 0; j < 8; ++j) { const int n = (F.lane >> 3) + 8 * j; const v4u o = *(const LAS v4u*)(scr + n * P + 4 * c);
                __builtin_nontemporal_store(o, (v4u*)(cur.dst + (size_t)n * cur.pitch + 16 * c)); }
        } else { const int c = F.lane & 15;
#pragma unroll
            for (int j = 0; j < 16; ++j) { const int n = (F.lane >> 4) + 4 * j; const v4u o = *(const LAS v4u*)(scr + n * P + 4 * c);
                __builtin_nontemporal_store(o, (v4u*)(cur.dst + (size_t)n * cur.pitch + 16 * c)); }
        }
        asm volatile("s_waitcnt lgkmcnt(0)" ::: "memory");
        cur = nx; it = nit;
    }
#undef CV_MAP
}
__device__ __forceinline__ void p0_convert(Frame& F) {
    convert_items<false>(F, 0, CV_NITEMS, CV_GU0, CV_DOWN_END, F.bid * 8 + F.wave, F.G * 8, 0);
    convert_items<true>(F, CV_GU0, CV_DOWN0, 0, 0, F.bid * 8 + F.wave, F.G * 8, 0);
    const int gt = F.bid * NTHR + F.tid, NGT = F.G * NTHR;
    float* wrt = WSP(float, WS_WRT);
    bf16* wrh = WSP(bf16, WS_WRH); bf16* wrl = WSP(bf16, WS_WRL);
    for (int i = gt; i < 2 * 16 * 4096; i += NGT) { const int l = i >> 16, e = (i >> 12) & 15, k = i & 4095; const float w = F.in[21][(size_t)l * 65536 + k * 16 + e]; wrt[i] = w;
        const unsigned hi = f2bf(w); wrh[i] = (bf16)hi; wrl[i] = (bf16)f2bf(w - bf2f(hi)); }
    float* ls8 = WSP(float, WS_LS8);
    for (int i = gt; i < 2 * DLRU; i += NGT) ls8[i] = 8.0f * logsigmoidf_(F.in[13][i]);
}

__device__ __forceinline__ void p0_adaln(Frame& F) {
    LAS float* sc = (LAS float*)F.lds;
    LAS float* red = (LAS float*)(F.lds + 49152);
    constexpr int NIT = 2 * 384;
    if (F.bid >= NIT) return;
    for (int i = F.tid; i < 3 * D; i += NTHR) { const int r = i >> 12, k = i & 4095; const float v = r < 2 ? F.in[1][r * D + k] : F.in[3][k]; sc[i] = siluf_(v); }
    __syncthreads();
    float* mod = WSP(float, WS_MOD);
    for (int it = F.bid; it < NIT; it += F.G) {
        const int l = it / 384, n0 = (it % 384) * 64;
        const float* W = F.in[4] + (size_t)l * D * 24576 + n0 + F.lane;
        float a0 = 0.f, a1 = 0.f, a2 = 0.f;
        const int kbeg = F.wave * 512;
#pragma unroll 64
        for (int k = kbeg; k < kbeg + 512; ++k) { const float w = __builtin_nontemporal_load(W + (size_t)k * 24576); a0 += sc[k] * w; a1 += sc[D + k] * w; a2 += sc[2 * D + k] * w; }
        red[(F.wave * 3 + 0) * 64 + F.lane] = a0; red[(F.wave * 3 + 1) * 64 + F.lane] = a1; red[(F.wave * 3 + 2) * 64 + F.lane] = a2;
        __syncthreads();
        if (F.tid < 192) { const int r = F.tid >> 6, ln = F.tid & 63; float s = 0.f;
#pragma unroll
            for (int w = 0; w < 8; ++w) s += red[(w * 3 + r) * 64 + ln];
            mod[((size_t)l * 3 + r) * 24576 + n0 + ln] = s + F.in[5][l * 24576 + n0 + ln]; }
        __syncthreads();
    }
}

struct Row8 { f32x4 a[8], b[8]; };
__device__ __forceinline__ void ld_row8(Row8& r, const float* p, int lane) {
#pragma unroll
    for (int j = 0; j < 8; ++j) { const float* q = p + 8 * (lane + 64 * j); r.a[j] = *(const f32x4*)q; r.b[j] = *(const f32x4*)(q + 4); }
}
__device__ __forceinline__ void ld_row8_raw(v4u (&h)[8], const bf16* p, int lane) {
#pragma unroll
    for (int j = 0; j < 8; ++j) h[j] = *(const v4u*)(p + 8 * (lane + 64 * j));
}
__device__ __forceinline__ void row8_from_raw(Row8& r, const v4u (&h)[8]) {
#pragma unroll
    for (int j = 0; j < 8; ++j) { r.a[j] = (f32x4){bflo(h[j].x), bfhi(h[j].x), bflo(h[j].y), bfhi(h[j].y)}; r.b[j] = (f32x4){bflo(h[j].z), bfhi(h[j].z), bflo(h[j].w), bfhi(h[j].w)}; }
}
__device__ __forceinline__ void row8_stats(const Row8& r, float& mean, float& rstd) {
    float s = 0.f;
#pragma unroll
    for (int j = 0; j < 8; ++j) s += ((r.a[j].x + r.a[j].y) + (r.a[j].z + r.a[j].w)) + ((r.b[j].x + r.b[j].y) + (r.b[j].z + r.b[j].w));
    mean = wave_sum(s) * (1.f / D);
    float q = 0.f;
#pragma unroll
    for (int j = 0; j < 8; ++j) { const f32x4 d0 = r.a[j] - mean, d1 = r.b[j] - mean; q += ((d0.x * d0.x + d0.y * d0.y) + (d0.z * d0.z + d0.w * d0.w)) + ((d1.x * d1.x + d1.y * d1.y) + (d1.z * d1.z + d1.w * d1.w)); }
    rstd = 1.f / sqrtf(wave_sum(q) * (1.f / D) + LN_EPS);
}
__device__ __forceinline__ v4u pack8(const f32x4& a, const f32x4& b) { v4u o; o.x = pk2(a.x, a.y); o.y = pk2(a.z, a.w); o.z = pk2(b.x, b.y); o.w = pk2(b.z, b.w); return o; }
__device__ __forceinline__ int group_mod(int g) { return g < 512 ? 0 : (g < 1024 ? 1 : 2); }
__device__ __forceinline__ void stage_vec(LAS float* dst, const float* src, int n, int tid) { for (int i = tid * 4; i < n; i += NTHR * 4) *(LAS f32x4*)(dst + i) = *(const f32x4*)(src + i); }

template <int N> __device__ __forceinline__ void prime_stores(Frame& F) {
    unsigned* dump = WSP(unsigned, WS_DUMP) + F.wave * 2048 + F.lane;
#pragma unroll
    for (int j = 0; j < N; ++j) dump[(j & 31) * 64] = 0u;
}
__device__ __forceinline__ void p1_ln0(Frame& F) {
    bf16* H = WSP(bf16, WS_H); bf16* U = WSP(bf16, WS_U); const float* mod = WSP(float, WS_MOD);
    LAS float* SH = (LAS float*)F.lds; LAS float* SC = SH + D;
    int cur_mod = -1; Row8 cur, nxt;
    { const int g0 = F.bid; if (g0 < MT / 8) { const int row = 8 * g0 + F.wave; ld_row8(cur, row < ML ? F.in[0] + (size_t)row * D : F.in[2] + (size_t)(row - ML) * D, F.lane); prime_stores<16>(F); } }
    for (int g = F.bid; g < MT / 8; g += F.G) {
        const int row = 8 * g + F.wave, mr = group_mod(g);
        if (mr != cur_mod) { __syncthreads(); stage_vec(SH, mod + (size_t)mr * 24576, D, F.tid); stage_vec(SC, mod + (size_t)mr * 24576 + D, D, F.tid); __syncthreads(); cur_mod = mr; }
        const int gn = g + F.G; if (gn < MT / 8) { const int rn = 8 * gn + F.wave; ld_row8(nxt, rn < ML ? F.in[0] + (size_t)rn * D : F.in[2] + (size_t)(rn - ML) * D, F.lane); }
        float mean, rstd; row8_stats(cur, mean, rstd);
#pragma unroll
        for (int j = 0; j < 8; ++j) { const int c = 8 * (F.lane + 64 * j); const f32x4 y0 = (cur.a[j] - mean) * rstd, y1 = (cur.b[j] - mean) * rstd;
            *(v4u*)(H + (size_t)row * D + c) = pack8(y0, y1);
            const f32x4 u0 = y0 * (1.f + *(const LAS f32x4*)(SC + c)) + *(const LAS f32x4*)(SH + c), u1 = y1 * (1.f + *(const LAS f32x4*)(SC + c + 4)) + *(const LAS f32x4*)(SH + c + 4);
            *(v4u*)(U + (size_t)row * D + c) = pack8(u0, u1); }
        cur = nxt;
    }
    __syncthreads();
}

using pg8::Unit;
struct EpiBf16Plain {
    static constexpr bool PERM = true;
    bf16* O; int ldc;
    __device__ __forceinline__ void operator()(const f32x4 (&acc)[2][2][4][2], const Unit& u, int wr, int wc, int fr, int fq) const {
        const int row0 = u.pm * 256 + wr * 64 + fr, col0 = u.pn * 256 + wc * 32 + 8 * fq;
#pragma unroll
        for (int ai = 0; ai < 2; ++ai)
#pragma unroll
            for (int m = 0; m < 4; ++m) { bf16* rowp = O + (size_t)(row0 + ai * 128 + m * 16) * ldc + col0;
#pragma unroll
                for (int bj = 0; bj < 2; ++bj) { const f32x4 v0 = acc[ai][bj][m][0], v1 = acc[ai][bj][m][1];
                    v4u w; w.x = pg8::cvt_pk_bf16(v0[0], v0[1]); w.y = pg8::cvt_pk_bf16(v0[2], v0[3]); w.z = pg8::cvt_pk_bf16(v1[0], v1[1]); w.w = pg8::cvt_pk_bf16(v1[2], v1[3]);
                    *(v4u*)(rowp + bj * 128) = w; } }
    }
};
struct EpiOddIn {
    static constexpr bool PERM = true;
    bf16* O; float* Gt; const float* gb;
    __device__ __forceinline__ void operator()(const f32x4 (&acc)[2][2][4][2], const Unit& u, int wr, int wc, int fr, int fq) const {
        const int row0 = u.pm * 256 + wr * 64 + fr;
        if (u.pn < 48) {
            const int col0 = u.pn * 256 + wc * 32 + 8 * fq;
#pragma unroll
            for (int ai = 0; ai < 2; ++ai)
#pragma unroll
                for (int m = 0; m < 4; ++m) { bf16* rowp = O + (size_t)(row0 + ai * 128 + m * 16) * DIN1 + col0;
#pragma unroll
                    for (int bj = 0; bj < 2; ++bj) { const f32x4 v0 = acc[ai][bj][m][0], v1 = acc[ai][bj][m][1];
                        v4u w; w.x = pg8::cvt_pk_bf16(v0[0], v0[1]); w.y = pg8::cvt_pk_bf16(v0[2], v0[3]); w.z = pg8::cvt_pk_bf16(v1[0], v1[1]); w.w = pg8::cvt_pk_bf16(v1[2], v1[3]);
                        *(v4u*)(rowp + bj * 128) = w; } }
        } else if (wc == 0) {
            const int c0 = 8 * fq; const f32x4 b0 = *(const f32x4*)(gb + c0), b1 = *(const f32x4*)(gb + c0 + 4);
#pragma unroll
            for (int ai = 0; ai < 2; ++ai)
#pragma unroll
                for (int m = 0; m < 4; ++m) { float* rowp = Gt + (size_t)(row0 + ai * 128 + m * 16) * 32 + c0;
                    *(f32x4*)(rowp) = acc[ai][0][m][0] + b0; *(f32x4*)(rowp + 4) = acc[ai][0][m][1] + b1; }
        }
    }
};
struct EpiSlab {
    static constexpr bool PERM = false;
    float* slab; int nS;
    __device__ __forceinline__ void operator()(const f32x4 (&acc)[2][2][4][2], const Unit& u, int wr, int wc, int fr, int fq) const {
        float* base = slab + (size_t)(u.t * nS + u.ks) * 65536 + (wr * 64 + fr) * 256 + wc * 32 + 4 * fq;
#pragma unroll
        for (int ai = 0; ai < 2; ++ai)
#pragma unroll
            for (int m = 0; m < 4; ++m)
#pragma unroll
                for (int bj = 0; bj < 2; ++bj)
#pragma unroll
                    for (int n = 0; n < 2; ++n) *(f32x4*)(base + (ai * 128 + m * 16) * 256 + bj * 128 + n * 16) = acc[ai][bj][m][n];
    }
};
struct EpiResid {
    static constexpr bool PERM = false;
    float* H; const float* modl;
    int goff;
    __device__ __forceinline__ void operator()(const f32x4 (&acc)[2][2][4][2], const Unit& u, int wr, int wc, int fr, int fq) const {
        const int row0 = u.pm * 256 + wr * 64 + fr, col0 = u.pn * 256 + wc * 32 + 4 * fq;
        const float* gv = modl + (size_t)row_mod(u.pm * 256) * 24576 + goff + col0;
        f32x4 g[2][2];
#pragma unroll
        for (int bj = 0; bj < 2; ++bj)
#pragma unroll
            for (int n = 0; n < 2; ++n) g[bj][n] = *(const f32x4*)(gv + bj * 128 + n * 16);
#pragma unroll
        for (int ai = 0; ai < 2; ++ai)
#pragma unroll
            for (int m = 0; m < 4; ++m) { float* rowp = H + (size_t)(row0 + ai * 128 + m * 16) * D + col0;
#pragma unroll
                for (int bj = 0; bj < 2; ++bj)
#pragma unroll
                    for (int n = 0; n < 2; ++n) { const f32x4 h = *(const f32x4*)(rowp + bj * 128 + n * 16); *(f32x4*)(rowp + bj * 128 + n * 16) = DN_ALPHA * h + g[bj][n] * acc[ai][bj][m][n]; }
                asm volatile("" ::: "memory"); }
    }
};
struct EpiPool {
    static constexpr bool PERM = true;
    bf16* A2; const float* ps;
    __device__ __forceinline__ void operator()(const f32x4 (&acc)[2][2][4][2], const Unit& u, int wr, int wc, int fr, int fq) const {
        const int row0 = u.pm * 256 + wr * 64 + fr, col0 = 512 * u.g + u.pn * 256 + wc * 32 + 8 * fq;
#pragma unroll
        for (int ai = 0; ai < 2; ++ai)
#pragma unroll
            for (int m = 0; m < 4; ++m) { bf16* rowp = A2 + (size_t)(row0 + ai * 128 + m * 16) * D + 2048 + col0;
#pragma unroll
                for (int bj = 0; bj < 2; ++bj) { const f32x4 s0 = *(const f32x4*)(ps + col0 + bj * 128), s1 = *(const f32x4*)(ps + col0 + bj * 128 + 4);
                    const f32x4 v0 = acc[ai][bj][m][0] * s0, v1 = acc[ai][bj][m][1] * s1;
                    v4u w; w.x = pg8::cvt_pk_bf16(v0[0], v0[1]); w.y = pg8::cvt_pk_bf16(v0[2], v0[3]); w.z = pg8::cvt_pk_bf16(v1[0], v1[1]); w.w = pg8::cvt_pk_bf16(v1[2], v1[3]);
                    *(v4u*)(rowp + bj * 128) = w; } }
    }
};
struct EpiGU {
    static constexpr bool PERM = true;
    unsigned char* ACT; int er;
    __device__ __forceinline__ void operator()(const f32x4 (&acc)[2][2][4][2], const Unit& u, int wr, int wc, int fr, int fq) const {
        const int row0 = u.pm * 256 + wr * 64 + fr, col0 = u.pn * 128 + wc * 32 + 8 * fq;
        unsigned char* base = ACT + (size_t)u.g * er * DE;
#pragma unroll
        for (int ai = 0; ai < 2; ++ai)
#pragma unroll
            for (int m = 0; m < 4; ++m) { unsigned char* rowp = base + (size_t)(row0 + ai * 128 + m * 16) * DE + col0;
                f32x4 v0, v1;
#pragma unroll
                for (int j = 0; j < 4; ++j) { v0[j] = siluf_(acc[ai][0][m][0][j] * W8_INV) * (acc[ai][1][m][0][j] * W8_INV); v1[j] = siluf_(acc[ai][0][m][1][j] * W8_INV) * (acc[ai][1][m][1][j] * W8_INV); }
                v2u w; w.x = pk4_fp8(v0[0], v0[1], v0[2], v0[3]); w.y = pk4_fp8(v1[0], v1[1], v1[2], v1[3]);
                *(v2u*)(rowp) = w; }
    }
};
struct EpiDown {
    static constexpr bool PERM = true;
    bf16* YE; const float* GX; int er;
    __device__ __forceinline__ void operator()(const f32x4 (&acc)[2][2][4][2], const Unit& u, int wr, int wc, int fr, int fq) const {
        const int row0 = u.pm * 256 + wr * 64 + fr, col0 = u.pn * 256 + wc * 32 + 8 * fq;
        bf16* base = YE + (size_t)u.g * er * D; const float* gx = GX + u.g * er;
#pragma unroll
        for (int ai = 0; ai < 2; ++ai)
#pragma unroll
            for (int m = 0; m < 4; ++m) { const int row = row0 + ai * 128 + m * 16; const float s = gx[row] * W8_INV; bf16* rowp = base + (size_t)row * D + col0;
#pragma unroll
                for (int bj = 0; bj < 2; ++bj) { const f32x4 v0 = acc[ai][bj][m][0] * s, v1 = acc[ai][bj][m][1] * s;
                    v4u w; w.x = pg8::cvt_pk_bf16(v0[0], v0[1]); w.y = pg8::cvt_pk_bf16(v0[2], v0[3]); w.z = pg8::cvt_pk_bf16(v1[0], v1[1]); w.w = pg8::cvt_pk_bf16(v1[2], v1[3]);
                    *(v4u*)(rowp + bj * 128) = w; } }
    }
};
constexpr int LRU_XC = 0, LRU_AF = 17408, LRU_BF = 50176, LRU_SG = 82944, LRU_XT = 87040, LRU_CW = 105472;
constexpr size_t WS_LS = WS_XE, WS_LPF = WS_XE + (size_t)MT * DLRU * 2, WS_LPB = WS_XE + (size_t)MT * DLRU * 4;
#ifndef RSEL
#define RSEL 0
#endif
#define RT4(k) do { if (RSEL) { const unsigned long long tn_ = __builtin_amdgcn_s_memrealtime(); if (RSEL == (k)) *racc += tn_ - rprev; rprev = tn_; } } while (0)
__device__ __forceinline__ void lru_phase(Frame& F, unsigned long long* racc = nullptr) {
    unsigned long long rprev = RSEL ? __builtin_amdgcn_s_memrealtime() : 0ull;
    const bf16* XZS = WSP(bf16, WS_BIG);
    const bf16* GWT = WSP(bf16, WS_GWT);
    const float* LS8 = WSP(float, WS_LS8);
    float* SUMM = WSP(float, WS_SUMM);
    bf16* LSb = WSP(bf16, WS_LS); bf16* LPF = WSP(bf16, WS_LPF); bf16* LPB = WSP(bf16, WS_LPB);
    const float* convw = F.in[9]; const float* convb = F.in[10]; const float* gateb = F.in[12];
    const int wr = F.wave >> 2, wc = F.wave & 3, fr = F.lane & 15, fq = F.lane >> 4;
    LAS unsigned char* XC = F.lds + LRU_XC; LAS float* AF = (LAS float*)(F.lds + LRU_AF); LAS float* BF = (LAS float*)(F.lds + LRU_BF); LAS float* SG = (LAS float*)(F.lds + LRU_SG); LAS unsigned char* XT = F.lds + LRU_XT; LAS float* CW = (LAS float*)(F.lds + LRU_CW);
    const bool hfixed = (F.G & 15) == 0;
#pragma unroll 1
    for (int d = 0; d < 2; ++d) {
        bf16x8 bfr[2][2][4];
        f32x4 gb0[2], gb1[2], l8[2];
        int hcur = -1;
        v4u xpre[3];
#define LRU_XLOAD(u_) do { const int tt_ = (u_) >> 4, h_ = (u_) & 15, r0_ = tile_row0(tt_); int lo_, hi_; tile_seq(tt_, lo_, hi_); \
            _Pragma("unroll") for (int i = 0; i < 3; ++i) { const int q = F.tid + NTHR * i, row = r0_ - 1 + (q >> 4); const bool ok = q < 67 * 16 && row >= lo_ && row < hi_; \
                const v4u xv_ = *(const v4u*)(XZS + (size_t)(ok ? row : r0_) * DIN0 + h_ * 128 + (q & 15) * 8); xpre[i] = ok ? xv_ : (v4u){0u, 0u, 0u, 0u}; } } while (0)
        for (int unit = F.bid; unit < NT_TILES * LRUH; unit += F.G) {
            const int tt = unit >> 4, h = unit & 15;
            const int r0 = tile_row0(tt); int slo, shi; tile_seq(tt, slo, shi);
            if (h != hcur) {
                hcur = h;
                __syncthreads();
                for (int i = F.tid; i < 640; i += NTHR) CW[i] = i < 512 ? convw[(i >> 7) * DLRU + h * 128 + (i & 127)] : convb[h * 128 + (i - 512)];
#pragma unroll
                for (int g = 0; g < 2; ++g)
#pragma unroll
                    for (int n = 0; n < 2; ++n)
#pragma unroll
                        for (int ks = 0; ks < 4; ++ks) bfr[g][n][ks] = *(const bf16x8*)(GWT + (size_t)((d * 2 + g) * 16 + h) * 16384 + (32 * wc + 16 * n + fr) * 128 + ks * 32 + fq * 8);
#pragma unroll
                for (int n = 0; n < 2; ++n) { const int ch = h * 128 + 32 * wc + 16 * n + 4 * fq;
                    gb0[n] = *(const f32x4*)(gateb + (d * 2 + 0) * DLRU + ch); gb1[n] = *(const f32x4*)(gateb + (d * 2 + 1) * DLRU + ch); l8[n] = *(const f32x4*)(LS8 + d * DLRU + ch); }
            }
            if (unit == F.bid) { LRU_XLOAD(unit); }
#pragma unroll
            for (int i = 0; i < 3; ++i) { const int q = F.tid + NTHR * i; if (q < 67 * 16) *(LAS v4u*)(XT + (q >> 4) * 272 + (q & 15) * 16) = xpre[i]; }
            __syncthreads();
            if (unit + F.G < NT_TILES * LRUH) { LRU_XLOAD(unit + F.G); }
            f32x4 xcv[2][2];
#pragma unroll
            for (int m = 0; m < 2; ++m)
#pragma unroll
                for (int n = 0; n < 2; ++n) {
                    const int t = 32 * wr + 16 * m + fr, c = 32 * wc + 16 * n + 4 * fq;
                    f32x4 a = *(const LAS f32x4*)(CW + 512 + c);
#pragma unroll
                    for (int j = 0; j < 4; ++j) { const v2u xv = *(const LAS v2u*)(XT + (t + j) * 272 + c * 2); const f32x4 w = *(const LAS f32x4*)(CW + j * 128 + c);
                        a.x += w.x * bflo(xv.x); a.y += w.y * bfhi(xv.x); a.z += w.z * bflo(xv.y); a.w += w.w * bfhi(xv.y); }
                    xcv[m][n] = a;
                    v2u o; o.x = pk2(a.x, a.y); o.y = pk2(a.z, a.w); *(LAS v2u*)(XC + t * 272 + c * 2) = o;
                }
            __syncthreads();
            RT4(12);
            f32x4 acc[2][2][2];
#pragma unroll
            for (int g = 0; g < 2; ++g)
#pragma unroll
                for (int m = 0; m < 2; ++m)
#pragma unroll
                    for (int n = 0; n < 2; ++n) acc[g][m][n] = (f32x4){0.f, 0.f, 0.f, 0.f};
#pragma unroll
            for (int ks = 0; ks < 4; ++ks) {
                bf16x8 af[2];
#pragma unroll
                for (int m = 0; m < 2; ++m) af[m] = *(const LAS bf16x8*)(XC + (32 * wr + 16 * m + fr) * 272 + (ks * 32 + fq * 8) * 2);
#pragma unroll
                for (int g = 0; g < 2; ++g)
#pragma unroll
                    for (int n = 0; n < 2; ++n)
#pragma unroll
                        for (int m = 0; m < 2; ++m) acc[g][m][n] = __builtin_amdgcn_mfma_f32_16x16x32_bf16(bfr[g][n][ks], af[m], acc[g][m][n], 0, 0, 0);
            }
#pragma unroll
            for (int m = 0; m < 2; ++m)
#pragma unroll
                for (int n = 0; n < 2; ++n) {
                    const int t = 32 * wr + 16 * m + fr, c = 32 * wc + 16 * n + 4 * fq;
                    f32x4 av, bv;
#pragma unroll
                    for (int j = 0; j < 4; ++j) { const float r = sigmoidf_(acc[0][m][n][j] + gb0[n][j]), ig = sigmoidf_(acc[1][m][n][j] + gb1[n][j]);
                        const float la = l8[n][j] * r, em1 = expm1_small(la); av[j] = 1.f + em1; bv[j] = __builtin_amdgcn_sqrtf(-em1 * (2.f + em1)) * ig * xcv[m][n][j]; }
                    *(LAS f32x4*)(AF + t * 128 + c) = av; *(LAS f32x4*)(BF + t * 128 + c) = bv;
                }
            __syncthreads();
            RT4(13);
            {
                const int c = F.tid & 127, seg = F.tid >> 7, ch = h * 128 + c;
                const int tb = d == 0 ? 16 * seg : 16 * seg + 15, ts = d == 0 ? 1 : -1;
                float hs = 0.f, P = 1.f;
#pragma unroll
                for (int i = 0; i < 16; ++i) { const int t = tb + ts * i; const float a = AF[t * 128 + c]; hs = a * hs + BF[t * 128 + c]; P *= a; }
                SG[(seg * 2 + 0) * 128 + c] = P; SG[(seg * 2 + 1) * 128 + c] = hs;
                __syncthreads();
                float Pin = 1.f, Hin = 0.f;
#pragma unroll
                for (int q = 0; q < 3; ++q) { const int sgi = d == 0 ? q : 3 - q; const bool before = d == 0 ? (sgi < seg) : (sgi > seg);
                    if (before) { const float Pq = SG[(sgi * 2 + 0) * 128 + c]; Hin = Pq * Hin + SG[(sgi * 2 + 1) * 128 + c]; Pin *= Pq; } }
                hs = Hin; P = Pin;
#pragma unroll
                for (int i = 0; i < 16; ++i) { const int t = tb + ts * i; const float a = AF[t * 128 + c]; hs = a * hs + BF[t * 128 + c]; P *= a; AF[t * 128 + c] = P; BF[t * 128 + c] = hs; }
                if (seg == (d == 0 ? 3 : 0)) { SUMM[((size_t)(tt * 2 + d) * 2 + 0) * DLRU + ch] = P; SUMM[((size_t)(tt * 2 + d) * 2 + 1) * DLRU + ch] = hs; }
            }
            __syncthreads();
            RT4(14);
            {
                const int et = F.tid >> 3, ecg = (F.tid & 7) * 16;
                const size_t go = (size_t)(r0 + et) * DLRU + h * 128 + ecg; f32x4 pv[4], hv[4];
#pragma unroll
                for (int i = 0; i < 4; ++i) { pv[i] = *(const LAS f32x4*)(AF + et * 128 + ecg + 4 * i); hv[i] = *(const LAS f32x4*)(BF + et * 128 + ecg + 4 * i); }
                bf16* pdst = d == 0 ? LPF : LPB;
                *(v4u*)(pdst + go) = pack8(pv[0], pv[1]); *(v4u*)(pdst + go + 8) = pack8(pv[2], pv[3]);
                if (d == 1) { const v4u f0 = *(const v4u*)(LSb + go), f1 = *(const v4u*)(LSb + go + 8);
                    hv[0] += (f32x4){bflo(f0.x), bfhi(f0.x), bflo(f0.y), bfhi(f0.y)}; hv[1] += (f32x4){bflo(f0.z), bfhi(f0.z), bflo(f0.w), bfhi(f0.w)};
                    hv[2] += (f32x4){bflo(f1.x), bfhi(f1.x), bflo(f1.y), bfhi(f1.y)}; hv[3] += (f32x4){bflo(f1.z), bfhi(f1.z), bflo(f1.w), bfhi(f1.w)}; }
                *(v4u*)(LSb + go) = pack8(hv[0], hv[1]); *(v4u*)(LSb + go + 8) = pack8(hv[2], hv[3]);
            }
            __syncthreads();
            RT4(15);
        }
        asm volatile("s_waitcnt vmcnt(0)" ::: "memory");
#undef LRU_XLOAD
    }
}
__device__ __forceinline__ void lru_apply(Frame& F) {
    const bf16* XZS = WSP(bf16, WS_BIG); const float* CARRY = WSP(float, WS_CARRY); bf16* A2 = WSP(bf16, WS_A2);
    const bf16* LSb = WSP(bf16, WS_LS); const bf16* LPF = WSP(bf16, WS_LPF); const bf16* LPB = WSP(bf16, WS_LPB);
    const int gt = F.bid * NTHR + F.tid, NGT = F.G * NTHR;
    for (int i = gt; i < MT * (DLRU / 8); i += NGT) {
        const int row = i >> 8, c = (i & 255) * 8; const int tt = row < ML ? (row >> 6) : 128 + ((row - ML) >> 6);
        const size_t go = (size_t)row * DLRU + c;
        const v4u sv = *(const v4u*)(LSb + go), pf = *(const v4u*)(LPF + go), pb = *(const v4u*)(LPB + go), zv = *(const v4u*)(XZS + (size_t)row * DIN0 + DLRU + c);
        const f32x4 cf0 = *(const f32x4*)(CARRY + (size_t)(tt * 2 + 0) * DLRU + c), cf1 = *(const f32x4*)(CARRY + (size_t)(tt * 2 + 0) * DLRU + c + 4);
        const f32x4 cb0 = *(const f32x4*)(CARRY + (size_t)(tt * 2 + 1) * DLRU + c), cb1 = *(const f32x4*)(CARRY + (size_t)(tt * 2 + 1) * DLRU + c + 4);
        v4u o;
#pragma unroll
        for (int k = 0; k < 4; ++k) { const float fa = k < 2 ? cf0[2 * k] : cf1[2 * k - 4], fb = k < 2 ? cf0[2 * k + 1] : cf1[2 * k - 3], ba = k < 2 ? cb0[2 * k] : cb1[2 * k - 4], bb = k < 2 ? cb0[2 * k + 1] : cb1[2 * k - 3];
            const float v0 = (bflo(sv[k]) + bflo(pf[k]) * fa + bflo(pb[k]) * ba) * gelu_tanh(bflo(zv[k])), v1 = (bfhi(sv[k]) + bfhi(pf[k]) * fb + bfhi(pb[k]) * bb) * gelu_tanh(bfhi(zv[k]));
            o[k] = pk2(v0, v1); }
        *(v4u*)(A2 + (size_t)row * D + c) = o;
    }
}

__device__ __forceinline__ void lru_carry(Frame& F) {
    const float* SUMM = WSP(float, WS_SUMM); float* CARRY = WSP(float, WS_CARRY);
    const int gt = F.bid * NTHR + F.tid, NGT = F.G * NTHR;
    for (int i = gt; i < NB * 2 * DLRU; i += NGT) {
        const int ch = i & 2047, d = (i >> 11) & 1, b = i >> 12;
        float st = 0.f;
#pragma unroll 1
        for (int half = 0; half < 2; ++half) {
            float Pv[34], Hv[34];
#pragma unroll
            for (int q = 0; q < 34; ++q) { const int s = half * 34 + q; const int tt = s < 4 ? 128 + 4 * b + (d ? 3 - s : s) : 64 * b + (d ? 63 - (s - 4) : (s - 4));
                Pv[q] = SUMM[((size_t)(tt * 2 + d) * 2 + 0) * DLRU + ch]; Hv[q] = SUMM[((size_t)(tt * 2 + d) * 2 + 1) * DLRU + ch]; }
#pragma unroll
            for (int q = 0; q < 34; ++q) { const int s = half * 34 + q; const int tt = s < 4 ? 128 + 4 * b + (d ? 3 - s : s) : 64 * b + (d ? 63 - (s - 4) : (s - 4));
                CARRY[(size_t)(tt * 2 + d) * DLRU + ch] = st; st = Pv[q] * st + Hv[q]; }
        }
    }
}

__device__ __forceinline__ int pool_w_of(int g) { return 2 << g; }
__device__ __forceinline__ void pool_pass1(Frame& F) {
    const bf16* XZS = WSP(bf16, WS_BIG); float* CM = WSP(float, WS_CM);
    LAS unsigned char* T = F.lds;
    for (int unit = F.bid; unit < NB * 64 * 4; unit += F.G) {
        const int g = unit & 3, gr = (unit >> 2) & 63, b = unit >> 8; const int row0 = b * SEQ + gr * 64, w = pool_w_of(g);
        for (int i = F.tid; i < 64 * 64; i += NTHR) { const int r = i >> 6, cseg = i & 63;
            *(LAS v4u*)(T + r * 1024 + cseg * 16) = *(const v4u*)(XZS + (size_t)(row0 + r) * DIN0 + 2 * DLRU + g * 512 + cseg * 8); }
        __syncthreads();
        const int c8 = (F.tid & 63) * 8, part = F.tid >> 6;
#pragma unroll 2
        for (int j = part * 8; j < part * 8 + 8; ++j) {
            const int lo = max(0, j - w / 2), hi = min(64, j + w - w / 2);
            f32x4 s0 = (f32x4){0.f, 0.f, 0.f, 0.f}, s1 = s0;
            for (int q = lo; q < hi; ++q) { const v4u v = *(const LAS v4u*)(T + q * 1024 + c8 * 2);
                s0 += (f32x4){bflo(v.x), bfhi(v.x), bflo(v.y), bfhi(v.y)}; s1 += (f32x4){bflo(v.z), bfhi(v.z), bflo(v.w), bfhi(v.w)}; }
            const float inv = 1.f / (float)(hi - lo);
            float* cp_ = CM + (size_t)(row0 + j) * DPOOL + g * 512 + c8;
            *(f32x4*)cp_ = s0 * inv; *(f32x4*)(cp_ + 4) = s1 * inv;
        }
        __syncthreads();
    }
}
__device__ __forceinline__ void pool_pass2(Frame& F) {
    const bf16* XZS = WSP(bf16, WS_BIG); const float* CM = WSP(float, WS_CM); bf16* DP = WSP(bf16, WS_DP);
    LAS float* T = (LAS float*)F.lds;
    for (int unit = F.bid; unit < NB * 64 * 4 * 2; unit += F.G) {
        const int hc = unit & 1, g = (unit >> 1) & 3, gc = (unit >> 3) & 63, b = unit >> 9; const int w = pool_w_of(g), cb = g * 512 + hc * 256;
        for (int i = F.tid; i < 64 * 64; i += NTHR) { const int r = i >> 6, cseg = i & 63;
            *(LAS f32x4*)(T + r * 256 + cseg * 4) = *(const f32x4*)(CM + (size_t)(b * SEQ + r * 64 + gc) * DPOOL + cb + cseg * 4); }
        __syncthreads();
        const int c4 = (F.tid & 63) * 4, part = F.tid >> 6;
        v2u xs[8];
#pragma unroll
        for (int q = 0; q < 8; ++q) xs[q] = *(const v2u*)(XZS + (size_t)(b * SEQ + (part * 8 + q) * 64 + gc) * DIN0 + 2 * DLRU + cb + c4);
#pragma unroll
        for (int q = 0; q < 8; ++q) { const int r = part * 8 + q;
            const int lo = max(0, r - w / 2), hi = min(64, r + w - w / 2);
            f32x4 sm = (f32x4){0.f, 0.f, 0.f, 0.f};
            for (int k = lo; k < hi; ++k) sm += *(const LAS f32x4*)(T + k * 256 + c4);
            const float inv = 1.f / (float)(hi - lo);
            v2u o; o.x = pk2(sm.x * inv - bflo(xs[q].x), sm.y * inv - bfhi(xs[q].x)); o.y = pk2(sm.z * inv - bflo(xs[q].y), sm.w * inv - bfhi(xs[q].y));
            *(v2u*)(DP + (size_t)(b * SEQ + r * 64 + gc) * DPOOL + cb + c4) = o;
        }
        __syncthreads();
    }
}
__device__ __forceinline__ void pool_ctx(Frame& F) {
    const bf16* XZS = WSP(bf16, WS_BIG); bf16* DP = WSP(bf16, WS_DP);
    const int gt = F.bid * NTHR + F.tid, NGT = F.G * NTHR;
    for (int i = gt; i < MC * (DPOOL / 8); i += NGT) {
        const int ch = (i & 255) * 8, r = i >> 8, b = r >> 8, t = r & 255; const int w = pool_w_of(ch >> 9);
        const int lo = max(0, t - w / 2), hi = min(CTXL, t + w - w / 2);
        v4u v[16];
#pragma unroll
        for (int q = 0; q < 16; ++q) { const int k = min(lo + q, CTXL - 1); v[q] = *(const v4u*)(XZS + (size_t)(ML + b * CTXL + k) * DIN0 + 2 * DLRU + ch); }
        const v4u x = *(const v4u*)(XZS + (size_t)(ML + r) * DIN0 + 2 * DLRU + ch);
        f32x4 s0 = (f32x4){0.f, 0.f, 0.f, 0.f}, s1 = s0;
#pragma unroll
        for (int q = 0; q < 16; ++q) { const float m = (lo + q < hi) ? 1.f : 0.f;
            s0 += m * (f32x4){bflo(v[q].x), bfhi(v[q].x), bflo(v[q].y), bfhi(v[q].y)}; s1 += m * (f32x4){bflo(v[q].z), bfhi(v[q].z), bflo(v[q].w), bfhi(v[q].w)}; }
        const float inv = 1.f / (float)(hi - lo);
        const f32x4 o0 = s0 * inv - (f32x4){bflo(x.x), bfhi(x.x), bflo(x.y), bfhi(x.y)}, o1 = s1 * inv - (f32x4){bflo(x.z), bfhi(x.z), bflo(x.w), bfhi(x.w)};
        *(v4u*)(DP + (size_t)(ML + r) * DPOOL + ch) = pack8(o0, o1);
    }
}
#ifndef RSEL
#define RSEL 0
#endif
#define RT(k) do { if (RSEL) { const unsigned long long tn_ = __builtin_amdgcn_s_memrealtime(); if (RSEL == (k)) *racc += tn_ - rprev; rprev = tn_; } } while (0)
__device__ __forceinline__ void ln_router_phase(Frame& F, int l, int nrows, bool probe = false, bool ctx_slab = false, unsigned long long* racc = nullptr) {
    unsigned char* U8 = probe ? WSP(unsigned char, WS_CM) : WSP(unsigned char, WS_U8);
    const bf16* Ymix = WSP(bf16, WS_YE);
    unsigned long long rprev = RSEL ? __builtin_amdgcn_s_memrealtime() : 0ull;
    const bf16* Hin = WSP(bf16, WS_H); bf16* H = probe ? WSP(bf16, WS_XE) : WSP(bf16, WS_H); bf16* U = probe ? WSP(bf16, WS_YE) : WSP(bf16, WS_U); const float* mod = WSP(float, WS_MOD) + (size_t)l * 3 * 24576;
    const f32x4* wrt4 = (const f32x4*)(WSP(float, WS_WRT) + (size_t)l * 16 * D); float* AFF = probe ? WSP(float, WS_CM) : WSP(float, WS_AFF);
    LAS float* LG = (LAS float*)F.lds; LAS float* LB = LG + D; LAS float* SH = LG + 2 * D; LAS float* SC = LG + 3 * D; LAS unsigned char* UH = F.lds + 65536; LAS unsigned char* UL = F.lds + 65536 + 32896; LAS float* RED = (LAS float*)(F.lds + 65536 + 65792);
    const bf16* wrh = WSP(bf16, WS_WRH) + (size_t)l * 16 * D; const bf16* wrl = WSP(bf16, WS_WRL) + (size_t)l * 16 * D;
    const int ngroups = nrows / 8;
    stage_vec(LG, F.in[6] + (size_t)(l * 2 + 0) * D, D, F.tid); stage_vec(LB, F.in[7] + (size_t)(l * 2 + 0) * D, D, F.tid);
    if (ctx_slab) {
        const float* slab = WSP(float, WS_SLAB); const float* gv = mod + (size_t)2 * 24576 + 2 * D; bf16* Hw = WSP(bf16, WS_H);
        for (int g = 1024 + (F.bid + F.G - 1024 % F.G) % F.G; g < ngroups; g += F.G) { const int row = 8 * g + F.wave, r = row - ML;
#pragma unroll 1
            for (int j = 0; j < 8; ++j) { const int c = 8 * (F.lane + 64 * j); const float* sp = slab + (size_t)(((r >> 8) + 2 * (c >> 8)) * 8) * 65536 + (r & 255) * 256 + (c & 255);
                f32x4 s0 = (f32x4){0.f, 0.f, 0.f, 0.f}, s1 = s0;
#pragma unroll
                for (int ks = 0; ks < 8; ++ks) { s0 += *(const f32x4*)(sp + (size_t)ks * 65536); s1 += *(const f32x4*)(sp + (size_t)ks * 65536 + 4); }
                bf16* hp = Hw + (size_t)row * D + c; const v4u hv = *(const v4u*)hp;
                const f32x4 t0 = DN_ALPHA * (f32x4){bflo(hv.x), bfhi(hv.x), bflo(hv.y), bfhi(hv.y)} + *(const f32x4*)(gv + c) * s0, t1 = DN_ALPHA * (f32x4){bflo(hv.z), bfhi(hv.z), bflo(hv.w), bfhi(hv.w)} + *(const f32x4*)(gv + c + 4) * s1;
                *(v4u*)hp = pack8(t0, t1); }
        }
        asm volatile("s_waitcnt vmcnt(0)" ::: "memory");
    }
    int cur_mod = -1; Row8 cur; v4u yrow[8], hraw[8];
#define LNR_LOAD(g_) do { const int row_ = 8 * (g_) + F.wave; ld_row8_raw(hraw, Hin + (size_t)row_ * D, F.lane); { const size_t yr_ = (size_t)((g_) < 1024 ? row_ : 0) * D; _Pragma("unroll") for (int j_ = 0; j_ < 8; ++j_) yrow[j_] = *(const v4u*)(Ymix + yr_ + 8 * (F.lane + 64 * j_)); } } while (0)
    const bool rebal = ctx_slab && F.G == 256 && ngroups == 1088;
#define LNR_GRP(i_) (!rebal ? (F.bid + (i_) * F.G < ngroups ? F.bid + (i_) * F.G : -1) \
        : ((i_) < (F.bid < 64 ? 3 : 4) ? F.bid + 256 * (i_) : ((i_) > (F.bid < 64 ? 3 : 4) ? -1 : (F.bid < 64 ? 1024 + F.bid : (F.bid < 128 ? F.bid + 704 : -1)))))
    int gcur = LNR_GRP(0);
    if (gcur >= 0) { LNR_LOAD(gcur); }
    for (int it = 0; gcur >= 0; ++it) {
        const int g = gcur, gnx = LNR_GRP(it + 1);
        const int row = 8 * g + F.wave, mr = group_mod(g);
        if (mr != cur_mod) { __syncthreads(); stage_vec(SH, mod + (size_t)mr * 24576 + 3 * D, D, F.tid); stage_vec(SC, mod + (size_t)mr * 24576 + 4 * D, D, F.tid); cur_mod = mr; }
        __syncthreads();
        RT(4);
        row8_from_raw(cur, hraw);
        if (g < 1024) {
            const float* gv = mod + (size_t)mr * 24576 + 2 * D;
#pragma unroll
            for (int j = 0; j < 8; ++j) { const int c = 8 * (F.lane + 64 * j); const f32x4 g0 = *(const f32x4*)(gv + c), g1 = *(const f32x4*)(gv + c + 4); const v4u y = yrow[j];
                cur.a[j] = DN_ALPHA * cur.a[j] + g0 * (f32x4){bflo(y.x), bfhi(y.x), bflo(y.y), bfhi(y.y)}; cur.b[j] = DN_ALPHA * cur.b[j] + g1 * (f32x4){bflo(y.z), bfhi(y.z), bflo(y.w), bfhi(y.w)}; if (j & 1) asm volatile("" ::: "memory"); }
        }
        float mean, rstd; row8_stats(cur, mean, rstd);
#pragma unroll
        for (int j = 0; j < 8; ++j) { const int c = 8 * (F.lane + 64 * j);
            const f32x4 y0 = (cur.a[j] - mean) * rstd * *(const LAS f32x4*)(LG + c) + *(const LAS f32x4*)(LB + c), y1 = (cur.b[j] - mean) * rstd * *(const LAS f32x4*)(LG + c + 4) + *(const LAS f32x4*)(LB + c + 4);
            *(v4u*)(H + (size_t)row * D + c) = pack8(y0, y1);
            const f32x4 u0 = y0 * (1.f + *(const LAS f32x4*)(SC + c)) + *(const LAS f32x4*)(SH + c), u1 = y1 * (1.f + *(const LAS f32x4*)(SC + c + 4)) + *(const LAS f32x4*)(SH + c + 4);
            { v2u w8; w8.x = pk4_fp8(u0.x, u0.y, u0.z, u0.w); w8.y = pk4_fp8(u1.x, u1.y, u1.z, u1.w); *(v2u*)(U8 + (size_t)row * D + c) = w8; }
            cur.a[j] = u0; cur.b[j] = u1; }
        RT(1);
        f32x4 racc4 = (f32x4){0.f, 0.f, 0.f, 0.f};
        const int fr = F.lane & 15, fq = F.lane >> 4;
        int opq = 0; asm volatile("" : "+v"(opq));
#pragma unroll
        for (int half = 0; half < 2; ++half) {
            bf16x8 bh[8], bl[8];
#pragma unroll
            for (int ks = 0; ks < 8; ++ks) { const size_t wo = (size_t)(fr * D + 2048 * half + 256 * F.wave + 32 * ks + 8 * fq + opq); bh[ks] = *(const bf16x8*)(wrh + wo); bl[ks] = *(const bf16x8*)(wrl + wo); }
            __syncthreads();
#pragma unroll
            for (int jj = 0; jj < 4; ++jj) { const int j = 4 * half + jj; const f32x4 xa = cur.a[j], xb = cur.b[j];
                const unsigned h0 = pg8::cvt_pk_bf16(xa.x, xa.y), h1 = pg8::cvt_pk_bf16(xa.z, xa.w), h2 = pg8::cvt_pk_bf16(xb.x, xb.y), h3 = pg8::cvt_pk_bf16(xb.z, xb.w);
                v4u hv; hv.x = h0; hv.y = h1; hv.z = h2; hv.w = h3;
                v4u lv; lv.x = pg8::cvt_pk_bf16(xa.x - bflo(h0), xa.y - bfhi(h0)); lv.y = pg8::cvt_pk_bf16(xa.z - bflo(h1), xa.w - bfhi(h1)); lv.z = pg8::cvt_pk_bf16(xb.x - bflo(h2), xb.y - bfhi(h2)); lv.w = pg8::cvt_pk_bf16(xb.z - bflo(h3), xb.w - bfhi(h3));
                const int co = F.wave * 4112 + (8 * (F.lane + 64 * jj)) * 2;
                *(LAS v4u*)(UH + co) = hv; *(LAS v4u*)(UL + co) = lv; }
            __syncthreads();
#pragma unroll
            for (int ks = 0; ks < 8; ++ks) { const int ao = (fr & 7) * 4112 + (256 * F.wave + 32 * ks + 8 * fq) * 2;
                const bf16x8 ah = *(const LAS bf16x8*)(UH + ao), al = *(const LAS bf16x8*)(UL + ao);
                racc4 = __builtin_amdgcn_mfma_f32_16x16x32_bf16(ah, bh[ks], racc4, 0, 0, 0);
                racc4 = __builtin_amdgcn_mfma_f32_16x16x32_bf16(al, bh[ks], racc4, 0, 0, 0);
                racc4 = __builtin_amdgcn_mfma_f32_16x16x32_bf16(ah, bl[ks], racc4, 0, 0, 0); }
        }
        if (fq < 2) {
#pragma unroll
            for (int j = 0; j < 4; ++j) RED[(F.wave * 8 + 4 * fq + j) * 16 + fr] = racc4[j]; }
        __syncthreads();
        float mylogit = 0.f;
        if (F.lane < 16) {
#pragma unroll
            for (int w = 0; w < 8; ++w) mylogit += RED[(w * 8 + F.wave) * 16 + F.lane]; }
        if (gnx >= 0) { LNR_LOAD(gnx); }
        RT(2);
        float v = F.lane < 16 ? mylogit : -3.0e38f;
        const float mx = wave_max(v); const float ex = F.lane < 16 ? __expf(v - mx) : 0.f; const float den = wave_sum(ex);
        if (F.lane < 16) { int sq, n; if (row < ML) { sq = row >> 12; n = row & 4095; } else { sq = 2 + ((row - ML) >> 8); n = (row - ML) & 255; }
            AFF[((size_t)sq * 16 + F.lane) * SEQ + n] = ex / den; }
        RT(3);
        gcur = gnx;
    }
#undef LNR_GRP
#undef LNR_LOAD
    __syncthreads();
}

__device__ __forceinline__ unsigned block_excl_scan(unsigned v, LAS unsigned* wsum, int tid, int lane, int wave, unsigned& tot) {
    unsigned inc = v;
#pragma unroll
    for (int o = 1; o < 64; o <<= 1) { const unsigned t = __shfl_up(inc, o); if (lane >= o) inc += t; }
    __syncthreads();
    if (lane == 63) wsum[wave] = inc;
    __syncthreads();
    unsigned off = 0; tot = 0;
#pragma unroll
    for (int w = 0; w < 8; ++w) { const unsigned x = wsum[w]; if (w < wave) off += x; tot += x; }
    return off + inc - v;
}
template <int SHIFT, int NB>
__device__ __forceinline__ void radix_pass(const unsigned (&key)[8], bool valid, unsigned& prefix, unsigned& pmask, unsigned& need, LAS unsigned* hist, LAS unsigned* wsum, LAS unsigned* bc, int tid, int lane, int wave) {
    constexpr int PER = NB / NTHR;
    __syncthreads();
    for (int i = tid; i < NB; i += NTHR) hist[i] = 0u;
    if (tid == 0) { bc[0] = 0u; bc[1] = 1u; }
    __syncthreads();
    if (valid) {
#pragma unroll
        for (int r = 0; r < 8; ++r) if ((key[r] & pmask) == prefix) __hip_atomic_fetch_add(&hist[(key[r] >> SHIFT) & (unsigned)(NB - 1)], 1u, __ATOMIC_RELAXED, __HIP_MEMORY_SCOPE_WORKGROUP); }
    __syncthreads();
    unsigned c[PER], tot = 0u;
#pragma unroll
    for (int q = 0; q < PER; ++q) { c[q] = hist[NB - 1 - (tid * PER + q)]; tot += c[q]; }
    unsigned dummy; unsigned above = block_excl_scan(tot, wsum, tid, lane, wave, dummy);
#pragma unroll
    for (int q = 0; q < PER; ++q) { if (above < need && above + c[q] >= need) { bc[0] = (unsigned)(NB - 1 - (tid * PER + q)); bc[1] = need - above; } above += c[q]; }
    __syncthreads();
    const unsigned digit = bc[0]; need = bc[1];
    prefix |= digit << SHIFT; pmask |= (unsigned)(NB - 1) << SHIFT;
}
__device__ __forceinline__ void topk_phase(Frame& F, int nseq, int er) {
    const float* AFF = WSP(float, WS_AFF); int* XR = WSP(int, WS_IDX); float* GX = WSP(float, WS_GX); int* INV = WSP(int, WS_INV);
    LAS unsigned* hist = (LAS unsigned*)F.lds; LAS unsigned* wsum = hist + 2048; LAS unsigned* bc = hist + 2048 + 16;
    const int tid = F.tid;
    for (int p = F.bid; p < nseq * 16; p += F.G) {
        const int s = p >> 4, e = p & 15, n = seq_len(s), cap = n >> 3;
        const bool valid = tid * 8 < n;
        unsigned key[8];
        { const float* ap = AFF + ((size_t)s * 16 + e) * SEQ + (valid ? tid * 8 : 0); const v4u k0 = *(const v4u*)ap, k1 = *(const v4u*)(ap + 4);
          key[0] = k0.x; key[1] = k0.y; key[2] = k0.z; key[3] = k0.w; key[4] = k1.x; key[5] = k1.y; key[6] = k1.z; key[7] = k1.w; }
        unsigned prefix = 0u, pmask = 0u, need = (unsigned)cap;
        radix_pass<21, 2048>(key, valid, prefix, pmask, need, hist, wsum, bc, tid, F.lane, F.wave);
        radix_pass<10, 2048>(key, valid, prefix, pmask, need, hist, wsum, bc, tid, F.lane, F.wave);
        radix_pass<0, 1024>(key, valid, prefix, pmask, need, hist, wsum, bc, tid, F.lane, F.wave);
        const unsigned T = prefix;
        unsigned neq = 0u;
#pragma unroll
        for (int r = 0; r < 8; ++r) neq += (valid && key[r] == T) ? 1u : 0u;
        unsigned toteq; unsigned eqrank = block_excl_scan(neq, wsum, tid, F.lane, F.wave, toteq);
        unsigned selm = 0u, nsel = 0u;
#pragma unroll
        for (int r = 0; r < 8; ++r) { const bool eq = valid && key[r] == T; const bool sel = valid && (key[r] > T || (eq && eqrank < need)); if (eq) ++eqrank; if (sel) { selm |= 1u << r; ++nsel; } }
        unsigned totsel; unsigned slot = block_excl_scan(nsel, wsum, tid, F.lane, F.wave, totsel);
        const int rbase = seq_row0(s), sb = s == 0 ? 0 : (s == 1 ? 512 : (s == 2 ? 1024 : 1056));
        if (valid) {
#pragma unroll
            for (int r = 0; r < 8; ++r) { const int tok = tid * 8 + r; const bool sel = (selm >> r) & 1u;
                if (sel && slot < (unsigned)cap) { XR[e * er + sb + (int)slot] = rbase + tok; GX[e * er + sb + (int)slot] = __builtin_bit_cast(float, key[r]); }
                INV[(size_t)(rbase + tok) * 16 + e] = (sel && slot < (unsigned)cap) ? (int)slot : -1;
                if (sel) ++slot; } }
        if (s == 3) for (int i = 1088 + tid; i < er; i += NTHR) { XR[e * er + i] = 0; GX[e * er + i] = 0.f; }
        __syncthreads();
    }
    const int nprob = nseq * 16;
    if (F.bid >= nprob && F.G > nprob) { const int lo = nseq == 4 ? CV_DOWN0 : CV_DOWN1; convert_items<true>(F, lo, lo + 16 * 512, 0, 0, (F.bid - nprob) * 8 + F.wave, (F.G - nprob) * 8, 0); }
    else if (F.G <= nprob) { const int lo = nseq == 4 ? CV_DOWN0 : CV_DOWN1; convert_items<true>(F, lo, lo + 16 * 512, 0, 0, F.bid * 8 + F.wave, F.G * 8, 0); }
}

__device__ __forceinline__ int slot_base(int s) { return s == 0 ? 0 : (s == 1 ? 512 : (s == 2 ? 1024 : 1056)); }

template <bool LAST>
__device__ __forceinline__ void combine_phase(Frame& F, int l, int nrows, int er, bool probe = false) {
    const bf16* Hin = WSP(bf16, WS_H); bf16* H = probe ? WSP(bf16, WS_XE) : WSP(bf16, WS_H); bf16* U = probe ? WSP(bf16, WS_A2) : WSP(bf16, WS_U); const float* mod = WSP(float, WS_MOD) + (size_t)l * 3 * 24576; const float* modn = WSP(float, WS_MOD) + (size_t)(l + 1) * 3 * 24576;
    const bf16* YE = WSP(bf16, WS_YE); const int* INV = WSP(int, WS_INV);
    LAS float* LG = (LAS float*)F.lds; LAS float* LB = LG + D; LAS float* G2 = LG + 2 * D; LAS float* SH = LG + 3 * D; LAS float* SC = LG + 4 * D;
    const int ngroups = nrows / 8;
    stage_vec(LG, F.in[6] + (size_t)(l * 2 + 1) * D, D, F.tid); stage_vec(LB, F.in[7] + (size_t)(l * 2 + 1) * D, D, F.tid);
    int cur_mod = -1; Row8 cur, ms; int slot_c = -1, slot_n = -1;
    if (F.bid < ngroups) slot_c = INV[(size_t)(8 * F.bid + F.wave) * 16 + (F.lane & 15)];
    for (int g = F.bid; g < ngroups; g += F.G) {
        const int row = 8 * g + F.wave, mr = group_mod(g);
        if (mr != cur_mod) { __syncthreads(); stage_vec(G2, mod + (size_t)mr * 24576 + 5 * D, D, F.tid);
            if (!LAST) { stage_vec(SH, modn + (size_t)mr * 24576, D, F.tid); stage_vec(SC, modn + (size_t)mr * 24576 + D, D, F.tid); }
            __syncthreads(); cur_mod = mr; }
        v4u hraw[8]; ld_row8_raw(hraw, Hin + (size_t)row * D, F.lane);
        const int gn = g + F.G; if (gn < ngroups) slot_n = INV[(size_t)(8 * gn + F.wave) * 16 + (F.lane & 15)];
#pragma unroll
        for (int j = 0; j < 8; ++j) { ms.a[j] = (f32x4){0.f, 0.f, 0.f, 0.f}; ms.b[j] = (f32x4){0.f, 0.f, 0.f, 0.f}; }
        const int sq = row < ML ? (row >> 12) : 2 + ((row - ML) >> 8); const int sb = slot_base(sq);
        unsigned long long mask = __ballot(slot_c >= 0) & 0xFFFFull;
        while (mask) {
            const int e = __builtin_ctzll(mask); mask &= mask - 1;
            const int slot = __builtin_amdgcn_readlane(slot_c, e);
            const bf16* y = YE + ((size_t)e * er + sb + slot) * D;
            v4u yv[8];
#pragma unroll
            for (int j = 0; j < 8; ++j) yv[j] = *(const v4u*)(y + 8 * (F.lane + 64 * j));
#pragma unroll
            for (int j = 0; j < 8; ++j) { ms.a[j] += (f32x4){bflo(yv[j].x), bfhi(yv[j].x), bflo(yv[j].y), bfhi(yv[j].y)}; ms.b[j] += (f32x4){bflo(yv[j].z), bfhi(yv[j].z), bflo(yv[j].w), bfhi(yv[j].w)}; }
        }
        row8_from_raw(cur, hraw);
#pragma unroll
        for (int j = 0; j < 8; ++j) { const int c = 8 * (F.lane + 64 * j); cur.a[j] = DN_ALPHA * cur.a[j] + *(const LAS f32x4*)(G2 + c) * ms.a[j]; cur.b[j] = DN_ALPHA * cur.b[j] + *(const LAS f32x4*)(G2 + c + 4) * ms.b[j]; }
        float mean, rstd; row8_stats(cur, mean, rstd);
#pragma unroll
        for (int j = 0; j < 8; ++j) { const int c = 8 * (F.lane + 64 * j);
            const f32x4 y0 = (cur.a[j] - mean) * rstd * *(const LAS f32x4*)(LG + c) + *(const LAS f32x4*)(LB + c), y1 = (cur.b[j] - mean) * rstd * *(const LAS f32x4*)(LG + c + 4) + *(const LAS f32x4*)(LB + c + 4);
            if (LAST) { __builtin_nontemporal_store(y0, (f32x4*)(F.out + (size_t)row * D + c)); __builtin_nontemporal_store(y1, (f32x4*)(F.out + (size_t)row * D + c + 4)); }
            else { *(v4u*)(H + (size_t)row * D + c) = pack8(y0, y1);
                const f32x4 u0 = y0 * (1.f + *(const LAS f32x4*)(SC + c)) + *(const LAS f32x4*)(SH + c), u1 = y1 * (1.f + *(const LAS f32x4*)(SC + c + 4)) + *(const LAS f32x4*)(SH + c + 4);
                *(v4u*)(U + (size_t)row * D + c) = pack8(u0, u1); }
            asm volatile("" ::: "memory"); }
        slot_c = slot_n;
    }
    __syncthreads();
}

__device__ __forceinline__ void reduce_xzs_ctx(Frame& F) {
    const float* slab = WSP(float, WS_SLAB); bf16* XZS = WSP(bf16, WS_BIG);
    const int gt = F.bid * NTHR + F.tid, NGT = F.G * NTHR;
    for (int i = gt; i < MC * (DIN0 / 8); i += NGT) { const int r = i / (DIN0 / 8), c = (i % (DIN0 / 8)) * 8;
        const float* sp = slab + (size_t)(((r >> 8) + 2 * (c >> 8)) * 4) * 65536 + (r & 255) * 256 + (c & 255);
        f32x4 s0 = (f32x4){0.f, 0.f, 0.f, 0.f}, s1 = s0;
#pragma unroll
        for (int ks = 0; ks < 4; ++ks) { s0 += *(const f32x4*)(sp + (size_t)ks * 65536); s1 += *(const f32x4*)(sp + (size_t)ks * 65536 + 4); }
        *(v4u*)(XZS + (size_t)(ML + r) * DIN0 + c) = pack8(s0, s1); }
}
__device__ __forceinline__ void reduce_act_ctx(Frame& F) {
    const float* slab = WSP(float, WS_SLAB); unsigned char* ACT = WSP(unsigned char, WS_ACT);
    const int gt = F.bid * NTHR + F.tid, NGT = F.G * NTHR;
    for (int i = gt; i < 16 * 256 * 128; i += NGT) { const int e = i >> 15, r = (i >> 7) & 255, chn = i & 127, pn = chn >> 4, cc = (chn & 15) * 8;
        const float* sp = slab + (size_t)((e * 8 + pn) * 2) * 65536 + r * 256 + cc;
        const f32x4 g0 = *(const f32x4*)(sp) + *(const f32x4*)(sp + 65536), g1 = *(const f32x4*)(sp + 4) + *(const f32x4*)(sp + 65536 + 4);
        const f32x4 u0 = *(const f32x4*)(sp + 128) + *(const f32x4*)(sp + 65536 + 128), u1 = *(const f32x4*)(sp + 132) + *(const f32x4*)(sp + 65536 + 132);
        f32x4 a0, a1;
#pragma unroll
        for (int k = 0; k < 4; ++k) { a0[k] = siluf_(g0[k] * W8_INV) * (u0[k] * W8_INV); a1[k] = siluf_(g1[k] * W8_INV) * (u1[k] * W8_INV); }
        v2u w; w.x = pk4_fp8(a0[0], a0[1], a0[2], a0[3]); w.y = pk4_fp8(a1[0], a1[1], a1[2], a1[3]); *(v2u*)(ACT + ((size_t)e * ER0 + 1024 + r) * DE + pn * 128 + cc) = w; }
}
__device__ __forceinline__ void reduce_odd_tail(Frame& F) {
    const float* slab = WSP(float, WS_SLAB); bf16* QKVO = WSP(bf16, WS_BIG); float* Gt = WSP(float, WS_G); const float* gb = F.in[18];
    const int gt = F.bid * NTHR + F.tid, NGT = F.G * NTHR;
    for (int i = gt; i < 82 * 256 * 32; i += NGT) { const int t = i >> 13, r = (i >> 5) & 255, chn = i & 31;
        int pm, pn; if (t < 32) { pm = t; pn = 48; } else { const int j = t - 32, q = j % 25; pm = 32 + j / 25; pn = q < 24 ? 8 + q : 48; }
        if (pn == 48 && chn >= 4) continue;
        const float* sp = slab + (size_t)(t * 2) * 65536 + r * 256 + chn * 8;
        const f32x4 s0 = *(const f32x4*)(sp) + *(const f32x4*)(sp + 65536), s1 = *(const f32x4*)(sp + 4) + *(const f32x4*)(sp + 65536 + 4);
        const size_t row = (size_t)pm * 256 + r;
        if (pn == 48) { *(f32x4*)(Gt + row * 32 + chn * 8) = s0 + *(const f32x4*)(gb + chn * 8); *(f32x4*)(Gt + row * 32 + chn * 8 + 4) = s1 + *(const f32x4*)(gb + chn * 8 + 4); }
        else *(v4u*)(QKVO + row * DIN1 + pn * 256 + chn * 8) = pack8(s0, s1); }
}
typedef short v4i16_t __attribute__((ext_vector_type(4)));
__device__ __forceinline__ bf16x8 row_frag(const LAS unsigned char* T, int stride, int r0, int k0, int fr, int fq) { return *(const LAS bf16x8*)(T + (r0 + fr) * stride + (k0 + fq * 8) * 2); }
__device__ __forceinline__ bf16x8 tr_frag(const LAS unsigned char* T, int stride, int k0, int n0, int fr, int fq) {
    const LAS unsigned char* p0 = T + (k0 + 8 * fq + (fr >> 2)) * stride + n0 * 2 + 8 * (fr & 3);
    const v4i16_t lo = __builtin_amdgcn_ds_read_tr16_b64_v4i16((LAS v4i16_t*)p0);
    const v4i16_t hi = __builtin_amdgcn_ds_read_tr16_b64_v4i16((LAS v4i16_t*)(p0 + 4 * stride));
    return (bf16x8){lo[0], lo[1], lo[2], lo[3], hi[0], hi[1], hi[2], hi[3]};
}
#define MFMA16(a, b, c) __builtin_amdgcn_mfma_f32_16x16x32_bf16((a), (b), (c), 0, 0, 0)
constexpr int ML_QS = 0, ML_KS = 33792, ML_VS = 67584, ML_VW = 76800, ML_SP = 86016, ML_CT = 95232, ML_SM = 129024;
constexpr int SM_A = 0, SM_ROWC = 64, SM_EINT = 128, SM_LOW = 192, SM_W = 256, SM_DEN4 = 320, SM_QN = 576, SM_NST = 640, SM_SCAL = 896, SM_NPART = 904;
__device__ __forceinline__ v4u scale_bf16x8(v4u v, float s) {
    v4u o;
#pragma unroll
    for (int i = 0; i < 4; ++i) { const unsigned w = v[i]; o[i] = pk2(bflo(w) * s, bfhi(w) * s); }
    return o;
}
constexpr int MSC_STRIDE = 576;
__device__ __forceinline__ int mlstm_base(int step, int b, int d) { return step < 4 ? ML + b * CTXL + 64 * (d ? 3 - step : step) : b * SEQ + 64 * (d ? 63 - (step - 4) : (step - 4)); }
__device__ __forceinline__ void mlstm_phase(Frame& F, unsigned long long* racc = nullptr) {
    unsigned long long rprev = RSEL ? __builtin_amdgcn_s_memrealtime() : 0ull;
    const bf16* QKVO = WSP(bf16, WS_BIG); const float* Gt = WSP(float, WS_G); bf16* HD = WSP(bf16, WS_HD);
    LAS unsigned char* QS = F.lds + ML_QS; LAS unsigned char* KS = F.lds + ML_KS; LAS unsigned char* VS = F.lds + ML_VS; LAS unsigned char* VW = F.lds + ML_VW;
    LAS unsigned char* SP = F.lds + ML_SP; LAS unsigned char* CT = F.lds + ML_CT; LAS float* SM = (LAS float*)(F.lds + ML_SM);
    const int wr = F.wave >> 2, wc = F.wave & 3, fr = F.lane & 15, fq = F.lane >> 4, tid = F.tid;
    for (int unit = F.bid; unit < 256; unit += F.G) {
        const int x = unit & 7, y = unit >> 3; const int combo = x + 8 * (y >> 3), jv = y & 7;
        const int b = combo >> 4, h = (combo >> 1) & 7, d = combo & 1;
        f32x4 accC[2][4];
#pragma unroll
        for (int m = 0; m < 2; ++m)
#pragma unroll
            for (int n = 0; n < 4; ++n) accC[m][n] = (f32x4){0.f, 0.f, 0.f, 0.f};
        float n_reg = 0.f;
        v4u kq[4], qq[4], vv;
        {
            const int base = mlstm_base(0, b, d);
#pragma unroll
            for (int i = 0; i < 4; ++i) { const int q = tid + 512 * i, r = q >> 5, cs = q & 31; const size_t row = (size_t)(base + (d ? 63 - r : r));
                kq[i] = *(const v4u*)(QKVO + row * DIN1 + 2048 + h * DQK + cs * 8); qq[i] = (v4u){0u, 0u, 0u, 0u}; }
            { const int r = tid >> 3, cs = tid & 7; const size_t row = (size_t)(base + (d ? 63 - r : r)); vv = *(const v4u*)(QKVO + row * DIN1 + 4096 + h * DV + jv * 64 + cs * 8); }
            if (tid < 256) SM[SM_NST + tid] = 0.f;
        }
        float* msc = WSP(float, WS_MSC) + (size_t)unit * 68 * MSC_STRIDE;
        {
            LAS float* BE = SM + SM_DEN4; LAS float* PMX = SM + SM_DEN4 + 68; LAS float* MP = SM + SM_DEN4 + 136;
            for (int k = F.wave; k < 68; k += 8) {
                const int row = mlstm_base(k, b, d) + (d ? 63 - F.lane : F.lane);
                const float ig = Gt[(size_t)row * 32 + d * 16 + h], fp = Gt[(size_t)row * 32 + d * 16 + 8 + h];
                float bc = logsigmoidf_(fp);
#pragma unroll
                for (int o = 1; o < 64; o <<= 1) { const float t = __shfl_up(bc, o); if (F.lane >= o) bc += t; }
                const float a = ig - bc; float pm = a;
#pragma unroll
                for (int o = 1; o < 64; o <<= 1) { const float t = __shfl_up(pm, o); if (F.lane >= o) pm = fmaxf(pm, t); }
                float* sl = msc + (size_t)k * MSC_STRIDE; sl[F.lane] = a; sl[384 + F.lane] = bc; sl[448 + F.lane] = pm;
                if (F.lane == 63) { BE[k] = bc; PMX[k] = pm; }
            }
            __syncthreads();
            if (tid == 0) { float m = 0.f; for (int k = 0; k < 68; ++k) { MP[k] = m; const float be = BE[k]; m = fmaxf(be + m, be + PMX[k]); } }
            __syncthreads();
            for (int k = F.wave; k < 68; k += 8) {
                float* sl = msc + (size_t)k * MSC_STRIDE; const float a = sl[F.lane], bc = sl[384 + F.lane], pm = sl[448 + F.lane];
                const float m_prev = MP[k], bend = BE[k], m_new = fmaxf(bend + m_prev, bend + PMX[k]);
                const float mcomb = bc + fmaxf(m_prev, pm);
                sl[64 + F.lane] = bc - mcomb - 2.772588722239781f; sl[128 + F.lane] = 0.0625f * __expf(bc + m_prev - mcomb); sl[192 + F.lane] = __expf(-mcomb); sl[256 + F.lane] = __expf(bend + a - m_new);
                if (F.lane == 0) sl[320] = __expf(bend + m_prev - m_new);
            }
            asm volatile("s_waitcnt vmcnt(0)" ::: "memory");
            __syncthreads();
            if (F.wave == 0) { const float* sl = msc;
                SM[SM_A + F.lane] = sl[F.lane]; SM[SM_ROWC + F.lane] = sl[64 + F.lane]; SM[SM_EINT + F.lane] = sl[128 + F.lane]; SM[SM_LOW + F.lane] = sl[192 + F.lane]; SM[SM_W + F.lane] = sl[256 + F.lane];
                if (F.lane == 0) SM[SM_SCAL + 0] = sl[320]; }
        }
        float sc_a = 0.f, sc_r = 0.f, sc_e = 0.f, sc_l = 0.f, sc_w = 0.f, sc_d = 0.f;
#pragma unroll 1
        for (int step = 0; step < 68; ++step) {
            const bool lat = step >= 4;
            const int base = mlstm_base(step, b, d);
#pragma unroll
            for (int i = 0; i < 4; ++i) { const int q = tid + 512 * i, r = q >> 5, cs = q & 31;
                *(LAS v4u*)(KS + r * 528 + cs * 16) = kq[i];
                if (lat) *(LAS v4u*)(QS + r * 528 + cs * 16) = qq[i]; }
            *(LAS v4u*)(VS + (tid >> 3) * 144 + (tid & 7) * 16) = vv;
            RT(5);
            __syncthreads();
            RT(6);
            const float decay = SM[SM_SCAL + 0];
            *(LAS v4u*)(VW + (tid >> 3) * 144 + (tid & 7) * 16) = scale_bf16x8(vv, SM[SM_W + (tid >> 3)]);
            if (step < 67) {
                const int nb = mlstm_base(step + 1, b, d); const bool nlat = step + 1 >= 4;
#pragma unroll
                for (int i = 0; i < 4; ++i) { const int q = tid + 512 * i, r = q >> 5, cs = q & 31; const size_t row = (size_t)(nb + (d ? 63 - r : r));
                    kq[i] = *(const v4u*)(QKVO + row * DIN1 + 2048 + h * DQK + cs * 8);
                    if (nlat) qq[i] = *(const v4u*)(QKVO + row * DIN1 + h * DQK + cs * 8); }
                { const int r = tid >> 3, cs = tid & 7; const size_t row = (size_t)(nb + (d ? 63 - r : r)); vv = *(const v4u*)(QKVO + row * DIN1 + 4096 + h * DV + jv * 64 + cs * 8); }
                if (F.wave == 0) { const float* sl = msc + (size_t)(step + 1) * MSC_STRIDE; sc_a = sl[F.lane]; sc_r = sl[64 + F.lane]; sc_e = sl[128 + F.lane]; sc_l = sl[192 + F.lane]; sc_w = sl[256 + F.lane]; sc_d = sl[320]; }
            }
            if (lat) {
                {
                    const int t = tid >> 3, part = tid & 7; float s = 0.f;
#pragma unroll
                    for (int i = 0; i < 4; ++i) { const v4u xq = *(const LAS v4u*)(QS + t * 528 + (part * 32 + i * 8) * 2);
#pragma unroll
                        for (int k = 0; k < 4; ++k) s += bflo(xq[k]) * SM[SM_NST + part * 32 + i * 8 + 2 * k] + bfhi(xq[k]) * SM[SM_NST + part * 32 + i * 8 + 2 * k + 1]; }
                    s += dppx<0xB1>(s); s += dppx<0x4E>(s); s += dppx<0x141>(s);
                    if (part == 0) SM[SM_QN + t] = s;
                }
                f32x4 accS[2]; accS[0] = accS[1] = (f32x4){0.f, 0.f, 0.f, 0.f};
#pragma unroll
                for (int ks = 0; ks < 256; ks += 32) { const bf16x8 kf = row_frag(KS, 528, 16 * wc, ks, fr, fq);
#pragma unroll
                    for (int m = 0; m < 2; ++m) accS[m] = MFMA16(kf, row_frag(QS, 528, 32 * wr + 16 * m, ks, fr, fq), accS[m]); }
#pragma unroll
                for (int m = 0; m < 2; ++m) { const int t = 32 * wr + 16 * m + fr, s0 = 16 * wc + 4 * fq; const float rc = SM[SM_ROWC + t];
                    f32x4 p; float ps = 0.f;
#pragma unroll
                    for (int j = 0; j < 4; ++j) { const int s = s0 + j; const float arg = (s <= t) ? rc + SM[SM_A + s] : -100.f; p[j] = accS[m][j] * __expf(arg); ps += p[j]; }
                    ps += __shfl_xor(ps, 16); ps += __shfl_xor(ps, 32);
                    if (fq == 0) SM[SM_DEN4 + t * 4 + wc] = ps;
                    v2u o; o.x = pk2(p[0], p[1]); o.y = pk2(p[2], p[3]); *(LAS v2u*)(SP + t * 144 + s0 * 2) = o; }
            }
            RT(7);
            __syncthreads();
            RT(8);
            if (lat) {
                f32x4 acc1[2], acc2[2]; acc1[0] = acc1[1] = acc2[0] = acc2[1] = (f32x4){0.f, 0.f, 0.f, 0.f};
#pragma unroll
                for (int ks = 0; ks < 256; ks += 32) { const bf16x8 cf = row_frag(CT, 528, 16 * wc, ks, fr, fq);
#pragma unroll
                    for (int m = 0; m < 2; ++m) acc2[m] = MFMA16(cf, row_frag(QS, 528, 32 * wr + 16 * m, ks, fr, fq), acc2[m]); }
#pragma unroll
                for (int ks = 0; ks < 64; ks += 32) { const bf16x8 vf = tr_frag(VS, 144, ks, 16 * wc, fr, fq);
#pragma unroll
                    for (int m = 0; m < 2; ++m) acc1[m] = MFMA16(vf, row_frag(SP, 144, 32 * wr + 16 * m, ks, fr, fq), acc1[m]); }
#pragma unroll
                for (int m = 0; m < 2; ++m) { const int t = 32 * wr + 16 * m + fr; const float ei = SM[SM_EINT + t];
                    const float den = (SM[SM_DEN4 + t * 4 + 0] + SM[SM_DEN4 + t * 4 + 1]) + (SM[SM_DEN4 + t * 4 + 2] + SM[SM_DEN4 + t * 4 + 3]) + ei * SM[SM_QN + t];
                    const float inv = 1.f / fmaxf(fabsf(den), SM[SM_LOW + t]);
                    const f32x4 hv = (acc1[m] + ei * acc2[m]) * inv;
                    const size_t row = (size_t)(base + (d ? 63 - t : t));
                    v2u o; o.x = pk2(hv[0], hv[1]); o.y = pk2(hv[2], hv[3]);
                    *(v2u*)(HD + ((size_t)d * ML + row) * D + h * DV + jv * 64 + 16 * wc + 4 * fq) = o; }
            }
            float npart = 0.f;
            { const int dd = tid & 255, q0 = (tid >> 8) * 32;
#pragma unroll 8
                for (int q = q0; q < q0 + 32; ++q) npart += SM[SM_W + q] * bf2f(*(const LAS unsigned short*)(KS + q * 528 + dd * 2));
                if (tid >= 256) SM[SM_NPART + dd] = npart; }
#pragma unroll
            for (int m = 0; m < 2; ++m)
#pragma unroll
                for (int n = 0; n < 4; ++n) accC[m][n] = accC[m][n] * decay;
#pragma unroll
            for (int ks = 0; ks < 64; ks += 32) { bf16x8 vf[2];
#pragma unroll
                for (int m = 0; m < 2; ++m) vf[m] = tr_frag(VW, 144, ks, 32 * wr + 16 * m, fr, fq);
#pragma unroll
                for (int n = 0; n < 4; ++n) { const bf16x8 kf = tr_frag(KS, 528, ks, 64 * wc + 16 * n, fr, fq);
#pragma unroll
                    for (int m = 0; m < 2; ++m) accC[m][n] = MFMA16(kf, vf[m], accC[m][n]); } }
            RT(9);
            __syncthreads();
            RT(10);
#pragma unroll
            for (int m = 0; m < 2; ++m)
#pragma unroll
                for (int n = 0; n < 4; ++n) { const int v = 32 * wr + 16 * m + fr, dd = 64 * wc + 16 * n + 4 * fq; v2u o; o.x = pk2(accC[m][n][0], accC[m][n][1]); o.y = pk2(accC[m][n][2], accC[m][n][3]);
                    *(LAS v2u*)(CT + v * 528 + dd * 2) = o; }
            if (tid < 256) { n_reg = decay * n_reg + npart + SM[SM_NPART + tid]; SM[SM_NST + tid] = n_reg; }
            if (F.wave == 0 && step < 67) { SM[SM_A + F.lane] = sc_a; SM[SM_ROWC + F.lane] = sc_r; SM[SM_EINT + F.lane] = sc_e; SM[SM_LOW + F.lane] = sc_l; SM[SM_W + F.lane] = sc_w; if (F.lane == 0) SM[SM_SCAL + 0] = sc_d; }
            RT(11);
        }
        __syncthreads();
    }
}
#undef MFMA16

__device__ __forceinline__ void headnorm_phase(Frame& F) {
    const int gw = F.bid * 8 + F.wave, NGW = F.G * 8;
    const bf16* HD = WSP(bf16, WS_HD); const bf16* QKVO = WSP(bf16, WS_BIG); bf16* A2 = WSP(bf16, WS_A2); const float* ng = F.in[19];
    v4u h0[8], h1[8], ov[8], n0[8], n1[8], no[8];
    if (gw < ML) {
#pragma unroll
        for (int j = 0; j < 8; ++j) { const int c = 8 * (F.lane + 64 * j); h0[j] = *(const v4u*)(HD + (size_t)gw * D + c); h1[j] = *(const v4u*)(HD + ((size_t)ML + gw) * D + c); ov[j] = *(const v4u*)(QKVO + (size_t)gw * DIN1 + 8192 + c); } }
    for (int row = gw; row < ML; row += NGW) {
        const int rn = row + NGW;
        if (rn < ML) {
#pragma unroll
            for (int j = 0; j < 8; ++j) { const int c = 8 * (F.lane + 64 * j); n0[j] = *(const v4u*)(HD + (size_t)rn * D + c); n1[j] = *(const v4u*)(HD + ((size_t)ML + rn) * D + c); no[j] = *(const v4u*)(QKVO + (size_t)rn * DIN1 + 8192 + c); } }
#pragma unroll
        for (int j = 0; j < 8; ++j) {
            float v[8];
#pragma unroll
            for (int k = 0; k < 4; ++k) { v[2 * k] = bflo(h0[j][k]) + bflo(h1[j][k]); v[2 * k + 1] = bfhi(h0[j][k]) + bfhi(h1[j][k]); }
            float sm = ((v[0] + v[1]) + (v[2] + v[3])) + ((v[4] + v[5]) + (v[6] + v[7]));
            const float mean = wave_sum(sm) * (1.f / DV); float q = 0.f;
#pragma unroll
            for (int k = 0; k < 8; ++k) { v[k] -= mean; q += v[k] * v[k]; }
            const float rstd = 1.f / sqrtf(wave_sum(q) * (1.f / DV) + LN_EPS);
            const int c = 8 * (F.lane + 64 * j); const f32x4 g0 = *(const f32x4*)(ng + c), g1 = *(const f32x4*)(ng + c + 4);
            v4u w;
            w.x = pk2(sigmoidf_(bflo(ov[j].x)) * v[0] * rstd * g0.x, sigmoidf_(bfhi(ov[j].x)) * v[1] * rstd * g0.y);
            w.y = pk2(sigmoidf_(bflo(ov[j].y)) * v[2] * rstd * g0.z, sigmoidf_(bfhi(ov[j].y)) * v[3] * rstd * g0.w);
            w.z = pk2(sigmoidf_(bflo(ov[j].z)) * v[4] * rstd * g1.x, sigmoidf_(bfhi(ov[j].z)) * v[5] * rstd * g1.y);
            w.w = pk2(sigmoidf_(bflo(ov[j].w)) * v[6] * rstd * g1.z, sigmoidf_(bfhi(ov[j].w)) * v[7] * rstd * g1.w);
            *(v4u*)(A2 + (size_t)row * D + c) = w;
        }
#pragma unroll
        for (int j = 0; j < 8; ++j) { h0[j] = n0[j]; h1[j] = n1[j]; ov[j] = no[j]; }
    }
}
#define XB_TMO      128
#define XB_XCNT(j)  (256  + 64 * (j))
#define XB_XSUB(j)  (1280 + 64 * (j))
#define XB_XGEN(j)  (2304 + 64 * (j))
#define XB_TOP      3328
#define XB_TOPGEN   3392
#define XCD_BAR_WORDS 3456
#define XB_SPIN_CAP (1u << 22)

__device__ __forceinline__ unsigned xb_ld(unsigned* p)              { return __hip_atomic_load(p, __ATOMIC_RELAXED, __HIP_MEMORY_SCOPE_AGENT); }
__device__ __forceinline__ unsigned xb_add(unsigned* p, unsigned v) { return __hip_atomic_fetch_add(p, v, __ATOMIC_RELAXED, __HIP_MEMORY_SCOPE_AGENT); }
__device__ __forceinline__ unsigned xb_xcc_id() { return (unsigned)__builtin_amdgcn_s_getreg((3 << 11) | 20) & 0xFu; }
#define XB_SPIN(cond, bar) do { unsigned _sp = 0; while (cond) { __builtin_amdgcn_s_sleep(1); \
    if ((++_sp & 255u) == 0u) { if (xb_ld(&(bar)[XB_TMO])) break; if (_sp > XB_SPIN_CAP) { atomicAdd(&(bar)[XB_TMO], 1u); break; } } } } while (0)

struct XcdBarrier { unsigned* bar; unsigned x; volatile LAS unsigned* st; };

__device__ __forceinline__ XcdBarrier xcd_barrier_post(unsigned* bar, volatile LAS unsigned* st) {
    XcdBarrier b; b.bar = bar; b.x = xb_xcc_id(); b.st = st;
    if (threadIdx.x == 0) (void)xb_add(&bar[XB_XCNT(b.x)], 1u);
    return b;
}
__device__ __forceinline__ void xcd_barrier_complete(unsigned* bar, unsigned x, unsigned& nloc, unsigned& nx) {
    const unsigned G = gridDim.x * gridDim.y * gridDim.z;
    unsigned sum, cnt, mine, sp = 0u;
    for (;;) {
        sum = 0u; cnt = 0u; mine = 0u;
#pragma unroll
        for (unsigned j = 0; j < 16; ++j) { const unsigned c = xb_ld(&bar[XB_XCNT(j)]); sum += c; cnt += (c > 0u) ? 1u : 0u; mine = (j == x) ? c : mine; }
        if (sum == G) break;
        __builtin_amdgcn_s_sleep(1);
        if ((++sp & 255u) == 0u) { if (xb_ld(&bar[XB_TMO])) break; if (sp > XB_SPIN_CAP) { atomicAdd(&bar[XB_TMO], 1u); break; } }
    }
    nloc = mine > 0u ? mine : 1u; nx = cnt > 0u ? cnt : 1u;
}
__device__ __forceinline__ void xcd_barrier(const int tid, const XcdBarrier& b) {
    asm volatile("s_waitcnt vmcnt(0)" ::: "memory");
    __syncthreads();
    if (tid == 0) {
        unsigned* bar = b.bar;
        __builtin_amdgcn_s_waitcnt(0);
        unsigned nloc = b.st[0], nx = b.st[1];
        if (nloc == 0u) { xcd_barrier_complete(bar, b.x, nloc, nx); b.st[0] = nloc; b.st[1] = nx; }
        const unsigned old = xb_add(&bar[XB_XSUB(b.x)], 1u);
        const unsigned gen = old / nloc;
        if (old + 1u == (gen + 1u) * nloc) {
            __builtin_amdgcn_fence(__ATOMIC_RELEASE, "agent");
            asm volatile("s_waitcnt vmcnt(0)" ::: "memory");
            const unsigned og = xb_add(&bar[XB_TOP], 1u);
            const unsigned tg = og / nx;
            if (og + 1u == (tg + 1u) * nx) xb_add(&bar[XB_TOPGEN], 1u);
            else XB_SPIN(xb_ld(&bar[XB_TOPGEN]) == tg, bar);
            __builtin_amdgcn_fence(__ATOMIC_ACQUIRE, "agent");
            xb_add(&bar[XB_XGEN(b.x)], 1u);
            asm volatile("s_waitcnt vmcnt(0)" ::: "memory");
        } else {
            XB_SPIN(xb_ld(&bar[XB_XGEN(b.x)]) == gen, bar);
            __builtin_amdgcn_fence(__ATOMIC_ACQUIRE, "agent");
            asm volatile("s_waitcnt vmcnt(0)" ::: "memory");
        }
    }
    __syncthreads();
}

constexpr int N_PHASES = 24;
struct Args { const float* in[24]; float* out; unsigned char* ws; int ph_lo, ph_hi; };
__global__ void __launch_bounds__(NTHR, 2) fwd_kernel(Args args) {
    extern __shared__ __attribute__((aligned(16))) unsigned char lds_raw[];
    Frame F;
    F.lds = (LAS unsigned char*)lds_raw;
    F.wave = __builtin_amdgcn_readfirstlane((int)threadIdx.x >> 6) & 7; F.lane = pg8::fresh_lane(); F.tid = F.wave * 64 + F.lane;
    F.bid = blockIdx.x; F.G = gridDim.x; F.ws = args.ws; F.out = args.out;
#pragma unroll
    for (int i = 0; i < 24; ++i) F.in[i] = args.in[i];
    volatile LAS unsigned* MISC = (volatile LAS unsigned*)(F.lds + MISC_OFF);
    if (F.tid < 64) MISC[F.tid] = 0u;
    __syncthreads();
    const int lo = args.ph_lo, hi = args.ph_hi;
    const bool multi = (hi - lo) > 1;
    unsigned* barw = (unsigned*)(F.ws + WS_CTL) + CW_BAR;
    XcdBarrier bar; bar.bar = barw; bar.x = 0; bar.st = MISC + 8;
    if (multi) bar = xcd_barrier_post(barw, MISC + 8);
#ifndef REP_MASK
#define REP_MASK 0u
#endif
#define IN(k) (lo <= (k) && (k) < hi)
#define NREP(k) (1 + (int)((REP_MASK >> (k)) & 1u))
#ifndef TSEL
#define TSEL 0u
#endif
#ifndef TAMP
#define TAMP 4
#endif
    unsigned long long t_prev = TSEL ? __builtin_amdgcn_s_memrealtime() : 0ull, t_acc = 0ull;
#define TMARK(k) do { if (TSEL) { const unsigned long long t_now = __builtin_amdgcn_s_memrealtime(); if ((TSEL >> (k)) & 1u) t_acc += t_now - t_prev; t_prev = t_now; } } while (0)
#define SEAM(k) do { if (IN(k) && IN((k) + 1)) xcd_barrier(F.tid, bar); TMARK(k); F.lane = pg8::fresh_lane(); F.tid = F.wave * 64 + F.lane; } while (0)
#define RUN(k, ...) _Pragma("unroll") for (int rep_ = 0; rep_ < NREP(k); ++rep_) { __VA_ARGS__ }
    LAS unsigned char* ring = F.lds;

    if (IN(0)) { RUN(0, p0_convert(F); __syncthreads(); p0_adaln(F);) } SEAM(0);
    if (IN(1)) { RUN(1, p1_ln0(F);) } SEAM(1);
    if (IN(2)) { RUN(2, { pg8::Gemm g{WSP(bf16, WS_U), WSP(bf16, WS_W1T), D, D, D, 0, 0, nullptr, 0, 0}; pg8::TileOrder S; S.init(1, ML / 256, DIN0 / 256, F.G, F.bid);
            EpiBf16Plain E{WSP(bf16, WS_BIG), DIN0}; pg8::gemm_phase(F.wave, ring, g, S, E); }
        { pg8::Gemm g{WSP(bf16, WS_U), WSP(bf16, WS_W1T), D, D, 1024, 0, 0, nullptr, 0, 2048}; pg8::TailOrder S; S.init(0, 48, 4, 32, 2, F.G, F.bid);
            EpiSlab E{WSP(float, WS_SLAB), 4}; pg8::gemm_phase(F.wave, ring, g, S, E); }) } SEAM(2);
    if (IN(3)) { RUN(3, reduce_xzs_ctx(F);) } SEAM(3);
    if (IN(4)) { RUN(4, lru_phase(F, &t_acc); pool_pass1(F); pool_ctx(F);) } SEAM(4);
    if (IN(5)) { RUN(5, lru_carry(F); pool_pass2(F);) } SEAM(5);
    if (IN(6)) { RUN(6, lru_apply(F);
        pg8::Gemm g{WSP(bf16, WS_DP), WSP(bf16, WS_PWT), DPOOL, 512, 512, 512 * 2, 512 * 512 * 2, nullptr, 0, 0}; pg8::TileOrder S; S.init(4, MT / 256, 2, F.G, F.bid);
        EpiPool E{WSP(bf16, WS_A2), F.in[15]}; pg8::gemm_phase(F.wave, ring, g, S, E);) } SEAM(6);
    if (IN(7)) { RUN(7, { pg8::Gemm g{WSP(bf16, WS_A2), WSP(bf16, WS_W2T), D, D, D, 0, 0, nullptr, 0, 0}; pg8::TileOrder S; S.init(1, ML / 256, D / 256, F.G, F.bid);
            EpiBf16Plain E{WSP(bf16, WS_YE), D}; pg8::gemm_phase(F.wave, ring, g, S, E); }
        { pg8::Gemm g{WSP(bf16, WS_A2), WSP(bf16, WS_W2T), D, D, 512, 0, 0, nullptr, 0, 1024}; pg8::TailOrder S; S.init(0, 32, 8, 32, 2, F.G, F.bid);
            EpiSlab E{WSP(float, WS_SLAB), 8}; pg8::gemm_phase(F.wave, ring, g, S, E); }) } SEAM(7);
    if (IN(8)) { RUN(8, ln_router_phase(F, 0, MT, rep_ > 0, true, &t_acc);) } SEAM(8);
    if (IN(9)) { RUN(9, topk_phase(F, 4, ER0);) } SEAM(9);
    if (IN(10)) { RUN(10, { pg8::Gemm g{WSP(bf16, WS_U8), WSP(bf16, WS_WGU), D, D, D, 0, (size_t)2048 * D, WSP(int, WS_IDX), ER0, 0}; pg8::TileOrder S; S.init(16, 4, 8, F.G, F.bid);
            EpiGU E{WSP(unsigned char, WS_ACT), ER0}; pg8::gemm_phase<true, 1>(F.wave, ring, g, S, E); }
        { pg8::Gemm g{WSP(bf16, WS_U8), WSP(bf16, WS_WGU), D, D, 2048, 0, (size_t)2048 * D, WSP(int, WS_IDX), ER0, 2048}; pg8::TailOrder S; S.init(1, 128, 2, 4, 1, F.G, F.bid);
            EpiSlab E{WSP(float, WS_SLAB), 2}; pg8::gemm_phase<true, 1>(F.wave, ring, g, S, E); }) } SEAM(10);
    if (IN(11)) { RUN(11, reduce_act_ctx(F);) } SEAM(11);
    if (IN(12)) { RUN(12, pg8::Gemm g{WSP(bf16, WS_ACT), WSP(bf16, WS_WDN), DE, DE, DE, (size_t)ER0 * DE, (size_t)D * DE, nullptr, 0, 0}; pg8::TileOrder S; S.init(16, ER0 / 256, 16, F.G, F.bid);
        EpiDown E{WSP(bf16, WS_YE), WSP(float, WS_GX), ER0}; pg8::gemm_phase<false, 1>(F.wave, ring, g, S, E);) } SEAM(12);
    if (IN(13)) { RUN(13, combine_phase<false>(F, 0, MT, ER0, rep_ > 0);) } SEAM(13);
    if (IN(14)) { RUN(14, { pg8::Gemm g{WSP(bf16, WS_U), WSP(bf16, WS_W3T), D, D, D, 0, 0, nullptr, 0, 0}; pg8::TileOrder S; S.init(1, ML / 256, DIN1 / 256, F.G, F.bid);
            EpiOddIn E{WSP(bf16, WS_BIG), WSP(float, WS_G), F.in[18]}; pg8::gemm_phase(F.wave, ring, g, S, E); }
        { pg8::Gemm g{WSP(bf16, WS_U), WSP(bf16, WS_W3T), D, D, 2048, 0, 0, nullptr, 0, 4096}; pg8::TailOrder S; S.init(2, 82, 2, 0, 0, F.G, F.bid);
            EpiSlab E{WSP(float, WS_SLAB), 2}; pg8::gemm_phase(F.wave, ring, g, S, E); }) } SEAM(14);
    if (IN(15)) { RUN(15, reduce_odd_tail(F);) } SEAM(15);
    if (IN(16)) { RUN(16, mlstm_phase(F, &t_acc);) } SEAM(16);
    if (IN(17)) { RUN(17, headnorm_phase(F);) } SEAM(17);
    if (IN(18)) { RUN(18, pg8::Gemm g{WSP(bf16, WS_A2), WSP(bf16, WS_W4T), D, D, D, 0, 0, nullptr, 0, 0}; pg8::TileOrder S; S.init(1, ML / 256, D / 256, F.G, F.bid);
        EpiBf16Plain E{WSP(bf16, WS_YE), D}; pg8::gemm_phase(F.wave, ring, g, S, E);) } SEAM(18);
    if (IN(19)) { RUN(19, ln_router_phase(F, 1, ML, rep_ > 0, false, &t_acc);) } SEAM(19);
    if (IN(20)) { RUN(20, topk_phase(F, 2, ER1);) } SEAM(20);
    if (IN(21)) { RUN(21, pg8::Gemm g{WSP(bf16, WS_U8), (const bf16*)(WSP(unsigned char, WS_WGU) + (size_t)16 * 2048 * D), D, D, D, 0, (size_t)2048 * D, WSP(int, WS_IDX), ER1, 0}; pg8::TileOrder S; S.init(16, ER1 / 256, 8, F.G, F.bid);
        EpiGU E{WSP(unsigned char, WS_ACT), ER1}; pg8::gemm_phase<true, 1>(F.wave, ring, g, S, E);) } SEAM(21);
    if (IN(22)) { RUN(22, pg8::Gemm g{WSP(bf16, WS_ACT), (const bf16*)(WSP(unsigned char, WS_WDN) + (size_t)16 * D * DE), DE, DE, DE, (size_t)ER1 * DE, (size_t)D * DE, nullptr, 0, 0}; pg8::TileOrder S; S.init(16, ER1 / 256, 16, F.G, F.bid);
        EpiDown E{WSP(bf16, WS_YE), WSP(float, WS_GX), ER1}; pg8::gemm_phase<false, 1>(F.wave, ring, g, S, E);) } SEAM(22);
    if (IN(23)) { RUN(23, combine_phase<true>(F, 1, ML, ER1);) }
    TMARK(23);
    if (TSEL && blockIdx.x == 0) { const unsigned long long t_end = __builtin_amdgcn_s_memrealtime(); while (__builtin_amdgcn_s_memrealtime() - t_end < (unsigned long long)TAMP * t_acc) __builtin_amdgcn_s_sleep(8); }
#undef IN
#undef RUN
#undef SEAM
}

#ifndef MK_ONE_LAUNCH
#define MK_ONE_LAUNCH 0
#endif
extern "C" void kernel_launch(void* const* d_in, const int* in_sizes, int n_in, void* d_out, int out_size, void* d_ws, size_t ws_size, hipStream_t stream) {
    static int grid = 0;
    if (grid == 0) {
        if (n_in != 24 || out_size != ML * D || ws_size < WS_END) { fprintf(stderr, "kernel_launch: unexpected shapes (n_in %d, out %d, ws %zu); nothing launched\n", n_in, out_size, ws_size); grid = -1; return; }
        int dev = 0, cus = 0, per_cu = 0;
        if (hipGetDevice(&dev) != hipSuccess || hipDeviceGetAttribute(&cus, hipDeviceAttributeMultiprocessorCount, dev) != hipSuccess) { grid = -1; return; }
        if (hipFuncSetAttribute((const void*)fwd_kernel, hipFuncAttributeMaxDynamicSharedMemorySize, LDS_BYTES) != hipSuccess) { fprintf(stderr, "kernel_launch: hipFuncSetAttribute failed\n"); grid = -1; return; }
        if (hipOccupancyMaxActiveBlocksPerMultiprocessor(&per_cu, (const void*)fwd_kernel, NTHR, LDS_BYTES) != hipSuccess || per_cu < 1) { fprintf(stderr, "kernel_launch: occupancy query says %d\n", per_cu); }
        (void)hipGetLastError();
        grid = cus;
    }
    if (grid < 0) return;
    if (hipMemsetAsync((char*)d_ws + WS_CTL, 0, CTL_ZERO_BYTES, stream) != hipSuccess) return;
    Args a{};
    for (int i = 0; i < 24; ++i) a.in[i] = (const float*)d_in[i];
    a.out = (float*)d_out; a.ws = (unsigned char*)d_ws;
#if MK_ONE_LAUNCH
    a.ph_lo = 0; a.ph_hi = N_PHASES;
    hipLaunchKernelGGL(fwd_kernel, dim3(grid), dim3(NTHR), LDS_BYTES, stream, a);
#else
    for (int p = 0; p < N_PHASES; ++p) { a.ph_lo = p; a.ph_hi = p + 1; hipLaunchKernelGGL(fwd_kernel, dim3(grid), dim3(NTHR), LDS_BYTES, stream, a); }
#endif
}
```

```cpp
#ifndef MK_ONE_LAUNCH
#define MK_ONE_LAUNCH 1
#endif
#ifndef REP_MASK
#define REP_MASK 0u
#endif
#ifndef TSEL
#define TSEL 0u
#endif
#ifndef RSEL
#define RSEL 0
#endif
#include <hip/hip_runtime.h>
#include <cstdio>
#include <cstdint>
namespace pg8 {
__device__ __forceinline__ int fresh_lane() { int l; asm volatile("v_mbcnt_lo_u32_b32 %0, -1, 0\n\tv_mbcnt_hi_u32_b32 %0, -1, %0" : "=v"(l)); return l & 63; }
#define PG8_LAS __attribute__((address_space(3)))
typedef unsigned short bf16_t;
typedef short bf16x8 __attribute__((ext_vector_type(8)));
typedef float f32x4 __attribute__((ext_vector_type(4)));
typedef float f32x2 __attribute__((ext_vector_type(2)));
typedef unsigned u32x4 __attribute__((ext_vector_type(4)));
typedef unsigned u32x2 __attribute__((ext_vector_type(2)));
typedef int i32x4 __attribute__((ext_vector_type(4)));
typedef int i32x8 __attribute__((ext_vector_type(8)));
constexpr int BM = 256, BK = 64, HALF = 128, HTB = HALF * BK * 2  , STAGE_BYTES = 8 * HTB, NXCD = 8, WGM = 8;

__host__ __device__ __forceinline__ int lds_byte(int r, int c) { const int st = (r >> 4) * 2 + (c >> 5), rr = r & 15, cc = c & 31, ob = rr * 64 + cc * 2; return st * 1024 + (ob ^ (((ob >> 9) & 1) << 5)); }
__host__ __device__ __forceinline__ void stage_rc(int b, int& R, int& C) { const int st = b / 1024, sb = b % 1024, swz = sb ^ (((sb >> 9) & 1) << 5); R = (st >> 1) * 16 + swz / 64; C = (st & 1) * 32 + (swz % 64) / 2; }
__host__ __device__ __forceinline__ int perm32(int rho) { const int n = rho >> 4, i = rho & 15; return 8 * (i >> 2) + 4 * n + (i & 3); }

struct Unit { int pm, pn, g, ks, t; };
struct Gemm { const bf16_t* A; const bf16_t* Bt; int lda, ldb, K; size_t gA, gB; const int* rowidx; int grows; size_t kS; };

struct TileOrder {
    int nG, nM, nN, per, nwg, G, c;
    __device__ __forceinline__ void init(int nG_, int nM_, int nN_, int G_, int c_) { nG = nG_; nM = nM_; nN = nN_; per = nM * nN; nwg = nG * per; G = G_; c = c_; }
    __device__ __forceinline__ bool next(int i, Unit& u) const {
        const long L = (long)i * G + c; if (L >= nwg) return false;
        int wgid = (int)L; { const int q = nwg / NXCD, r = nwg % NXCD, xcd = wgid % NXCD, off = wgid / NXCD; wgid = (xcd < r ? xcd * (q + 1) : r * (q + 1) + (xcd - r) * q) + off; }
        u.ks = 0; u.t = 0; u.g = wgid / per; wgid -= u.g * per;
        const int nig = WGM * nN, gid = wgid / nig, fm = gid * WGM, gsz = (nM - fm) < WGM ? (nM - fm) : WGM;
        u.pm = fm + ((wgid % nig) % gsz); u.pn = (wgid % nig) / gsz; return true;
    }
};

struct TailOrder {
    int ntiles, nS, G, c, kind, pm0, nM;
    __device__ __forceinline__ void init(int kind_, int ntiles_, int nS_, int pm0_, int nM_, int G_, int c_) { kind = kind_; ntiles = ntiles_; nS = nS_; pm0 = pm0_; nM = nM_; G = G_; c = c_; }
    __device__ __forceinline__ bool next(int i, Unit& u) const {
        const int nwg = ntiles * nS; const long L = (long)i * G + c; if (L >= nwg) return false;
        int wgid = (int)L; { const int q = nwg / NXCD, r = nwg % NXCD, xcd = wgid % NXCD, off = wgid / NXCD; wgid = (xcd < r ? xcd * (q + 1) : r * (q + 1) + (xcd - r) * q) + off; }
        u.ks = wgid % nS; const int t = wgid / nS; u.t = t; u.g = 0;
        if (kind == 0) { u.pm = pm0 + t % nM; u.pn = t / nM; }
        else if (kind == 1) { u.g = t >> 3; u.pn = t & 7; u.pm = 4; }
        else { if (t < 32) { u.pm = t; u.pn = 48; } else { const int j = t - 32, q = j % 25; u.pm = 32 + j / 25; u.pn = q < 24 ? 8 + q : 48; } }
        return true;
    }
};

__device__ __forceinline__ unsigned cvt_pk_bf16(float lo, float hi) { unsigned r; asm volatile("v_cvt_pk_bf16_f32 %0, %1, %2" : "=v"(r) : "v"(lo), "v"(hi)); return r; }

template <bool GATHER = false, int ES = 2, class Epi, class Sched>
__device__ __forceinline__ void gemm_phase(const int wid  , PG8_LAS unsigned char* lds, const Gemm g, const Sched& S, const Epi& E) {
    const int lane = fresh_lane(), tid = wid * 64 + lane, wr = wid >> 2, wc = wid & 3, fr = lane & 15, fq = lane >> 4;
    const int K = g.K, nt = K * ES / (BK * 2);
    unsigned voffA[2], voffB[2];
#pragma unroll
    for (int i = 0; i < 2; ++i) { int R, C; stage_rc(tid * 16 + i * 8192, R, C); const int Rb = Epi::PERM ? ((R & ~31) + perm32(R & 31)) : R;
        voffA[i] = (unsigned)(R * g.lda * ES + C * 2); voffB[i] = (unsigned)(Rb * g.ldb * ES + C * 2); }
    unsigned vA[2][2], vAn[2][2];
#define PG8_GOFFS(v, u) do { int _t = tid; asm volatile("" : "+v"(_t));     \
        _Pragma("unroll") for (int _i = 0; _i < 2; ++_i) { int _R, _C; stage_rc(_t * 16 + _i * 8192, _R, _C); _Pragma("unroll") for (int _h = 0; _h < 2; ++_h) \
        (v)[_h][_i] = (unsigned)(g.rowidx[(size_t)(u).g * g.grows + (u).pm * 256 + _h * 128 + _R] * g.lda * ES + _C * 2); } } while (0)
    const size_t kstep = (size_t)(BK * 2);
    const size_t hstepA = (size_t)HALF * g.lda * ES, hstepB = (size_t)HALF * g.ldb * ES;
    const size_t tstepA = 2 * hstepA, tstepB = 2 * hstepB;
    const unsigned ldsw = (unsigned)wid * 1024u;
    const int aoff = lds_byte(wr * 64 + fr, fq * 8), boff = lds_byte(wc * 32 + fr, fq * 8);
#define PG8_SA(b, h) (((b) * 2 + (h)) * HTB)
#define PG8_SB(b, h) ((4 + (b) * 2 + (h)) * HTB)
#define PG8_STAGE(bufoff, gbase, voff) do { _Pragma("unroll") for (int _i = 0; _i < 2; ++_i) { unsigned _vo = (voff)[_i]; asm volatile("" : "+v"(_vo));     \
        __builtin_amdgcn_global_load_lds((const unsigned*)((const char*)(gbase) + _vo), (PG8_LAS unsigned*)(lds + (bufoff) + ldsw + _i * 8192), 16, 0, 0); } } while (0)
#define PG8_LDA(dst, b, h) do { if constexpr (ES == 2) { _Pragma("unroll") for (int m = 0; m < 4; ++m) _Pragma("unroll") for (int k = 0; k < 2; ++k) dst[m][k] = *(const PG8_LAS bf16x8*)(lds + PG8_SA(b, h) + aoff + m * 2048 + k * 1024); } \
        else { _Pragma("unroll") for (int m = 0; m < 4; ++m) { dst##8[m].lo = *(const PG8_LAS i32x4*)(lds + PG8_SA(b, h) + aoff + m * 2048); dst##8[m].hi = *(const PG8_LAS i32x4*)(lds + PG8_SA(b, h) + aoff + m * 2048 + 1024); } } } while (0)
#define PG8_LDB(dst, b, h) do { if constexpr (ES == 2) { _Pragma("unroll") for (int n = 0; n < 2; ++n) _Pragma("unroll") for (int k = 0; k < 2; ++k) dst[n][k] = *(const PG8_LAS bf16x8*)(lds + PG8_SB(b, h) + boff + n * 2048 + k * 1024); } \
        else { _Pragma("unroll") for (int n = 0; n < 2; ++n) { dst##8[n].lo = *(const PG8_LAS i32x4*)(lds + PG8_SB(b, h) + boff + n * 2048); dst##8[n].hi = *(const PG8_LAS i32x4*)(lds + PG8_SB(b, h) + boff + n * 2048 + 1024); } } } while (0)
#define PG8_CAT8(x, y) __builtin_shufflevector(__builtin_bit_cast(i32x4, (x)), __builtin_bit_cast(i32x4, (y)), 0, 1, 2, 3, 4, 5, 6, 7)
#define PG8_MMA(ai, bj, At, Bt) do { __builtin_amdgcn_s_setprio(1); \
        if constexpr (ES == 2) { _Pragma("unroll") for (int m = 0; m < 4; ++m) _Pragma("unroll") for (int n = 0; n < 2; ++n) _Pragma("unroll") for (int k = 0; k < 2; ++k) \
            acc[ai][bj][m][n] = __builtin_amdgcn_mfma_f32_16x16x32_bf16(Bt[n][k], At[m][k], acc[ai][bj][m][n], 0, 0, 0); } \
        else { _Pragma("unroll") for (int m = 0; m < 4; ++m) _Pragma("unroll") for (int n = 0; n < 2; ++n) \
            acc[ai][bj][m][n] = __builtin_amdgcn_mfma_scale_f32_16x16x128_f8f6f4(Bt##8[n], At##8[m], acc[ai][bj][m][n], 0, 0, 0, 0, 0, 0); } \
        __builtin_amdgcn_s_setprio(0); } while (0)
#define PG8_WAIT_V(n) asm volatile("s_waitcnt vmcnt(" #n ")" ::: "memory")
#define PG8_WAIT_L(n) asm volatile("s_waitcnt lgkmcnt(" #n ")" ::: "memory")
#define PG8_BAR __builtin_amdgcn_s_barrier()
#define PG8_SCHED __builtin_amdgcn_sched_barrier(0)
    Unit cur, nxt; int ui = 0;
    if (!S.next(0, cur)) return;
    f32x4 acc[2][2][4][2];
#pragma unroll
    for (int a = 0; a < 2; ++a)
#pragma unroll
        for (int b = 0; b < 2; ++b)
#pragma unroll
            for (int m = 0; m < 4; ++m)
#pragma unroll
                for (int n = 0; n < 2; ++n) acc[a][b][m][n] = (f32x4){0.f, 0.f, 0.f, 0.f};
    bf16x8 At[4][2], B0[2][2], B1[2][2];
    i32x8 At8[4], B08[2], B18[2];
    const char* cA = (GATHER ? (const char*)g.A : (const char*)g.A + (size_t)cur.g * g.gA + (size_t)cur.pm * tstepA) + (size_t)cur.ks * g.kS; const char* cB = (const char*)g.Bt + (size_t)cur.g * g.gB + (size_t)cur.pn * tstepB + (size_t)cur.ks * g.kS;
    if constexpr (GATHER) { PG8_GOFFS(vA, cur); }
    if constexpr (GATHER) { PG8_STAGE(PG8_SB(0, 0), cB, voffB); PG8_STAGE(PG8_SB(0, 1), cB + hstepB, voffB); PG8_STAGE(PG8_SA(0, 0), cA, vA[0]); PG8_STAGE(PG8_SA(0, 1), cA, vA[1]); }
    else { PG8_STAGE(PG8_SB(0, 0), cB, voffB); PG8_STAGE(PG8_SB(0, 1), cB + hstepB, voffB); PG8_STAGE(PG8_SA(0, 0), cA, voffA); PG8_STAGE(PG8_SA(0, 1), cA + hstepA, voffA); }
    if (wr == 1) PG8_BAR;
    PG8_WAIT_V(2); PG8_BAR;
    if constexpr (GATHER) { PG8_STAGE(PG8_SB(1, 0), cB + kstep, voffB); PG8_STAGE(PG8_SA(1, 0), cA + kstep, vA[0]); PG8_STAGE(PG8_SB(1, 1), cB + hstepB + kstep, voffB); }
    else { PG8_STAGE(PG8_SB(1, 0), cB + kstep, voffB); PG8_STAGE(PG8_SA(1, 0), cA + kstep, voffA); PG8_STAGE(PG8_SB(1, 1), cB + hstepB + kstep, voffB); }
    PG8_WAIT_V(6); PG8_BAR;
    for (;;) {
        const bool has_next = S.next(ui + 1, nxt);
        const char* nA = !has_next ? cA : (GATHER ? (const char*)g.A : (const char*)g.A + (size_t)nxt.g * g.gA + (size_t)nxt.pm * tstepA) + (size_t)nxt.ks * g.kS; const char* nB = has_next ? (const char*)g.Bt + (size_t)nxt.g * g.gB + (size_t)nxt.pn * tstepB + (size_t)nxt.ks * g.kS : cB;
        if constexpr (GATHER) { if (has_next) { PG8_GOFFS(vAn, nxt); } else {
#pragma unroll
                for (int _h = 0; _h < 2; ++_h)
#pragma unroll
                    for (int _i = 0; _i < 2; ++_i) vAn[_h][_i] = vA[_h][_i]; } }
        for (int t = 0; t < nt; t += 2) {
            const bool last = (t == nt - 2);
            const char* a1 = cA + (size_t)(t + 1) * kstep;
            const char* a2 = last ? nA : cA + (size_t)(t + 2) * kstep; const char* b2 = last ? nB : cB + (size_t)(t + 2) * kstep;
            const char* a3 = a2 + kstep; const char* b3 = b2 + kstep;
            PG8_LDB(B0, 0, 0); PG8_LDB(B1, 0, 1); PG8_SCHED; PG8_LDA(At, 0, 0); if constexpr (GATHER) { PG8_STAGE(PG8_SA(1, 1), a1, vA[1]); } else { PG8_STAGE(PG8_SA(1, 1), a1 + hstepA, voffA); }
            PG8_WAIT_V(8); PG8_WAIT_L(0); PG8_BAR; PG8_MMA(0, 0, At, B0); PG8_MMA(0, 1, At, B1); PG8_BAR; PG8_SCHED;
            if constexpr (GATHER) { if (last) {
#pragma unroll
                    for (int _h = 0; _h < 2; ++_h)
#pragma unroll
                        for (int _i = 0; _i < 2; ++_i) vA[_h][_i] = vAn[_h][_i]; } }
            PG8_LDA(At, 0, 1); PG8_STAGE(PG8_SB(0, 0), b2, voffB); PG8_STAGE(PG8_SB(0, 1), b2 + hstepB, voffB); if constexpr (GATHER) { PG8_STAGE(PG8_SA(0, 0), a2, vA[0]); } else { PG8_STAGE(PG8_SA(0, 0), a2, voffA); }
            PG8_WAIT_V(8); PG8_WAIT_L(0); PG8_BAR; PG8_MMA(1, 0, At, B0); PG8_MMA(1, 1, At, B1); PG8_BAR; PG8_SCHED;
            PG8_LDB(B0, 1, 0); PG8_LDB(B1, 1, 1); PG8_SCHED; PG8_LDA(At, 1, 0); if constexpr (GATHER) { PG8_STAGE(PG8_SA(0, 1), a2, vA[1]); } else { PG8_STAGE(PG8_SA(0, 1), a2 + hstepA, voffA); }
            PG8_WAIT_V(8); PG8_WAIT_L(0); PG8_BAR; PG8_MMA(0, 0, At, B0); PG8_MMA(0, 1, At, B1); PG8_BAR; PG8_SCHED;
            PG8_LDA(At, 1, 1); PG8_STAGE(PG8_SB(1, 0), b3, voffB); PG8_STAGE(PG8_SB(1, 1), b3 + hstepB, voffB); if constexpr (GATHER) { PG8_STAGE(PG8_SA(1, 0), a3, vA[0]); } else { PG8_STAGE(PG8_SA(1, 0), a3, voffA); }
            PG8_WAIT_V(8); PG8_WAIT_L(0); PG8_BAR; PG8_MMA(1, 0, At, B0); PG8_MMA(1, 1, At, B1); PG8_BAR; PG8_SCHED;
        }
        if (wr == 0) PG8_BAR;
        E(acc, cur, wr, wc, fr, fq);
        if (!has_next) break;
#pragma unroll
        for (int a = 0; a < 2; ++a)
#pragma unroll
            for (int b = 0; b < 2; ++b)
#pragma unroll
                for (int m = 0; m < 4; ++m)
#pragma unroll
                    for (int n = 0; n < 2; ++n) acc[a][b][m][n] = (f32x4){0.f, 0.f, 0.f, 0.f};
        cur = nxt; cA = nA; cB = nB; ++ui;
        if (wr == 1) PG8_BAR;
    }
    PG8_WAIT_V(0);
    PG8_BAR;
#undef PG8_GOFFS
#undef PG8_SA
#undef PG8_SB
#undef PG8_STAGE
#undef PG8_LDA
#undef PG8_LDB
#undef PG8_MMA
#undef PG8_CAT8
#undef PG8_WAIT_V
#undef PG8_WAIT_L
#undef PG8_BAR
#undef PG8_SCHED
}
}
#define GAS __attribute__((address_space(1)))
#define LAS __attribute__((address_space(3)))
typedef unsigned short bf16;
typedef unsigned v4u __attribute__((ext_vector_type(4)));
typedef unsigned v2u __attribute__((ext_vector_type(2)));
typedef float f32x4 __attribute__((ext_vector_type(4)));
typedef float f32x2 __attribute__((ext_vector_type(2)));
typedef short bf16x8 __attribute__((ext_vector_type(8)));

constexpr int D = 4096, NB = 2, SEQ = 4096, CTXL = 256;
constexpr int ML = NB * SEQ, MC = NB * CTXL, MT = ML + MC;
constexpr int DLRU = 2048, LRUH = 16, LRUB = 128, DPOOL = 2048, DIN0 = 6144;
constexpr int MH = 8, DQK = 256, DV = 512, DIN1 = 12288, DIN1P = 12544, CHUNK = 64;
constexpr int NE = 16, DE = 1024;
constexpr int ER0 = 1280, ER1 = 1024;
constexpr float LN_EPS = 1e-5f, DN_ALPHA = 1.41421356237f;
constexpr int NT_TILES = 136;

constexpr size_t WS_CTL = 0ull, CTL_ZERO_BYTES = 1048576ull;
constexpr size_t WS_MOD = 1048576ull;
constexpr size_t WS_WRT = 1638400ull;
constexpr size_t WS_LS8 = 2162688ull;
constexpr size_t WS_W1T = 2179072ull;
constexpr size_t WS_W2T = 52510720ull;
constexpr size_t WS_W3T = 86065152ull;
constexpr size_t WS_W4T = 188825600ull;
constexpr size_t WS_WGU = 222380032ull;
constexpr size_t WS_WDN = 759250944ull;
constexpr size_t WS_GWT = 1027686400ull;
constexpr size_t WS_PWT = 1029783552ull;
constexpr size_t WS_H = 1031880704ull;
constexpr size_t WS_U = 1174487040ull;
constexpr size_t WS_BIG = 1245790208ull;
constexpr size_t WS_A2 = 1459699712ull;
constexpr size_t WS_CM = 1531002880ull;
constexpr size_t WS_DP = 1598111744ull;
constexpr size_t WS_SUMM = 1633763328ull;
constexpr size_t WS_CARRY = 1638219776ull;
constexpr size_t WS_AFF = 1640448000ull;
constexpr size_t WS_IDX = 1641496576ull;
constexpr size_t WS_GSEL = 1641627648ull;
constexpr size_t WS_INV = 1641758720ull;
constexpr size_t WS_GX = 1642315776ull;
constexpr size_t WS_XE = 1642397696ull;
constexpr size_t WS_ACT = 1810169856ull;
constexpr size_t WS_YE = 1852112896ull;
constexpr size_t WS_G = 2019885056ull;
constexpr size_t WS_HD = 2020999168ull;
constexpr size_t WS_SLAB = 2155216896ull;
constexpr size_t WS_MSC = 2155216896ull + 67108864ull;
constexpr size_t WS_WRH = WS_MSC + 256ull * 68 * 576 * 4;
constexpr size_t WS_WRL = WS_WRH + 262144ull;
constexpr size_t WS_U8 = WS_WRL + 262144ull;
constexpr size_t WS_DUMP = WS_U8 + 8704ull * 4096;
constexpr size_t WS_END = WS_DUMP + 65536ull;

constexpr int CW_BAR = 4096;
constexpr int LDS_BYTES = 147456;
constexpr int MISC_OFF = 144 * 1024 - 256;
constexpr int NTHR = 512;

typedef __bf16 hwbf16x2 __attribute__((ext_vector_type(2)));
typedef float f32x2_ __attribute__((ext_vector_type(2)));
__device__ __forceinline__ unsigned pk2(float lo, float hi) { const f32x2_ f = {lo, hi}; return __builtin_bit_cast(unsigned, __builtin_convertvector(f, hwbf16x2)); }
__device__ __forceinline__ unsigned f2bf(float f) { return pk2(f, 0.f) & 0xffffu; }
__device__ __forceinline__ float bf2f(unsigned b) { return __builtin_bit_cast(float, b << 16); }
__device__ __forceinline__ float bflo(unsigned w) { return __builtin_bit_cast(float, w << 16); }
__device__ __forceinline__ float bfhi(unsigned w) { return __builtin_bit_cast(float, w & 0xffff0000u); }
template <int CTRL> __device__ __forceinline__ float dppx(float v) { return __builtin_bit_cast(float, __builtin_amdgcn_update_dpp(0, __builtin_bit_cast(int, v), CTRL, 0xF, 0xF, true)); }
__device__ __forceinline__ float rlane(float v, int l) { return __builtin_bit_cast(float, __builtin_amdgcn_readlane(__builtin_bit_cast(int, v), l)); }
__device__ __forceinline__ float wave_sum(float v) {
    v += dppx<0xB1>(v); v += dppx<0x4E>(v); v += dppx<0x141>(v); v += dppx<0x140>(v);
    return (rlane(v, 0) + rlane(v, 16)) + (rlane(v, 32) + rlane(v, 48));
}
__device__ __forceinline__ float wave_max(float v) {
    v = fmaxf(v, dppx<0xB1>(v)); v = fmaxf(v, dppx<0x4E>(v)); v = fmaxf(v, dppx<0x141>(v)); v = fmaxf(v, dppx<0x140>(v));
    return fmaxf(fmaxf(rlane(v, 0), rlane(v, 16)), fmaxf(rlane(v, 32), rlane(v, 48)));
}
__device__ __forceinline__ float rcp_fast(float x) { return __builtin_amdgcn_rcpf(x); }
__device__ __forceinline__ float sigmoidf_(float x) { return rcp_fast(1.f + __expf(-x)); }
__device__ __forceinline__ float siluf_(float x) { return x * rcp_fast(1.f + __expf(-x)); }
__device__ __forceinline__ float logsigmoidf_(float x) { return fminf(x, 0.f) - log1pf(__expf(-fabsf(x))); }
__device__ __forceinline__ float gelu_tanh(float x) { const float u = 0.7978845608028654f * (x + 0.044715f * x * x * x); const float t = 1.f - 2.f * rcp_fast(__expf(2.f * u) + 1.f); return 0.5f * x * (1.f + t); }
__device__ __forceinline__ float expm1_small(float x) {
    float p = 1.f / 720.f; p = p * x + (1.f / 120.f); p = p * x + (1.f / 24.f); p = p * x + (1.f / 6.f); p = p * x + 0.5f; p = p * x + 1.f; p = p * x;
    if (fabsf(x) > 0.5f) p = expm1f(x);
    return p;
}

__device__ __forceinline__ int seq_row0(int s) { return s < 2 ? s * SEQ : ML + (s - 2) * CTXL; }
__device__ __forceinline__ int seq_len(int s) { return s < 2 ? SEQ : CTXL; }
__device__ __forceinline__ int row_mod(int row) { return row < SEQ ? 0 : (row < ML ? 1 : 2); }
__device__ __forceinline__ int tile_row0(int tt) { return tt < 128 ? tt * 64 : ML + (tt - 128) * 64; }
__device__ __forceinline__ void tile_seq(int tt, int& lo, int& hi) { if (tt < 128) { lo = (tt >> 6) * SEQ; hi = lo + SEQ; } else { lo = ML + ((tt - 128) >> 2) * CTXL; hi = lo + CTXL; } }
struct Frame {
    LAS unsigned char* lds;
    int tid, lane, wave;
    int bid, G;
    unsigned char* ws;
    const float* in[24];
    float* out;
};
#define WSP(T, off) ((T*)(F.ws + (off)))

constexpr float W8_SCALE = 256.f, W8_INV = 1.f / 256.f;
struct TItem { const float* src; unsigned char* dst; int N, pitch; bool ok; };
__device__ __forceinline__ TItem t_make(const float* W, int N, void* WT, int ldk, int k0, int n0, int drow0, int lane, bool f8 = false) {
    const int col = n0 + 4 * (lane & 15), kq = lane >> 4;
    TItem t; t.ok = col < N; t.src = W + (size_t)(k0 + 32 * kq) * N + (t.ok ? col : N - 4); const int es = f8 ? 1 : 2;
    t.dst = (unsigned char*)WT + ((size_t)drow0 * ldk + k0) * es; t.N = N; t.pitch = ldk * es; return t;
}
__device__ __forceinline__ unsigned pk4_fp8(float a, float b, float c, float d) { int w = 0; w = __builtin_amdgcn_cvt_pk_fp8_f32(a, b, w, false); w = __builtin_amdgcn_cvt_pk_fp8_f32(c, d, w, true); return (unsigned)w; }
__device__ __forceinline__ TItem t_decode(Frame& F, int it) {
    constexpr int I0 = 32 * 96, I1 = 32 * 64, I2 = 32 * 193, I3 = 32 * 64, I4 = 32 * 1024, I5 = 32 * 512, I6 = 64 * 2;
    int r = it;
    if (r < I0) { const int kb = r / 96, nb = r % 96; return t_make(F.in[8], DIN0, WSP(bf16, WS_W1T), D, kb * 128, nb * 64, nb * 64, F.lane); } r -= I0;
    if (r < I1) { const int kb = r / 64, nb = r % 64; return t_make(F.in[16], D, WSP(bf16, WS_W2T), D, kb * 128, nb * 64, nb * 64, F.lane); } r -= I1;
    if (r < I2) { const int kb = r / 193, nb = r % 193; return t_make(F.in[17], 12320, WSP(bf16, WS_W3T), D, kb * 128, nb * 64, nb * 64, F.lane); } r -= I2;
    if (r < I3) { const int kb = r / 64, nb = r % 64; return t_make(F.in[20], D, WSP(bf16, WS_W4T), D, kb * 128, nb * 64, nb * 64, F.lane); } r -= I3;
    if (r < I4) { const int mat = r / 1024, q = r % 1024, kb = q / 32, nb = q % 32, n0 = nb * 64;
        const int drow0 = 256 * ((n0 & 1023) >> 7) + 128 * (n0 >> 10) + (n0 & 127);
        return t_make(F.in[22] + (size_t)mat * D * 2048, 2048, WSP(unsigned char, WS_WGU) + (size_t)mat * 2048 * D, D, kb * 128, n0, drow0, F.lane, true); } r -= I4;
    if (r < I5) { const int mat = r / 512, q = r % 512, kb = q / 64, nb = q % 64;
        return t_make(F.in[23] + (size_t)mat * DE * D, D, WSP(unsigned char, WS_WDN) + (size_t)mat * D * DE, DE, kb * 128, nb * 64, nb * 64, F.lane, true); } r -= I5;
    if (r < I6) { const int mat = r / 2, nb = r % 2;
        return t_make(F.in[11] + (size_t)mat * 16384, 128, WSP(bf16, WS_GWT) + (size_t)mat * 16384, 128, 0, nb * 64, nb * 64, F.lane); } r -= I6;
    { const int mat = r / 32, q = r % 32, kb = q / 8, nb = q % 8;
        return t_make(F.in[14] + (size_t)mat * 262144, 512, WSP(bf16, WS_PWT) + (size_t)mat * 262144, 512, kb * 128, nb * 64, nb * 64, F.lane); }
}
constexpr int CV_GU0 = 32 * 96 + 32 * 64 + 32 * 193 + 32 * 64;
constexpr int CV_DOWN0 = CV_GU0 + 32 * 1024, CV_DOWN1 = CV_DOWN0 + 16 * 512, CV_DOWN_END = CV_DOWN1 + 16 * 512;
constexpr int CV_NITEMS = CV_DOWN_END + 64 * 2 + 4 * 32;
template <bool F8> __device__ __forceinline__ void convert_items(Frame& F, int lo, int hi, int skip_lo, int skip_hi, int gw, int NGW, int scr_off) {
    constexpr int P = F8 ? 36 : 68, NST = F8 ? 8 : 16;
    LAS unsigned* scr = (LAS unsigned*)(F.lds + scr_off + F.wave * 17408);
    const int n4 = F.lane & 15, kq = F.lane >> 4;
    const int NITEMS = hi - (skip_hi - skip_lo);
#define CV_MAP(i) ((i) >= skip_lo ? (i) + (skip_hi - skip_lo) : (i))
    f32x4 v[32]; TItem cur, nx; nx.ok = false; nx.src = nullptr; nx.dst = nullptr; nx.N = 0; nx.pitch = 0;
    int it = lo + gw;
    if (it < NITEMS) { cur = t_decode(F, CV_MAP(it));
#pragma unroll
        for (int i = 0; i < 32; ++i) v[i] = __builtin_nontemporal_load((const f32x4*)(cur.src + (size_t)i * cur.N));
        unsigned* dump = WSP(unsigned, WS_DUMP) + (gw & 15) * 1024 + F.lane;
#pragma unroll
        for (int j = 0; j < NST; ++j) dump[j * 64] = 0u; }
    while (it < NITEMS) {
#pragma unroll
        for (int r = 0; r < 4; ++r) {
            LAS unsigned* rp = scr + (4 * n4 + r) * P + (F8 ? 8 : 16) * kq;
#define CV_V(i) (cur.ok ? (r == 0 ? v[i].x : (r == 1 ? v[i].y : (r == 2 ? v[i].z : v[i].w))) : 0.f)
            if constexpr (F8) {
#pragma unroll
                for (int q = 0; q < 2; ++q) { v4u w;
                    w.x = pk4_fp8(CV_V(16 * q + 0) * W8_SCALE, CV_V(16 * q + 1) * W8_SCALE, CV_V(16 * q + 2) * W8_SCALE, CV_V(16 * q + 3) * W8_SCALE);
                    w.y = pk4_fp8(CV_V(16 * q + 4) * W8_SCALE, CV_V(16 * q + 5) * W8_SCALE, CV_V(16 * q + 6) * W8_SCALE, CV_V(16 * q + 7) * W8_SCALE);
                    w.z = pk4_fp8(CV_V(16 * q + 8) * W8_SCALE, CV_V(16 * q + 9) * W8_SCALE, CV_V(16 * q + 10) * W8_SCALE, CV_V(16 * q + 11) * W8_SCALE);
                    w.w = pk4_fp8(CV_V(16 * q + 12) * W8_SCALE, CV_V(16 * q + 13) * W8_SCALE, CV_V(16 * q + 14) * W8_SCALE, CV_V(16 * q + 15) * W8_SCALE);
                    *(LAS v4u*)(rp + 4 * q) = w; }
            } else {
#pragma unroll
                for (int q = 0; q < 4; ++q) { v4u w;
                    w.x = pk2(CV_V(8 * q + 0), CV_V(8 * q + 1)); w.y = pk2(CV_V(8 * q + 2), CV_V(8 * q + 3)); w.z = pk2(CV_V(8 * q + 4), CV_V(8 * q + 5)); w.w = pk2(CV_V(8 * q + 6), CV_V(8 * q + 7));
                    *(LAS v4u*)(rp + 4 * q) = w; }
            }
#undef CV_V
        }
        const int nit = it + NGW;
        if (nit < NITEMS) { nx = t_decode(F, CV_MAP(nit));
#pragma unroll
            for (int i = 0; i < 32; ++i) v[i] = __builtin_nontemporal_load((const f32x4*)(nx.src + (size_t)i * nx.N)); }
        asm volatile("s_waitcnt lgkmcnt(0)" ::: "memory");
        if constexpr (F8) { const int c = F.lane & 7;
#pragma unroll
            for (int j = 0; j < 8; ++j) { const int n = (F.lane >> 3) + 8 * j; const v4u o = *(const LAS v4u*)(scr + n * P + 4 * c);
                __builtin_nontemporal_store(o, (v4u*)(cur.dst + (size_t)n * cur.pitch + 16 * c)); }
        } else { const int c = F.lane & 15;
#pragma unroll
            for (int j = 0; j < 16; ++j) { const int n = (F.lane >> 4) + 4 * j; const v4u o = *(const LAS v4u*)(scr + n * P + 4 * c);
                __builtin_nontemporal_store(o, (v4u*)(cur.dst + (size_t)n * cur.pitch + 16 * c)); }
        }
        asm volatile("s_waitcnt lgkmcnt(0)" ::: "memory");
        cur = nx; it = nit;
    }
#undef CV_MAP
}
__device__ __forceinline__ void p0_convert(Frame& F) {
    convert_items<false>(F, 0, CV_NITEMS, CV_GU0, CV_DOWN_END, F.bid * 8 + F.wave, F.G * 8, 0);
    convert_items<true>(F, CV_GU0, CV_DOWN0, 0, 0, F.bid * 8 + F.wave, F.G * 8, 0);
    const int gt = F.bid * NTHR + F.tid, NGT = F.G * NTHR;
    float* wrt = WSP(float, WS_WRT);
    bf16* wrh = WSP(bf16, WS_WRH); bf16* wrl = WSP(bf16, WS_WRL);
    for (int i = gt; i < 2 * 16 * 4096; i += NGT) { const int l = i >> 16, e = (i >> 12) & 15, k = i & 4095; const float w = F.in[21][(size_t)l * 65536 + k * 16 + e]; wrt[i] = w;
        const unsigned hi = f2bf(w); wrh[i] = (bf16)hi; wrl[i] = (bf16)f2bf(w - bf2f(hi)); }
    float* ls8 = WSP(float, WS_LS8);
    for (int i = gt; i < 2 * DLRU; i += NGT) ls8[i] = 8.0f * logsigmoidf_(F.in[13][i]);
}

__device__ __forceinline__ void p0_adaln(Frame& F) {
    LAS float* sc = (LAS float*)F.lds;
    LAS float* red = (LAS float*)(F.lds + 49152);
    constexpr int NIT = 2 * 384;
    if (F.bid >= NIT) return;
    for (int i = F.tid; i < 3 * D; i += NTHR) { const int r = i >> 12, k = i & 4095; const float v = r < 2 ? F.in[1][r * D + k] : F.in[3][k]; sc[i] = siluf_(v); }
    __syncthreads();
    float* mod = WSP(float, WS_MOD);
    for (int it = F.bid; it < NIT; it += F.G) {
        const int l = it / 384, n0 = (it % 384) * 64;
        const float* W = F.in[4] + (size_t)l * D * 24576 + n0 + F.lane;
        float a0 = 0.f, a1 = 0.f, a2 = 0.f;
        const int kbeg = F.wave * 512;
#pragma unroll 64
        for (int k = kbeg; k < kbeg + 512; ++k) { const float w = __builtin_nontemporal_load(W + (size_t)k * 24576); a0 += sc[k] * w; a1 += sc[D + k] * w; a2 += sc[2 * D + k] * w; }
        red[(F.wave * 3 + 0) * 64 + F.lane] = a0; red[(F.wave * 3 + 1) * 64 + F.lane] = a1; red[(F.wave * 3 + 2) * 64 + F.lane] = a2;
        __syncthreads();
        if (F.tid < 192) { const int r = F.tid >> 6, ln = F.tid & 63; float s = 0.f;
#pragma unroll
            for (int w = 0; w < 8; ++w) s += red[(w * 3 + r) * 64 + ln];
            mod[((size_t)l * 3 + r) * 24576 + n0 + ln] = s + F.in[5][l * 24576 + n0 + ln]; }
        __syncthreads();
    }
}

struct Row8 { f32x4 a[8], b[8]; };
__device__ __forceinline__ void ld_row8(Row8& r, const float* p, int lane) {
#pragma unroll
    for (int j = 0; j < 8; ++j) { const float* q = p + 8 * (lane + 64 * j); r.a[j] = *(const f32x4*)q; r.b[j] = *(const f32x4*)(q + 4); }
}
__device__ __forceinline__ void ld_row8_raw(v4u (&h)[8], const bf16* p, int lane) {
#pragma unroll
    for (int j = 0; j < 8; ++j) h[j] = *(const v4u*)(p + 8 * (lane + 64 * j));
}
__device__ __forceinline__ void row8_from_raw(Row8& r, const v4u (&h)[8]) {
#pragma unroll
    for (int j = 0; j < 8; ++j) { r.a[j] = (f32x4){bflo(h[j].x), bfhi(h[j].x), bflo(h[j].y), bfhi(h[j].y)}; r.b[j] = (f32x4){bflo(h[j].z), bfhi(h[j].z), bflo(h[j].w), bfhi(h[j].w)}; }
}
__device__ __forceinline__ void row8_stats(const Row8& r, float& mean, float& rstd) {
    float s = 0.f;
#pragma unroll
    for (int j = 0; j < 8; ++j) s += ((r.a[j].x + r.a[j].y) + (r.a[j].z + r.a[j].w)) + ((r.b[j].x + r.b[j].y) + (r.b[j].z + r.b[j].w));
    mean = wave_sum(s) * (1.f / D);
    float q = 0.f;
#pragma unroll
    for (int j = 0; j < 8; ++j) { const f32x4 d0 = r.a[j] - mean, d1 = r.b[j] - mean; q += ((d0.x * d0.x + d0.y * d0.y) + (d0.z * d0.z + d0.w * d0.w)) + ((d1.x * d1.x + d1.y * d1.y) + (d1.z * d1.z + d1.w * d1.w)); }
    rstd = 1.f / sqrtf(wave_sum(q) * (1.f / D) + LN_EPS);
}
__device__ __forceinline__ v4u pack8(const f32x4& a, const f32x4& b) { v4u o; o.x = pk2(a.x, a.y); o.y = pk2(a.z, a.w); o.z = pk2(b.x, b.y); o.w = pk2(b.z, b.w); return o; }
__device__ __forceinline__ int group_mod(int g) { return g < 512 ? 0 : (g < 1024 ? 1 : 2); }
__device__ __forceinline__ void stage_vec(LAS float* dst, const float* src, int n, int tid) { for (int i = tid * 4; i < n; i += NTHR * 4) *(LAS f32x4*)(dst + i) = *(const f32x4*)(src + i); }

template <int N> __device__ __forceinline__ void prime_stores(Frame& F) {
    unsigned* dump = WSP(unsigned, WS_DUMP) + F.wave * 2048 + F.lane;
#pragma unroll
    for (int j = 0; j < N; ++j) dump[(j & 31) * 64] = 0u;
}
__device__ __forceinline__ void p1_ln0(Frame& F) {
    bf16* H = WSP(bf16, WS_H); bf16* U = WSP(bf16, WS_U); const float* mod = WSP(float, WS_MOD);
    LAS float* SH = (LAS float*)F.lds; LAS float* SC = SH + D;
    int cur_mod = -1; Row8 cur, nxt;
    { const int g0 = F.bid; if (g0 < MT / 8) { const int row = 8 * g0 + F.wave; ld_row8(cur, row < ML ? F.in[0] + (size_t)row * D : F.in[2] + (size_t)(row - ML) * D, F.lane); prime_stores<16>(F); } }
    for (int g = F.bid; g < MT / 8; g += F.G) {
        const int row = 8 * g + F.wave, mr = group_mod(g);
        if (mr != cur_mod) { __syncthreads(); stage_vec(SH, mod + (size_t)mr * 24576, D, F.tid); stage_vec(SC, mod + (size_t)mr * 24576 + D, D, F.tid); __syncthreads(); cur_mod = mr; }
        const int gn = g + F.G; if (gn < MT / 8) { const int rn = 8 * gn + F.wave; ld_row8(nxt, rn < ML ? F.in[0] + (size_t)rn * D : F.in[2] + (size_t)(rn - ML) * D, F.lane); }
        float mean, rstd; row8_stats(cur, mean, rstd);
#pragma unroll
        for (int j = 0; j < 8; ++j) { const int c = 8 * (F.lane + 64 * j); const f32x4 y0 = (cur.a[j] - mean) * rstd, y1 = (cur.b[j] - mean) * rstd;
            *(v4u*)(H + (size_t)row * D + c) = pack8(y0, y1);
            const f32x4 u0 = y0 * (1.f + *(const LAS f32x4*)(SC + c)) + *(const LAS f32x4*)(SH + c), u1 = y1 * (1.f + *(const LAS f32x4*)(SC + c + 4)) + *(const LAS f32x4*)(SH + c + 4);
            *(v4u*)(U + (size_t)row * D + c) = pack8(u0, u1); }
        cur = nxt;
    }
    __syncthreads();
}

using pg8::Unit;
struct EpiBf16Plain {
    static constexpr bool PERM = true;
    bf16* O; int ldc;
    __device__ __forceinline__ void operator()(const f32x4 (&acc)[2][2][4][2], const Unit& u, int wr, int wc, int fr, int fq) const {
        const int row0 = u.pm * 256 + wr * 64 + fr, col0 = u.pn * 256 + wc * 32 + 8 * fq;
#pragma unroll
        for (int ai = 0; ai < 2; ++ai)
#pragma unroll
            for (int m = 0; m < 4; ++m) { bf16* rowp = O + (size_t)(row0 + ai * 128 + m * 16) * ldc + col0;
#pragma unroll
                for (int bj = 0; bj < 2; ++bj) { const f32x4 v0 = acc[ai][bj][m][0], v1 = acc[ai][bj][m][1];
                    v4u w; w.x = pg8::cvt_pk_bf16(v0[0], v0[1]); w.y = pg8::cvt_pk_bf16(v0[2], v0[3]); w.z = pg8::cvt_pk_bf16(v1[0], v1[1]); w.w = pg8::cvt_pk_bf16(v1[2], v1[3]);
                    *(v4u*)(rowp + bj * 128) = w; } }
    }
};
struct EpiOddIn {
    static constexpr bool PERM = true;
    bf16* O; float* Gt; const float* gb;
    __device__ __forceinline__ void operator()(const f32x4 (&acc)[2][2][4][2], const Unit& u, int wr, int wc, int fr, int fq) const {
        const int row0 = u.pm * 256 + wr * 64 + fr;
        if (u.pn < 48) {
            const int col0 = u.pn * 256 + wc * 32 + 8 * fq;
#pragma unroll
            for (int ai = 0; ai < 2; ++ai)
#pragma unroll
                for (int m = 0; m < 4; ++m) { bf16* rowp = O + (size_t)(row0 + ai * 128 + m * 16) * DIN1 + col0;
#pragma unroll
                    for (int bj = 0; bj < 2; ++bj) { const f32x4 v0 = acc[ai][bj][m][0], v1 = acc[ai][bj][m][1];
                        v4u w; w.x = pg8::cvt_pk_bf16(v0[0], v0[1]); w.y = pg8::cvt_pk_bf16(v0[2], v0[3]); w.z = pg8::cvt_pk_bf16(v1[0], v1[1]); w.w = pg8::cvt_pk_bf16(v1[2], v1[3]);
                        *(v4u*)(rowp + bj * 128) = w; } }
        } else if (wc == 0) {
            const int c0 = 8 * fq; const f32x4 b0 = *(const f32x4*)(gb + c0), b1 = *(const f32x4*)(gb + c0 + 4);
#pragma unroll
            for (int ai = 0; ai < 2; ++ai)
#pragma unroll
                for (int m = 0; m < 4; ++m) { float* rowp = Gt + (size_t)(row0 + ai * 128 + m * 16) * 32 + c0;
                    *(f32x4*)(rowp) = acc[ai][0][m][0] + b0; *(f32x4*)(rowp + 4) = acc[ai][0][m][1] + b1; }
        }
    }
};
struct EpiSlab {
    static constexpr bool PERM = false;
    float* slab; int nS;
    __device__ __forceinline__ void operator()(const f32x4 (&acc)[2][2][4][2], const Unit& u, int wr, int wc, int fr, int fq) const {
        float* base = slab + (size_t)(u.t * nS + u.ks) * 65536 + (wr * 64 + fr) * 256 + wc * 32 + 4 * fq;
#pragma unroll
        for (int ai = 0; ai < 2; ++ai)
#pragma unroll
            for (int m = 0; m < 4; ++m)
#pragma unroll
                for (int bj = 0; bj < 2; ++bj)
#pragma unroll
                    for (int n = 0; n < 2; ++n) *(f32x4*)(base + (ai * 128 + m * 16) * 256 + bj * 128 + n * 16) = acc[ai][bj][m][n];
    }
};
struct EpiResid {
    static constexpr bool PERM = false;
    float* H; const float* modl;
    int goff;
    __device__ __forceinline__ void operator()(const f32x4 (&acc)[2][2][4][2], const Unit& u, int wr, int wc, int fr, int fq) const {
        const int row0 = u.pm * 256 + wr * 64 + fr, col0 = u.pn * 256 + wc * 32 + 4 * fq;
        const float* gv = modl + (size_t)row_mod(u.pm * 256) * 24576 + goff + col0;
        f32x4 g[2][2];
#pragma unroll
        for (int bj = 0; bj < 2; ++bj)
#pragma unroll
            for (int n = 0; n < 2; ++n) g[bj][n] = *(const f32x4*)(gv + bj * 128 + n * 16);
#pragma unroll
        for (int ai = 0; ai < 2; ++ai)
#pragma unroll
            for (int m = 0; m < 4; ++m) { float* rowp = H + (size_t)(row0 + ai * 128 + m * 16) * D + col0;
#pragma unroll
                for (int bj = 0; bj < 2; ++bj)
#pragma unroll
                    for (int n = 0; n < 2; ++n) { const f32x4 h = *(const f32x4*)(rowp + bj * 128 + n * 16); *(f32x4*)(rowp + bj * 128 + n * 16) = DN_ALPHA * h + g[bj][n] * acc[ai][bj][m][n]; }
                asm volatile("" ::: "memory"); }
    }
};
struct EpiPool {
    static constexpr bool PERM = true;
    bf16* A2; const float* ps;
    __device__ __forceinline__ void operator()(const f32x4 (&acc)[2][2][4][2], const Unit& u, int wr, int wc, int fr, int fq) const {
        const int row0 = u.pm * 256 + wr * 64 + fr, col0 = 512 * u.g + u.pn * 256 + wc * 32 + 8 * fq;
#pragma unroll
        for (int ai = 0; ai < 2; ++ai)
#pragma unroll
            for (int m = 0; m < 4; ++m) { bf16* rowp = A2 + (size_t)(row0 + ai * 128 + m * 16) * D + 2048 + col0;
#pragma unroll
                for (int bj = 0; bj < 2; ++bj) { const f32x4 s0 = *(const f32x4*)(ps + col0 + bj * 128), s1 = *(const f32x4*)(ps + col0 + bj * 128 + 4);
                    const f32x4 v0 = acc[ai][bj][m][0] * s0, v1 = acc[ai][bj][m][1] * s1;
                    v4u w; w.x = pg8::cvt_pk_bf16(v0[0], v0[1]); w.y = pg8::cvt_pk_bf16(v0[2], v0[3]); w.z = pg8::cvt_pk_bf16(v1[0], v1[1]); w.w = pg8::cvt_pk_bf16(v1[2], v1[3]);
                    *(v4u*)(rowp + bj * 128) = w; } }
    }
};
struct EpiGU {
    static constexpr bool PERM = true;
    unsigned char* ACT; int er;
    __device__ __forceinline__ void operator()(const f32x4 (&acc)[2][2][4][2], const Unit& u, int wr, int wc, int fr, int fq) const {
        const int row0 = u.pm * 256 + wr * 64 + fr, col0 = u.pn * 128 + wc * 32 + 8 * fq;
        unsigned char* base = ACT + (size_t)u.g * er * DE;
#pragma unroll
        for (int ai = 0; ai < 2; ++ai)
#pragma unroll
            for (int m = 0; m < 4; ++m) { unsigned char* rowp = base + (size_t)(row0 + ai * 128 + m * 16) * DE + col0;
                f32x4 v0, v1;
#pragma unroll
                for (int j = 0; j < 4; ++j) { v0[j] = siluf_(acc[ai][0][m][0][j] * W8_INV) * (acc[ai][1][m][0][j] * W8_INV); v1[j] = siluf_(acc[ai][0][m][1][j] * W8_INV) * (acc[ai][1][m][1][j] * W8_INV); }
                v2u w; w.x = pk4_fp8(v0[0], v0[1], v0[2], v0[3]); w.y = pk4_fp8(v1[0], v1[1], v1[2], v1[3]);
                *(v2u*)(rowp) = w; }
    }
};
struct EpiDown {
    static constexpr bool PERM = true;
    bf16* YE; const float* GX; int er;
    __device__ __forceinline__ void operator()(const f32x4 (&acc)[2][2][4][2], const Unit& u, int wr, int wc, int fr, int fq) const {
        const int row0 = u.pm * 256 + wr * 64 + fr, col0 = u.pn * 256 + wc * 32 + 8 * fq;
        bf16* base = YE + (size_t)u.g * er * D; const float* gx = GX + u.g * er;
#pragma unroll
        for (int ai = 0; ai < 2; ++ai)
#pragma unroll
            for (int m = 0; m < 4; ++m) { const int row = row0 + ai * 128 + m * 16; const float s = gx[row] * W8_INV; bf16* rowp = base + (size_t)row * D + col0;
#pragma unroll
                for (int bj = 0; bj < 2; ++bj) { const f32x4 v0 = acc[ai][bj][m][0] * s, v1 = acc[ai][bj][m][1] * s;
                    v4u w; w.x = pg8::cvt_pk_bf16(v0[0], v0[1]); w.y = pg8::cvt_pk_bf16(v0[2], v0[3]); w.z = pg8::cvt_pk_bf16(v1[0], v1[1]); w.w = pg8::cvt_pk_bf16(v1[2], v1[3]);
                    *(v4u*)(rowp + bj * 128) = w; } }
    }
};
constexpr int LRU_XC = 0, LRU_AF = 17408, LRU_BF = 50176, LRU_SG = 82944, LRU_XT = 87040, LRU_CW = 105472;
constexpr size_t WS_LS = WS_XE, WS_LPF = WS_XE + (size_t)MT * DLRU * 2, WS_LPB = WS_XE + (size_t)MT * DLRU * 4;
#ifndef RSEL
#define RSEL 0
#endif
#define RT4(k) do { if (RSEL) { const unsigned long long tn_ = __builtin_amdgcn_s_memrealtime(); if (RSEL == (k)) *racc += tn_ - rprev; rprev = tn_; } } while (0)
__device__ __forceinline__ void lru_phase(Frame& F, unsigned long long* racc = nullptr) {
    unsigned long long rprev = RSEL ? __builtin_amdgcn_s_memrealtime() : 0ull;
    const bf16* XZS = WSP(bf16, WS_BIG);
    const bf16* GWT = WSP(bf16, WS_GWT);
    const float* LS8 = WSP(float, WS_LS8);
    float* SUMM = WSP(float, WS_SUMM);
    bf16* LSb = WSP(bf16, WS_LS); bf16* LPF = WSP(bf16, WS_LPF); bf16* LPB = WSP(bf16, WS_LPB);
    const float* convw = F.in[9]; const float* convb = F.in[10]; const float* gateb = F.in[12];
    const int wr = F.wave >> 2, wc = F.wave & 3, fr = F.lane & 15, fq = F.lane >> 4;
    LAS unsigned char* XC = F.lds + LRU_XC; LAS float* AF = (LAS float*)(F.lds + LRU_AF); LAS float* BF = (LAS float*)(F.lds + LRU_BF); LAS float* SG = (LAS float*)(F.lds + LRU_SG); LAS unsigned char* XT = F.lds + LRU_XT; LAS float* CW = (LAS float*)(F.lds + LRU_CW);
    const bool hfixed = (F.G & 15) == 0;
#pragma unroll 1
    for (int d = 0; d < 2; ++d) {
        bf16x8 bfr[2][2][4];
        f32x4 gb0[2], gb1[2], l8[2];
        int hcur = -1;
        v4u xpre[3];
#define LRU_XLOAD(u_) do { const int tt_ = (u_) >> 4, h_ = (u_) & 15, r0_ = tile_row0(tt_); int lo_, hi_; tile_seq(tt_, lo_, hi_); \
            _Pragma("unroll") for (int i = 0; i < 3; ++i) { const int q = F.tid + NTHR * i, row = r0_ - 1 + (q >> 4); const bool ok = q < 67 * 16 && row >= lo_ && row < hi_; \
                const v4u xv_ = *(const v4u*)(XZS + (size_t)(ok ? row : r0_) * DIN0 + h_ * 128 + (q & 15) * 8); xpre[i] = ok ? xv_ : (v4u){0u, 0u, 0u, 0u}; } } while (0)
        for (int unit = F.bid; unit < NT_TILES * LRUH; unit += F.G) {
            const int tt = unit >> 4, h = unit & 15;
            const int r0 = tile_row0(tt); int slo, shi; tile_seq(tt, slo, shi);
            if (h != hcur) {
                hcur = h;
                __syncthreads();
                for (int i = F.tid; i < 640; i += NTHR) CW[i] = i < 512 ? convw[(i >> 7) * DLRU + h * 128 + (i & 127)] : convb[h * 128 + (i - 512)];
#pragma unroll
                for (int g = 0; g < 2; ++g)
#pragma unroll
                    for (int n = 0; n < 2; ++n)
#pragma unroll
                        for (int ks = 0; ks < 4; ++ks) bfr[g][n][ks] = *(const bf16x8*)(GWT + (size_t)((d * 2 + g) * 16 + h) * 16384 + (32 * wc + 16 * n + fr) * 128 + ks * 32 + fq * 8);
#pragma unroll
                for (int n = 0; n < 2; ++n) { const int ch = h * 128 + 32 * wc + 16 * n + 4 * fq;
                    gb0[n] = *(const f32x4*)(gateb + (d * 2 + 0) * DLRU + ch); gb1[n] = *(const f32x4*)(gateb + (d * 2 + 1) * DLRU + ch); l8[n] = *(const f32x4*)(LS8 + d * DLRU + ch); }
            }
            if (unit == F.bid) { LRU_XLOAD(unit); }
#pragma unroll
            for (int i = 0; i < 3; ++i) { const int q = F.tid + NTHR * i; if (q < 67 * 16) *(LAS v4u*)(XT + (q >> 4) * 272 + (q & 15) * 16) = xpre[i]; }
            __syncthreads();
            if (unit + F.G < NT_TILES * LRUH) { LRU_XLOAD(unit + F.G); }
            f32x4 xcv[2][2];
#pragma unroll
            for (int m = 0; m < 2; ++m)
#pragma unroll
                for (int n = 0; n < 2; ++n) {
                    const int t = 32 * wr + 16 * m + fr, c = 32 * wc + 16 * n + 4 * fq;
                    f32x4 a = *(const LAS f32x4*)(CW + 512 + c);
#pragma unroll
                    for (int j = 0; j < 4; ++j) { const v2u xv = *(const LAS v2u*)(XT + (t + j) * 272 + c * 2); const f32x4 w = *(const LAS f32x4*)(CW + j * 128 + c);
                        a.x += w.x * bflo(xv.x); a.y += w.y * bfhi(xv.x); a.z += w.z * bflo(xv.y); a.w += w.w * bfhi(xv.y); }
                    xcv[m][n] = a;
                    v2u o; o.x = pk2(a.x, a.y); o.y = pk2(a.z, a.w); *(LAS v2u*)(XC + t * 272 + c * 2) = o;
                }
            __syncthreads();
            RT4(12);
            f32x4 acc[2][2][2];
#pragma unroll
            for (int g = 0; g < 2; ++g)
#pragma unroll
                for (int m = 0; m < 2; ++m)
#pragma unroll
                    for (int n = 0; n < 2; ++n) acc[g][m][n] = (f32x4){0.f, 0.f, 0.f, 0.f};
#pragma unroll
            for (int ks = 0; ks < 4; ++ks) {
                bf16x8 af[2];
#pragma unroll
                for (int m = 0; m < 2; ++m) af[m] = *(const LAS bf16x8*)(XC + (32 * wr + 16 * m + fr) * 272 + (ks * 32 + fq * 8) * 2);
#pragma unroll
                for (int g = 0; g < 2; ++g)
#pragma unroll
                    for (int n = 0; n < 2; ++n)
#pragma unroll
                        for (int m = 0; m < 2; ++m) acc[g][m][n] = __builtin_amdgcn_mfma_f32_16x16x32_bf16(bfr[g][n][ks], af[m], acc[g][m][n], 0, 0, 0);
            }
#pragma unroll
            for (int m = 0; m < 2; ++m)
#pragma unroll
                for (int n = 0; n < 2; ++n) {
                    const int t = 32 * wr + 16 * m + fr, c = 32 * wc + 16 * n + 4 * fq;
                    f32x4 av, bv;
#pragma unroll
                    for (int j = 0; j < 4; ++j) { const float r = sigmoidf_(acc[0][m][n][j] + gb0[n][j]), ig = sigmoidf_(acc[1][m][n][j] + gb1[n][j]);
                        const float la = l8[n][j] * r, em1 = expm1_small(la); av[j] = 1.f + em1; bv[j] = __builtin_amdgcn_sqrtf(-em1 * (2.f + em1)) * ig * xcv[m][n][j]; }
                    *(LAS f32x4*)(AF + t * 128 + c) = av; *(LAS f32x4*)(BF + t * 128 + c) = bv;
                }
            __syncthreads();
            RT4(13);
            {
                const int c = F.tid & 127, seg = F.tid >> 7, ch = h * 128 + c;
                const int tb = d == 0 ? 16 * seg : 16 * seg + 15, ts = d == 0 ? 1 : -1;
                float hs = 0.f, P = 1.f;
#pragma unroll
                for (int i = 0; i < 16; ++i) { const int t = tb + ts * i; const float a = AF[t * 128 + c]; hs = a * hs + BF[t * 128 + c]; P *= a; }
                SG[(seg * 2 + 0) * 128 + c] = P; SG[(seg * 2 + 1) * 128 + c] = hs;
                __syncthreads();
                float Pin = 1.f, Hin = 0.f;
#pragma unroll
                for (int q = 0; q < 3; ++q) { const int sgi = d == 0 ? q : 3 - q; const bool before = d == 0 ? (sgi < seg) : (sgi > seg);
                    if (before) { const float Pq = SG[(sgi * 2 + 0) * 128 + c]; Hin = Pq * Hin + SG[(sgi * 2 + 1) * 128 + c]; Pin *= Pq; } }
                hs = Hin; P = Pin;
#pragma unroll
                for (int i = 0; i < 16; ++i) { const int t = tb + ts * i; const float a = AF[t * 128 + c]; hs = a * hs + BF[t * 128 + c]; P *= a; AF[t * 128 + c] = P; BF[t * 128 + c] = hs; }
                if (seg == (d == 0 ? 3 : 0)) { SUMM[((size_t)(tt * 2 + d) * 2 + 0) * DLRU + ch] = P; SUMM[((size_t)(tt * 2 + d) * 2 + 1) * DLRU + ch] = hs; }
            }
            __syncthreads();
            RT4(14);
            {
                const int et = F.tid >> 3, ecg = (F.tid & 7) * 16;
                const size_t go = (size_t)(r0 + et) * DLRU + h * 128 + ecg; f32x4 pv[4], hv[4];
#pragma unroll
                for (int i = 0; i < 4; ++i) { pv[i] = *(const LAS f32x4*)(AF + et * 128 + ecg + 4 * i); hv[i] = *(const LAS f32x4*)(BF + et * 128 + ecg + 4 * i); }
                bf16* pdst = d == 0 ? LPF : LPB;
                *(v4u*)(pdst + go) = pack8(pv[0], pv[1]); *(v4u*)(pdst + go + 8) = pack8(pv[2], pv[3]);
                if (d == 1) { const v4u f0 = *(const v4u*)(LSb + go), f1 = *(const v4u*)(LSb + go + 8);
                    hv[0] += (f32x4){bflo(f0.x), bfhi(f0.x), bflo(f0.y), bfhi(f0.y)}; hv[1] += (f32x4){bflo(f0.z), bfhi(f0.z), bflo(f0.w), bfhi(f0.w)};
                    hv[2] += (f32x4){bflo(f1.x), bfhi(f1.x), bflo(f1.y), bfhi(f1.y)}; hv[3] += (f32x4){bflo(f1.z), bfhi(f1.z), bflo(f1.w), bfhi(f1.w)}; }
                *(v4u*)(LSb + go) = pack8(hv[0], hv[1]); *(v4u*)(LSb + go + 8) = pack8(hv[2], hv[3]);
            }
            __syncthreads();
            RT4(15);
        }
        asm volatile("s_waitcnt vmcnt(0)" ::: "memory");
#undef LRU_XLOAD
    }
}
__device__ __forceinline__ void lru_apply(Frame& F) {
    const bf16* XZS = WSP(bf16, WS_BIG); const float* CARRY = WSP(float, WS_CARRY); bf16* A2 = WSP(bf16, WS_A2);
    const bf16* LSb = WSP(bf16, WS_LS); const bf16* LPF = WSP(bf16, WS_LPF); const bf16* LPB = WSP(bf16, WS_LPB);
    const int gt = F.bid * NTHR + F.tid, NGT = F.G * NTHR;
    for (int i = gt; i < MT * (DLRU / 8); i += NGT) {
        const int row = i >> 8, c = (i & 255) * 8; const int tt = row < ML ? (row >> 6) : 128 + ((row - ML) >> 6);
        const size_t go = (size_t)row * DLRU + c;
        const v4u sv = *(const v4u*)(LSb + go), pf = *(const v4u*)(LPF + go), pb = *(const v4u*)(LPB + go), zv = *(const v4u*)(XZS + (size_t)row * DIN0 + DLRU + c);
        const f32x4 cf0 = *(const f32x4*)(CARRY + (size_t)(tt * 2 + 0) * DLRU + c), cf1 = *(const f32x4*)(CARRY + (size_t)(tt * 2 + 0) * DLRU + c + 4);
        const f32x4 cb0 = *(const f32x4*)(CARRY + (size_t)(tt * 2 + 1) * DLRU + c), cb1 = *(const f32x4*)(CARRY + (size_t)(tt * 2 + 1) * DLRU + c + 4);
        v4u o;
#pragma unroll
        for (int k = 0; k < 4; ++k) { const float fa = k < 2 ? cf0[2 * k] : cf1[2 * k - 4], fb = k < 2 ? cf0[2 * k + 1] : cf1[2 * k - 3], ba = k < 2 ? cb0[2 * k] : cb1[2 * k - 4], bb = k < 2 ? cb0[2 * k + 1] : cb1[2 * k - 3];
            const float v0 = (bflo(sv[k]) + bflo(pf[k]) * fa + bflo(pb[k]) * ba) * gelu_tanh(bflo(zv[k])), v1 = (bfhi(sv[k]) + bfhi(pf[k]) * fb + bfhi(pb[k]) * bb) * gelu_tanh(bfhi(zv[k]));
            o[k] = pk2(v0, v1); }
        *(v4u*)(A2 + (size_t)row * D + c) = o;
    }
}

__device__ __forceinline__ void lru_carry(Frame& F) {
    const float* SUMM = WSP(float, WS_SUMM); float* CARRY = WSP(float, WS_CARRY);
    const int gt = F.bid * NTHR + F.tid, NGT = F.G * NTHR;
    for (int i = gt; i < NB * 2 * DLRU; i += NGT) {
        const int ch = i & 2047, d = (i >> 11) & 1, b = i >> 12;
        float st = 0.f;
#pragma unroll 1
        for (int half = 0; half < 2; ++half) {
            float Pv[34], Hv[34];
#pragma unroll
            for (int q = 0; q < 34; ++q) { const int s = half * 34 + q; const int tt = s < 4 ? 128 + 4 * b + (d ? 3 - s : s) : 64 * b + (d ? 63 - (s - 4) : (s - 4));
                Pv[q] = SUMM[((size_t)(tt * 2 + d) * 2 + 0) * DLRU + ch]; Hv[q] = SUMM[((size_t)(tt * 2 + d) * 2 + 1) * DLRU + ch]; }
#pragma unroll
            for (int q = 0; q < 34; ++q) { const int s = half * 34 + q; const int tt = s < 4 ? 128 + 4 * b + (d ? 3 - s : s) : 64 * b + (d ? 63 - (s - 4) : (s - 4));
                CARRY[(size_t)(tt * 2 + d) * DLRU + ch] = st; st = Pv[q] * st + Hv[q]; }
        }
    }
}

__device__ __forceinline__ int pool_w_of(int g) { return 2 << g; }
__device__ __forceinline__ void pool_pass1(Frame& F) {
    const bf16* XZS = WSP(bf16, WS_BIG); float* CM = WSP(float, WS_CM);
    LAS unsigned char* T = F.lds;
    for (int unit = F.bid; unit < NB * 64 * 4; unit += F.G) {
        const int g = unit & 3, gr = (unit >> 2) & 63, b = unit >> 8; const int row0 = b * SEQ + gr * 64, w = pool_w_of(g);
        for (int i = F.tid; i < 64 * 64; i += NTHR) { const int r = i >> 6, cseg = i & 63;
            *(LAS v4u*)(T + r * 1024 + cseg * 16) = *(const v4u*)(XZS + (size_t)(row0 + r) * DIN0 + 2 * DLRU + g * 512 + cseg * 8); }
        __syncthreads();
        const int c8 = (F.tid & 63) * 8, part = F.tid >> 6;
#pragma unroll 2
        for (int j = part * 8; j < part * 8 + 8; ++j) {
            const int lo = max(0, j - w / 2), hi = min(64, j + w - w / 2);
            f32x4 s0 = (f32x4){0.f, 0.f, 0.f, 0.f}, s1 = s0;
            for (int q = lo; q < hi; ++q) { const v4u v = *(const LAS v4u*)(T + q * 1024 + c8 * 2);
                s0 += (f32x4){bflo(v.x), bfhi(v.x), bflo(v.y), bfhi(v.y)}; s1 += (f32x4){bflo(v.z), bfhi(v.z), bflo(v.w), bfhi(v.w)}; }
            const float inv = 1.f / (float)(hi - lo);
            float* cp_ = CM + (size_t)(row0 + j) * DPOOL + g * 512 + c8;
            *(f32x4*)cp_ = s0 * inv; *(f32x4*)(cp_ + 4) = s1 * inv;
        }
        __syncthreads();
    }
}
__device__ __forceinline__ void pool_pass2(Frame& F) {
    const bf16* XZS = WSP(bf16, WS_BIG); const float* CM = WSP(float, WS_CM); bf16* DP = WSP(bf16, WS_DP);
    LAS float* T = (LAS float*)F.lds;
    for (int unit = F.bid; unit < NB * 64 * 4 * 2; unit += F.G) {
        const int hc = unit & 1, g = (unit >> 1) & 3, gc = (unit >> 3) & 63, b = unit >> 9; const int w = pool_w_of(g), cb = g * 512 + hc * 256;
        for (int i = F.tid; i < 64 * 64; i += NTHR) { const int r = i >> 6, cseg = i & 63;
            *(LAS f32x4*)(T + r * 256 + cseg * 4) = *(const f32x4*)(CM + (size_t)(b * SEQ + r * 64 + gc) * DPOOL + cb + cseg * 4); }
        __syncthreads();
        const int c4 = (F.tid & 63) * 4, part = F.tid >> 6;
        v2u xs[8];
#pragma unroll
        for (int q = 0; q < 8; ++q) xs[q] = *(const v2u*)(XZS + (size_t)(b * SEQ + (part * 8 + q) * 64 + gc) * DIN0 + 2 * DLRU + cb + c4);
#pragma unroll
        for (int q = 0; q < 8; ++q) { const int r = part * 8 + q;
            const int lo = max(0, r - w / 2), hi = min(64, r + w - w / 2);
            f32x4 sm = (f32x4){0.f, 0.f, 0.f, 0.f};
            for (int k = lo; k < hi; ++k) sm += *(const LAS f32x4*)(T + k * 256 + c4);
            const float inv = 1.f / (float)(hi - lo);
            v2u o; o.x = pk2(sm.x * inv - bflo(xs[q].x), sm.y * inv - bfhi(xs[q].x)); o.y = pk2(sm.z * inv - bflo(xs[q].y), sm.w * inv - bfhi(xs[q].y));
            *(v2u*)(DP + (size_t)(b * SEQ + r * 64 + gc) * DPOOL + cb + c4) = o;
        }
        __syncthreads();
    }
}
__device__ __forceinline__ void pool_ctx(Frame& F) {
    const bf16* XZS = WSP(bf16, WS_BIG); bf16* DP = WSP(bf16, WS_DP);
    const int gt = F.bid * NTHR + F.tid, NGT = F.G * NTHR;
    for (int i = gt; i < MC * (DPOOL / 8); i += NGT) {
        const int ch = (i & 255) * 8, r = i >> 8, b = r >> 8, t = r & 255; const int w = pool_w_of(ch >> 9);
        const int lo = max(0, t - w / 2), hi = min(CTXL, t + w - w / 2);
        v4u v[16];
#pragma unroll
        for (int q = 0; q < 16; ++q) { const int k = min(lo + q, CTXL - 1); v[q] = *(const v4u*)(XZS + (size_t)(ML + b * CTXL + k) * DIN0 + 2 * DLRU + ch); }
        const v4u x = *(const v4u*)(XZS + (size_t)(ML + r) * DIN0 + 2 * DLRU + ch);
        f32x4 s0 = (f32x4){0.f, 0.f, 0.f, 0.f}, s1 = s0;
#pragma unroll
        for (int q = 0; q < 16; ++q) { const float m = (lo + q < hi) ? 1.f : 0.f;
            s0 += m * (f32x4){bflo(v[q].x), bfhi(v[q].x), bflo(v[q].y), bfhi(v[q].y)}; s1 += m * (f32x4){bflo(v[q].z), bfhi(v[q].z), bflo(v[q].w), bfhi(v[q].w)}; }
        const float inv = 1.f / (float)(hi - lo);
        const f32x4 o0 = s0 * inv - (f32x4){bflo(x.x), bfhi(x.x), bflo(x.y), bfhi(x.y)}, o1 = s1 * inv - (f32x4){bflo(x.z), bfhi(x.z), bflo(x.w), bfhi(x.w)};
        *(v4u*)(DP + (size_t)(ML + r) * DPOOL + ch) = pack8(o0, o1);
    }
}
#ifndef RSEL
#define RSEL 0
#endif
#define RT(k) do { if (RSEL) { const unsigned long long tn_ = __builtin_amdgcn_s_memrealtime(); if (RSEL == (k)) *racc += tn_ - rprev; rprev = tn_; } } while (0)
__device__ __forceinline__ void ln_router_phase(Frame& F, int l, int nrows, bool probe = false, bool ctx_slab = false, unsigned long long* racc = nullptr) {
    unsigned char* U8 = probe ? WSP(unsigned char, WS_CM) : WSP(unsigned char, WS_U8);
    const bf16* Ymix = WSP(bf16, WS_YE);
    unsigned long long rprev = RSEL ? __builtin_amdgcn_s_memrealtime() : 0ull;
    const bf16* Hin = WSP(bf16, WS_H); bf16* H = probe ? WSP(bf16, WS_XE) : WSP(bf16, WS_H); bf16* U = probe ? WSP(bf16, WS_YE) : WSP(bf16, WS_U); const float* mod = WSP(float, WS_MOD) + (size_t)l * 3 * 24576;
    const f32x4* wrt4 = (const f32x4*)(WSP(float, WS_WRT) + (size_t)l * 16 * D); float* AFF = probe ? WSP(float, WS_CM) : WSP(float, WS_AFF);
    LAS float* LG = (LAS float*)F.lds; LAS float* LB = LG + D; LAS float* SH = LG + 2 * D; LAS float* SC = LG + 3 * D; LAS unsigned char* UH = F.lds + 65536; LAS unsigned char* UL = F.lds + 65536 + 32896; LAS float* RED = (LAS float*)(F.lds + 65536 + 65792);
    const bf16* wrh = WSP(bf16, WS_WRH) + (size_t)l * 16 * D; const bf16* wrl = WSP(bf16, WS_WRL) + (size_t)l * 16 * D;
    const int ngroups = nrows / 8;
    stage_vec(LG, F.in[6] + (size_t)(l * 2 + 0) * D, D, F.tid); stage_vec(LB, F.in[7] + (size_t)(l * 2 + 0) * D, D, F.tid);
    if (ctx_slab) {
        const float* slab = WSP(float, WS_SLAB); const float* gv = mod + (size_t)2 * 24576 + 2 * D; bf16* Hw = WSP(bf16, WS_H);
        for (int g = 1024 + (F.bid + F.G - 1024 % F.G) % F.G; g < ngroups; g += F.G) { const int row = 8 * g + F.wave, r = row - ML;
#pragma unroll 1
            for (int j = 0; j < 8; ++j) { const int c = 8 * (F.lane + 64 * j); const float* sp = slab + (size_t)(((r >> 8) + 2 * (c >> 8)) * 8) * 65536 + (r & 255) * 256 + (c & 255);
                f32x4 s0 = (f32x4){0.f, 0.f, 0.f, 0.f}, s1 = s0;
#pragma unroll
                for (int ks = 0; ks < 8; ++ks) { s0 += *(const f32x4*)(sp + (size_t)ks * 65536); s1 += *(const f32x4*)(sp + (size_t)ks * 65536 + 4); }
                bf16* hp = Hw + (size_t)row * D + c; const v4u hv = *(const v4u*)hp;
                const f32x4 t0 = DN_ALPHA * (f32x4){bflo(hv.x), bfhi(hv.x), bflo(hv.y), bfhi(hv.y)} + *(const f32x4*)(gv + c) * s0, t1 = DN_ALPHA * (f32x4){bflo(hv.z), bfhi(hv.z), bflo(hv.w), bfhi(hv.w)} + *(const f32x4*)(gv + c + 4) * s1;
                *(v4u*)hp = pack8(t0, t1); }
        }
        asm volatile("s_waitcnt vmcnt(0)" ::: "memory");
    }
    int cur_mod = -1; Row8 cur; v4u yrow[8], hraw[8];
#define LNR_LOAD(g_) do { const int row_ = 8 * (g_) + F.wave; ld_row8_raw(hraw, Hin + (size_t)row_ * D, F.lane); { const size_t yr_ = (size_t)((g_) < 1024 ? row_ : 0) * D; _Pragma("unroll") for (int j_ = 0; j_ < 8; ++j_) yrow[j_] = *(const v4u*)(Ymix + yr_ + 8 * (F.lane + 64 * j_)); } } while (0)
    const bool rebal = ctx_slab && F.G == 256 && ngroups == 1088;
#define LNR_GRP(i_) (!rebal ? (F.bid + (i_) * F.G < ngroups ? F.bid + (i_) * F.G : -1) \
        : ((i_) < (F.bid < 64 ? 3 : 4) ? F.bid + 256 * (i_) : ((i_) > (F.bid < 64 ? 3 : 4) ? -1 : (F.bid < 64 ? 1024 + F.bid : (F.bid < 128 ? F.bid + 704 : -1)))))
    int gcur = LNR_GRP(0);
    if (gcur >= 0) { LNR_LOAD(gcur); }
    for (int it = 0; gcur >= 0; ++it) {
        const int g = gcur, gnx = LNR_GRP(it + 1);
        const int row = 8 * g + F.wave, mr = group_mod(g);
        if (mr != cur_mod) { __syncthreads(); stage_vec(SH, mod + (size_t)mr * 24576 + 3 * D, D, F.tid); stage_vec(SC, mod + (size_t)mr * 24576 + 4 * D, D, F.tid); cur_mod = mr; }
        __syncthreads();
        RT(4);
        row8_from_raw(cur, hraw);
        if (g < 1024) {
            const float* gv = mod + (size_t)mr * 24576 + 2 * D;
#pragma unroll
            for (int j = 0; j < 8; ++j) { const int c = 8 * (F.lane + 64 * j); const f32x4 g0 = *(const f32x4*)(gv + c), g1 = *(const f32x4*)(gv + c + 4); const v4u y = yrow[j];
                cur.a[j] = DN_ALPHA * cur.a[j] + g0 * (f32x4){bflo(y.x), bfhi(y.x), bflo(y.y), bfhi(y.y)}; cur.b[j] = DN_ALPHA * cur.b[j] + g1 * (f32x4){bflo(y.z), bfhi(y.z), bflo(y.w), bfhi(y.w)}; if (j & 1) asm volatile("" ::: "memory"); }
        }
        float mean, rstd; row8_stats(cur, mean, rstd);
#pragma unroll
        for (int j = 0; j < 8; ++j) { const int c = 8 * (F.lane + 64 * j);
            const f32x4 y0 = (cur.a[j] - mean) * rstd * *(const LAS f32x4*)(LG + c) + *(const LAS f32x4*)(LB + c), y1 = (cur.b[j] - mean) * rstd * *(const LAS f32x4*)(LG + c + 4) + *(const LAS f32x4*)(LB + c + 4);
            *(v4u*)(H + (size_t)row * D + c) = pack8(y0, y1);
            const f32x4 u0 = y0 * (1.f + *(const LAS f32x4*)(SC + c)) + *(const LAS f32x4*)(SH + c), u1 = y1 * (1.f + *(const LAS f32x4*)(SC + c + 4)) + *(const LAS f32x4*)(SH + c + 4);
            { v2u w8; w8.x = pk4_fp8(u0.x, u0.y, u0.z, u0.w); w8.y = pk4_fp8(u1.x, u1.y, u1.z, u1.w); *(v2u*)(U8 + (size_t)row * D + c) = w8; }
            cur.a[j] = u0; cur.b[j] = u1; }
        RT(1);
        f32x4 racc4 = (f32x4){0.f, 0.f, 0.f, 0.f};
        const int fr = F.lane & 15, fq = F.lane >> 4;
        int opq = 0; asm volatile("" : "+v"(opq));
#pragma unroll
        for (int half = 0; half < 2; ++half) {
            bf16x8 bh[8], bl[8];
#pragma unroll
            for (int ks = 0; ks < 8; ++ks) { const size_t wo = (size_t)(fr * D + 2048 * half + 256 * F.wave + 32 * ks + 8 * fq + opq); bh[ks] = *(const bf16x8*)(wrh + wo); bl[ks] = *(const bf16x8*)(wrl + wo); }
            __syncthreads();
#pragma unroll
            for (int jj = 0; jj < 4; ++jj) { const int j = 4 * half + jj; const f32x4 xa = cur.a[j], xb = cur.b[j];
                const unsigned h0 = pg8::cvt_pk_bf16(xa.x, xa.y), h1 = pg8::cvt_pk_bf16(xa.z, xa.w), h2 = pg8::cvt_pk_bf16(xb.x, xb.y), h3 = pg8::cvt_pk_bf16(xb.z, xb.w);
                v4u hv; hv.x = h0; hv.y = h1; hv.z = h2; hv.w = h3;
                v4u lv; lv.x = pg8::cvt_pk_bf16(xa.x - bflo(h0), xa.y - bfhi(h0)); lv.y = pg8::cvt_pk_bf16(xa.z - bflo(h1), xa.w - bfhi(h1)); lv.z = pg8::cvt_pk_bf16(xb.x - bflo(h2), xb.y - bfhi(h2)); lv.w = pg8::cvt_pk_bf16(xb.z - bflo(h3), xb.w - bfhi(h3));
                const int co = F.wave * 4112 + (8 * (F.lane + 64 * jj)) * 2;
                *(LAS v4u*)(UH + co) = hv; *(LAS v4u*)(UL + co) = lv; }
            __syncthreads();
#pragma unroll
            for (int ks = 0; ks < 8; ++ks) { const int ao = (fr & 7) * 4112 + (256 * F.wave + 32 * ks + 8 * fq) * 2;
                const bf16x8 ah = *(const LAS bf16x8*)(UH + ao), al = *(const LAS bf16x8*)(UL + ao);
                racc4 = __builtin_amdgcn_mfma_f32_16x16x32_bf16(ah, bh[ks], racc4, 0, 0, 0);
                racc4 = __builtin_amdgcn_mfma_f32_16x16x32_bf16(al, bh[ks], racc4, 0, 0, 0);
                racc4 = __builtin_amdgcn_mfma_f32_16x16x32_bf16(ah, bl[ks], racc4, 0, 0, 0); }
        }
        if (fq < 2) {
#pragma unroll
            for (int j = 0; j < 4; ++j) RED[(F.wave * 8 + 4 * fq + j) * 16 + fr] = racc4[j]; }
        __syncthreads();
        float mylogit = 0.f;
        if (F.lane < 16) {
#pragma unroll
            for (int w = 0; w < 8; ++w) mylogit += RED[(w * 8 + F.wave) * 16 + F.lane]; }
        if (gnx >= 0) { LNR_LOAD(gnx); }
        RT(2);
        float v = F.lane < 16 ? mylogit : -3.0e38f;
        const float mx = wave_max(v); const float ex = F.lane < 16 ? __expf(v - mx) : 0.f; const float den = wave_sum(ex);
        if (F.lane < 16) { int sq, n; if (row < ML) { sq = row >> 12; n = row & 4095; } else { sq = 2 + ((row - ML) >> 8); n = (row - ML) & 255; }
            AFF[((size_t)sq * 16 + F.lane) * SEQ + n] = ex / den; }
        RT(3);
        gcur = gnx;
    }
#undef LNR_GRP
#undef LNR_LOAD
    __syncthreads();
}

__device__ __forceinline__ unsigned block_excl_scan(unsigned v, LAS unsigned* wsum, int tid, int lane, int wave, unsigned& tot) {
    unsigned inc = v;
#pragma unroll
    for (int o = 1; o < 64; o <<= 1) { const unsigned t = __shfl_up(inc, o); if (lane >= o) inc += t; }
    __syncthreads();
    if (lane == 63) wsum[wave] = inc;
    __syncthreads();
    unsigned off = 0; tot = 0;
#pragma unroll
    for (int w = 0; w < 8; ++w) { const unsigned x = wsum[w]; if (w < wave) off += x; tot += x; }
    return off + inc - v;
}
template <int SHIFT, int NB>
__device__ __forceinline__ void radix_pass(const unsigned (&key)[8], bool valid, unsigned& prefix, unsigned& pmask, unsigned& need, LAS unsigned* hist, LAS unsigned* wsum, LAS unsigned* bc, int tid, int lane, int wave) {
    constexpr int PER = NB / NTHR;
    __syncthreads();
    for (int i = tid; i < NB; i += NTHR) hist[i] = 0u;
    if (tid == 0) { bc[0] = 0u; bc[1] = 1u; }
    __syncthreads();
    if (valid) {
#pragma unroll
        for (int r = 0; r < 8; ++r) if ((key[r] & pmask) == prefix) __hip_atomic_fetch_add(&hist[(key[r] >> SHIFT) & (unsigned)(NB - 1)], 1u, __ATOMIC_RELAXED, __HIP_MEMORY_SCOPE_WORKGROUP); }
    __syncthreads();
    unsigned c[PER], tot = 0u;
#pragma unroll
    for (int q = 0; q < PER; ++q) { c[q] = hist[NB - 1 - (tid * PER + q)]; tot += c[q]; }
    unsigned dummy; unsigned above = block_excl_scan(tot, wsum, tid, lane, wave, dummy);
#pragma unroll
    for (int q = 0; q < PER; ++q) { if (above < need && above + c[q] >= need) { bc[0] = (unsigned)(NB - 1 - (tid * PER + q)); bc[1] = need - above; } above += c[q]; }
    __syncthreads();
    const unsigned digit = bc[0]; need = bc[1];
    prefix |= digit << SHIFT; pmask |= (unsigned)(NB - 1) << SHIFT;
}
__device__ __forceinline__ void topk_phase(Frame& F, int nseq, int er) {
    const float* AFF = WSP(float, WS_AFF); int* XR = WSP(int, WS_IDX); float* GX = WSP(float, WS_GX); int* INV = WSP(int, WS_INV);
    LAS unsigned* hist = (LAS unsigned*)F.lds; LAS unsigned* wsum = hist + 2048; LAS unsigned* bc = hist + 2048 + 16;
    const int tid = F.tid;
    for (int p = F.bid; p < nseq * 16; p += F.G) {
        const int s = p >> 4, e = p & 15, n = seq_len(s), cap = n >> 3;
        const bool valid = tid * 8 < n;
        unsigned key[8];
        { const float* ap = AFF + ((size_t)s * 16 + e) * SEQ + (valid ? tid * 8 : 0); const v4u k0 = *(const v4u*)ap, k1 = *(const v4u*)(ap + 4);
          key[0] = k0.x; key[1] = k0.y; key[2] = k0.z; key[3] = k0.w; key[4] = k1.x; key[5] = k1.y; key[6] = k1.z; key[7] = k1.w; }
        unsigned prefix = 0u, pmask = 0u, need = (unsigned)cap;
        radix_pass<21, 2048>(key, valid, prefix, pmask, need, hist, wsum, bc, tid, F.lane, F.wave);
        radix_pass<10, 2048>(key, valid, prefix, pmask, need, hist, wsum, bc, tid, F.lane, F.wave);
        radix_pass<0, 1024>(key, valid, prefix, pmask, need, hist, wsum, bc, tid, F.lane, F.wave);
        const unsigned T = prefix;
        unsigned neq = 0u;
#pragma unroll
        for (int r = 0; r < 8; ++r) neq += (valid && key[r] == T) ? 1u : 0u;
        unsigned toteq; unsigned eqrank = block_excl_scan(neq, wsum, tid, F.lane, F.wave, toteq);
        unsigned selm = 0u, nsel = 0u;
#pragma unroll
        for (int r = 0; r < 8; ++r) { const bool eq = valid && key[r] == T; const bool sel = valid && (key[r] > T || (eq && eqrank < need)); if (eq) ++eqrank; if (sel) { selm |= 1u << r; ++nsel; } }
        unsigned totsel; unsigned slot = block_excl_scan(nsel, wsum, tid, F.lane, F.wave, totsel);
        const int rbase = seq_row0(s), sb = s == 0 ? 0 : (s == 1 ? 512 : (s == 2 ? 1024 : 1056));
        if (valid) {
#pragma unroll
            for (int r = 0; r < 8; ++r) { const int tok = tid * 8 + r; const bool sel = (selm >> r) & 1u;
                if (sel && slot < (unsigned)cap) { XR[e * er + sb + (int)slot] = rbase + tok; GX[e * er + sb + (int)slot] = __builtin_bit_cast(float, key[r]); }
                INV[(size_t)(rbase + tok) * 16 + e] = (sel && slot < (unsigned)cap) ? (int)slot : -1;
                if (sel) ++slot; } }
        if (s == 3) for (int i = 1088 + tid; i < er; i += NTHR) { XR[e * er + i] = 0; GX[e * er + i] = 0.f; }
        __syncthreads();
    }
    const int nprob = nseq * 16;
    if (F.bid >= nprob && F.G > nprob) { const int lo = nseq == 4 ? CV_DOWN0 : CV_DOWN1; convert_items<true>(F, lo, lo + 16 * 512, 0, 0, (F.bid - nprob) * 8 + F.wave, (F.G - nprob) * 8, 0); }
    else if (F.G <= nprob) { const int lo = nseq == 4 ? CV_DOWN0 : CV_DOWN1; convert_items<true>(F, lo, lo + 16 * 512, 0, 0, F.bid * 8 + F.wave, F.G * 8, 0); }
}

__device__ __forceinline__ int slot_base(int s) { return s == 0 ? 0 : (s == 1 ? 512 : (s == 2 ? 1024 : 1056)); }

template <bool LAST>
__device__ __forceinline__ void combine_phase(Frame& F, int l, int nrows, int er, bool probe = false) {
    const bf16* Hin = WSP(bf16, WS_H); bf16* H = probe ? WSP(bf16, WS_XE) : WSP(bf16, WS_H); bf16* U = probe ? WSP(bf16, WS_A2) : WSP(bf16, WS_U); const float* mod = WSP(float, WS_MOD) + (size_t)l * 3 * 24576; const float* modn = WSP(float, WS_MOD) + (size_t)(l + 1) * 3 * 24576;
    const bf16* YE = WSP(bf16, WS_YE); const int* INV = WSP(int, WS_INV);
    LAS float* LG = (LAS float*)F.lds; LAS float* LB = LG + D; LAS float* G2 = LG + 2 * D; LAS float* SH = LG + 3 * D; LAS float* SC = LG + 4 * D;
    const int ngroups = nrows / 8;
    stage_vec(LG, F.in[6] + (size_t)(l * 2 + 1) * D, D, F.tid); stage_vec(LB, F.in[7] + (size_t)(l * 2 + 1) * D, D, F.tid);
    int cur_mod = -1; Row8 cur, ms; int slot_c = -1, slot_n = -1;
    if (F.bid < ngroups) slot_c = INV[(size_t)(8 * F.bid + F.wave) * 16 + (F.lane & 15)];
    for (int g = F.bid; g < ngroups; g += F.G) {
        const int row = 8 * g + F.wave, mr = group_mod(g);
        if (mr != cur_mod) { __syncthreads(); stage_vec(G2, mod + (size_t)mr * 24576 + 5 * D, D, F.tid);
            if (!LAST) { stage_vec(SH, modn + (size_t)mr * 24576, D, F.tid); stage_vec(SC, modn + (size_t)mr * 24576 + D, D, F.tid); }
            __syncthreads(); cur_mod = mr; }
        v4u hraw[8]; ld_row8_raw(hraw, Hin + (size_t)row * D, F.lane);
        const int gn = g + F.G; if (gn < ngroups) slot_n = INV[(size_t)(8 * gn + F.wave) * 16 + (F.lane & 15)];
#pragma unroll
        for (int j = 0; j < 8; ++j) { ms.a[j] = (f32x4){0.f, 0.f, 0.f, 0.f}; ms.b[j] = (f32x4){0.f, 0.f, 0.f, 0.f}; }
        const int sq = row < ML ? (row >> 12) : 2 + ((row - ML) >> 8); const int sb = slot_base(sq);
        unsigned long long mask = __ballot(slot_c >= 0) & 0xFFFFull;
        while (mask) {
            const int e = __builtin_ctzll(mask); mask &= mask - 1;
            const int slot = __shfl(slot_c, e);
            const bf16* y = YE + ((size_t)e * er + sb + slot) * D;
            v4u yv[8];
#pragma unroll
            for (int j = 0; j < 8; ++j) yv[j] = *(const v4u*)(y + 8 * (F.lane + 64 * j));
#pragma unroll
            for (int j = 0; j < 8; ++j) { ms.a[j] += (f32x4){bflo(yv[j].x), bfhi(yv[j].x), bflo(yv[j].y), bfhi(yv[j].y)}; ms.b[j] += (f32x4){bflo(yv[j].z), bfhi(yv[j].z), bflo(yv[j].w), bfhi(yv[j].w)}; }
        }
        row8_from_raw(cur, hraw);
#pragma unroll
        for (int j = 0; j < 8; ++j) { const int c = 8 * (F.lane + 64 * j); cur.a[j] = DN_ALPHA * cur.a[j] + *(const LAS f32x4*)(G2 + c) * ms.a[j]; cur.b[j] = DN_ALPHA * cur.b[j] + *(const LAS f32x4*)(G2 + c + 4) * ms.b[j]; }
        float mean, rstd; row8_stats(cur, mean, rstd);
#pragma unroll
        for (int j = 0; j < 8; ++j) { const int c = 8 * (F.lane + 64 * j);
            const f32x4 y0 = (cur.a[j] - mean) * rstd * *(const LAS f32x4*)(LG + c) + *(const LAS f32x4*)(LB + c), y1 = (cur.b[j] - mean) * rstd * *(const LAS f32x4*)(LG + c + 4) + *(const LAS f32x4*)(LB + c + 4);
            if (LAST) { __builtin_nontemporal_store(y0, (f32x4*)(F.out + (size_t)row * D + c)); __builtin_nontemporal_store(y1, (f32x4*)(F.out + (size_t)row * D + c + 4)); }
            else { *(v4u*)(H + (size_t)row * D + c) = pack8(y0, y1);
                const f32x4 u0 = y0 * (1.f + *(const LAS f32x4*)(SC + c)) + *(const LAS f32x4*)(SH + c), u1 = y1 * (1.f + *(const LAS f32x4*)(SC + c + 4)) + *(const LAS f32x4*)(SH + c + 4);
                *(v4u*)(U + (size_t)row * D + c) = pack8(u0, u1); }
            asm volatile("" ::: "memory"); }
        slot_c = slot_n;
    }
    __syncthreads();
}

__device__ __forceinline__ void reduce_xzs_ctx(Frame& F) {
    const float* slab = WSP(float, WS_SLAB); bf16* XZS = WSP(bf16, WS_BIG);
    const int gt = F.bid * NTHR + F.tid, NGT = F.G * NTHR;
    for (int i = gt; i < MC * (DIN0 / 8); i += NGT) { const int r = i / (DIN0 / 8), c = (i % (DIN0 / 8)) * 8;
        const float* sp = slab + (size_t)(((r >> 8) + 2 * (c >> 8)) * 4) * 65536 + (r & 255) * 256 + (c & 255);
        f32x4 s0 = (f32x4){0.f, 0.f, 0.f, 0.f}, s1 = s0;
#pragma unroll
        for (int ks = 0; ks < 4; ++ks) { s0 += *(const f32x4*)(sp + (size_t)ks * 65536); s1 += *(const f32x4*)(sp + (size_t)ks * 65536 + 4); }
        *(v4u*)(XZS + (size_t)(ML + r) * DIN0 + c) = pack8(s0, s1); }
}
__device__ __forceinline__ void reduce_act_ctx(Frame& F) {
    const float* slab = WSP(float, WS_SLAB); unsigned char* ACT = WSP(unsigned char, WS_ACT);
    const int gt = F.bid * NTHR + F.tid, NGT = F.G * NTHR;
    for (int i = gt; i < 16 * 256 * 128; i += NGT) { const int e = i >> 15, r = (i >> 7) & 255, chn = i & 127, pn = chn >> 4, cc = (chn & 15) * 8;
        const float* sp = slab + (size_t)((e * 8 + pn) * 2) * 65536 + r * 256 + cc;
        const f32x4 g0 = *(const f32x4*)(sp) + *(const f32x4*)(sp + 65536), g1 = *(const f32x4*)(sp + 4) + *(const f32x4*)(sp + 65536 + 4);
        const f32x4 u0 = *(const f32x4*)(sp + 128) + *(const f32x4*)(sp + 65536 + 128), u1 = *(const f32x4*)(sp + 132) + *(const f32x4*)(sp + 65536 + 132);
        f32x4 a0, a1;
#pragma unroll
        for (int k = 0; k < 4; ++k) { a0[k] = siluf_(g0[k] * W8_INV) * (u0[k] * W8_INV); a1[k] = siluf_(g1[k] * W8_INV) * (u1[k] * W8_INV); }
        v2u w; w.x = pk4_fp8(a0[0], a0[1], a0[2], a0[3]); w.y = pk4_fp8(a1[0], a1[1], a1[2], a1[3]); *(v2u*)(ACT + ((size_t)e * ER0 + 1024 + r) * DE + pn * 128 + cc) = w; }
}
__device__ __forceinline__ void reduce_odd_tail(Frame& F) {
    const float* slab = WSP(float, WS_SLAB); bf16* QKVO = WSP(bf16, WS_BIG); float* Gt = WSP(float, WS_G); const float* gb = F.in[18];
    const int gt = F.bid * NTHR + F.tid, NGT = F.G * NTHR;
    for (int i = gt; i < 82 * 256 * 32; i += NGT) { const int t = i >> 13, r = (i >> 5) & 255, chn = i & 31;
        int pm, pn; if (t < 32) { pm = t; pn = 48; } else { const int j = t - 32, q = j % 25; pm = 32 + j / 25; pn = q < 24 ? 8 + q : 48; }
        if (pn == 48 && chn >= 4) continue;
        const float* sp = slab + (size_t)(t * 2) * 65536 + r * 256 + chn * 8;
        const f32x4 s0 = *(const f32x4*)(sp) + *(const f32x4*)(sp + 65536), s1 = *(const f32x4*)(sp + 4) + *(const f32x4*)(sp + 65536 + 4);
        const size_t row = (size_t)pm * 256 + r;
        if (pn == 48) { *(f32x4*)(Gt + row * 32 + chn * 8) = s0 + *(const f32x4*)(gb + chn * 8); *(f32x4*)(Gt + row * 32 + chn * 8 + 4) = s1 + *(const f32x4*)(gb + chn * 8 + 4); }
        else *(v4u*)(QKVO + row * DIN1 + pn * 256 + chn * 8) = pack8(s0, s1); }
}
typedef short v4i16_t __attribute__((ext_vector_type(4)));
__device__ __forceinline__ bf16x8 row_frag(const LAS unsigned char* T, int stride, int r0, int k0, int fr, int fq) { return *(const LAS bf16x8*)(T + (r0 + fr) * stride + (k0 + fq * 8) * 2); }
__device__ __forceinline__ bf16x8 tr_frag(const LAS unsigned char* T, int stride, int k0, int n0, int fr, int fq) {
    const LAS unsigned char* p0 = T + (k0 + 8 * fq + (fr >> 2)) * stride + n0 * 2 + 8 * (fr & 3);
    const v4i16_t lo = __builtin_amdgcn_ds_read_tr16_b64_v4i16((LAS v4i16_t*)p0);
    const v4i16_t hi = __builtin_amdgcn_ds_read_tr16_b64_v4i16((LAS v4i16_t*)(p0 + 4 * stride));
    return (bf16x8){lo[0], lo[1], lo[2], lo[3], hi[0], hi[1], hi[2], hi[3]};
}
#define MFMA16(a, b, c) __builtin_amdgcn_mfma_f32_16x16x32_bf16((a), (b), (c), 0, 0, 0)
constexpr int ML_QS = 0, ML_KS = 33792, ML_VS = 67584, ML_VW = 76800, ML_SP = 86016, ML_CT = 95232, ML_SM = 129024;
constexpr int SM_A = 0, SM_ROWC = 64, SM_EINT = 128, SM_LOW = 192, SM_W = 256, SM_DEN4 = 320, SM_QN = 576, SM_NST = 640, SM_SCAL = 896, SM_NPART = 904;
__device__ __forceinline__ v4u scale_bf16x8(v4u v, float s) {
    v4u o;
#pragma unroll
    for (int i = 0; i < 4; ++i) { const unsigned w = v[i]; o[i] = pk2(bflo(w) * s, bfhi(w) * s); }
    return o;
}
constexpr int MSC_STRIDE = 576;
__device__ __forceinline__ int mlstm_base(int step, int b, int d) { return step < 4 ? ML + b * CTXL + 64 * (d ? 3 - step : step) : b * SEQ + 64 * (d ? 63 - (step - 4) : (step - 4)); }
__device__ __forceinline__ void mlstm_phase(Frame& F, unsigned long long* racc = nullptr) {
    unsigned long long rprev = RSEL ? __builtin_amdgcn_s_memrealtime() : 0ull;
    const bf16* QKVO = WSP(bf16, WS_BIG); const float* Gt = WSP(float, WS_G); bf16* HD = WSP(bf16, WS_HD);
    LAS unsigned char* QS = F.lds + ML_QS; LAS unsigned char* KS = F.lds + ML_KS; LAS unsigned char* VS = F.lds + ML_VS; LAS unsigned char* VW = F.lds + ML_VW;
    LAS unsigned char* SP = F.lds + ML_SP; LAS unsigned char* CT = F.lds + ML_CT; LAS float* SM = (LAS float*)(F.lds + ML_SM);
    const int wr = F.wave >> 2, wc = F.wave & 3, fr = F.lane & 15, fq = F.lane >> 4, tid = F.tid;
    for (int unit = F.bid; unit < 256; unit += F.G) {
        const int x = unit & 7, y = unit >> 3; const int combo = x + 8 * (y >> 3), jv = y & 7;
        const int b = combo >> 4, h = (combo >> 1) & 7, d = combo & 1;
        f32x4 accC[2][4];
#pragma unroll
        for (int m = 0; m < 2; ++m)
#pragma unroll
            for (int n = 0; n < 4; ++n) accC[m][n] = (f32x4){0.f, 0.f, 0.f, 0.f};
        float n_reg = 0.f;
        v4u kq[4], qq[4], vv;
        {
            const int base = mlstm_base(0, b, d);
#pragma unroll
            for (int i = 0; i < 4; ++i) { const int q = tid + 512 * i, r = q >> 5, cs = q & 31; const size_t row = (size_t)(base + (d ? 63 - r : r));
                kq[i] = *(const v4u*)(QKVO + row * DIN1 + 2048 + h * DQK + cs * 8); qq[i] = (v4u){0u, 0u, 0u, 0u}; }
            { const int r = tid >> 3, cs = tid & 7; const size_t row = (size_t)(base + (d ? 63 - r : r)); vv = *(const v4u*)(QKVO + row * DIN1 + 4096 + h * DV + jv * 64 + cs * 8); }
            if (tid < 256) SM[SM_NST + tid] = 0.f;
        }
        float* msc = WSP(float, WS_MSC) + (size_t)unit * 68 * MSC_STRIDE;
        {
            LAS float* BE = SM + SM_DEN4; LAS float* PMX = SM + SM_DEN4 + 68; LAS float* MP = SM + SM_DEN4 + 136;
            for (int k = F.wave; k < 68; k += 8) {
                const int row = mlstm_base(k, b, d) + (d ? 63 - F.lane : F.lane);
                const float ig = Gt[(size_t)row * 32 + d * 16 + h], fp = Gt[(size_t)row * 32 + d * 16 + 8 + h];
                float bc = logsigmoidf_(fp);
#pragma unroll
                for (int o = 1; o < 64; o <<= 1) { const float t = __shfl_up(bc, o); if (F.lane >= o) bc += t; }
                const float a = ig - bc; float pm = a;
#pragma unroll
                for (int o = 1; o < 64; o <<= 1) { const float t = __shfl_up(pm, o); if (F.lane >= o) pm = fmaxf(pm, t); }
                float* sl = msc + (size_t)k * MSC_STRIDE; sl[F.lane] = a; sl[384 + F.lane] = bc; sl[448 + F.lane] = pm;
                if (F.lane == 63) { BE[k] = bc; PMX[k] = pm; }
            }
            __syncthreads();
            if (tid == 0) { float m = 0.f; for (int k = 0; k < 68; ++k) { MP[k] = m; const float be = BE[k]; m = fmaxf(be + m, be + PMX[k]); } }
            __syncthreads();
            for (int k = F.wave; k < 68; k += 8) {
                float* sl = msc + (size_t)k * MSC_STRIDE; const float a = sl[F.lane], bc = sl[384 + F.lane], pm = sl[448 + F.lane];
                const float m_prev = MP[k], bend = BE[k], m_new = fmaxf(bend + m_prev, bend + PMX[k]);
                const float mcomb = bc + fmaxf(m_prev, pm);
                sl[64 + F.lane] = bc - mcomb - 2.772588722239781f; sl[128 + F.lane] = 0.0625f * __expf(bc + m_prev - mcomb); sl[192 + F.lane] = __expf(-mcomb); sl[256 + F.lane] = __expf(bend + a - m_new);
                if (F.lane == 0) sl[320] = __expf(bend + m_prev - m_new);
            }
            asm volatile("s_waitcnt vmcnt(0)" ::: "memory");
            __syncthreads();
            if (F.wave == 0) { const float* sl = msc;
                SM[SM_A + F.lane] = sl[F.lane]; SM[SM_ROWC + F.lane] = sl[64 + F.lane]; SM[SM_EINT + F.lane] = sl[128 + F.lane]; SM[SM_LOW + F.lane] = sl[192 + F.lane]; SM[SM_W + F.lane] = sl[256 + F.lane];
                if (F.lane == 0) SM[SM_SCAL + 0] = sl[320]; }
        }
        float sc_a = 0.f, sc_r = 0.f, sc_e = 0.f, sc_l = 0.f, sc_w = 0.f, sc_d = 0.f;
#pragma unroll 1
        for (int step = 0; step < 68; ++step) {
            const bool lat = step >= 4;
            const int base = mlstm_base(step, b, d);
#pragma unroll
            for (int i = 0; i < 4; ++i) { const int q = tid + 512 * i, r = q >> 5, cs = q & 31;
                *(LAS v4u*)(KS + r * 528 + cs * 16) = kq[i];
                if (lat) *(LAS v4u*)(QS + r * 528 + cs * 16) = qq[i]; }
            *(LAS v4u*)(VS + (tid >> 3) * 144 + (tid & 7) * 16) = vv;
            RT(5);
            __syncthreads();
            RT(6);
            const float decay = SM[SM_SCAL + 0];
            *(LAS v4u*)(VW + (tid >> 3) * 144 + (tid & 7) * 16) = scale_bf16x8(vv, SM[SM_W + (tid >> 3)]);
            if (step < 67) {
                const int nb = mlstm_base(step + 1, b, d); const bool nlat = step + 1 >= 4;
#pragma unroll
                for (int i = 0; i < 4; ++i) { const int q = tid + 512 * i, r = q >> 5, cs = q & 31; const size_t row = (size_t)(nb + (d ? 63 - r : r));
                    kq[i] = *(const v4u*)(QKVO + row * DIN1 + 2048 + h * DQK + cs * 8);
                    if (nlat) qq[i] = *(const v4u*)(QKVO + row * DIN1 + h * DQK + cs * 8); }
                { const int r = tid >> 3, cs = tid & 7; const size_t row = (size_t)(nb + (d ? 63 - r : r)); vv = *(const v4u*)(QKVO + row * DIN1 + 4096 + h * DV + jv * 64 + cs * 8); }
                if (F.wave == 0) { const float* sl = msc + (size_t)(step + 1) * MSC_STRIDE; sc_a = sl[F.lane]; sc_r = sl[64 + F.lane]; sc_e = sl[128 + F.lane]; sc_l = sl[192 + F.lane]; sc_w = sl[256 + F.lane]; sc_d = sl[320]; }
            }
            if (lat) {
                {
                    const int t = tid >> 3, part = tid & 7; float s = 0.f;
#pragma unroll
                    for (int i = 0; i < 4; ++i) { const v4u xq = *(const LAS v4u*)(QS + t * 528 + (part * 32 + i * 8) * 2);
#pragma unroll
                        for (int k = 0; k < 4; ++k) s += bflo(xq[k]) * SM[SM_NST + part * 32 + i * 8 + 2 * k] + bfhi(xq[k]) * SM[SM_NST + part * 32 + i * 8 + 2 * k + 1]; }
                    s += __shfl_xor(s, 1); s += __shfl_xor(s, 2); s += __shfl_xor(s, 4);
                    if (part == 0) SM[SM_QN + t] = s;
                }
                f32x4 accS[2]; accS[0] = accS[1] = (f32x4){0.f, 0.f, 0.f, 0.f};
#pragma unroll
                for (int ks = 0; ks < 256; ks += 32) { const bf16x8 kf = row_frag(KS, 528, 16 * wc, ks, fr, fq);
#pragma unroll
                    for (int m = 0; m < 2; ++m) accS[m] = MFMA16(kf, row_frag(QS, 528, 32 * wr + 16 * m, ks, fr, fq), accS[m]); }
#pragma unroll
                for (int m = 0; m < 2; ++m) { const int t = 32 * wr + 16 * m + fr, s0 = 16 * wc + 4 * fq; const float rc = SM[SM_ROWC + t];
                    f32x4 p; float ps = 0.f;
#pragma unroll
                    for (int j = 0; j < 4; ++j) { const int s = s0 + j; const float arg = (s <= t) ? rc + SM[SM_A + s] : -100.f; p[j] = accS[m][j] * __expf(arg); ps += p[j]; }
                    ps += __shfl_xor(ps, 16); ps += __shfl_xor(ps, 32);
                    if (fq == 0) SM[SM_DEN4 + t * 4 + wc] = ps;
                    v2u o; o.x = pk2(p[0], p[1]); o.y = pk2(p[2], p[3]); *(LAS v2u*)(SP + t * 144 + s0 * 2) = o; }
            }
            RT(7);
            __syncthreads();
            RT(8);
            if (lat) {
                f32x4 acc1[2], acc2[2]; acc1[0] = acc1[1] = acc2[0] = acc2[1] = (f32x4){0.f, 0.f, 0.f, 0.f};
#pragma unroll
                for (int ks = 0; ks < 256; ks += 32) { const bf16x8 cf = row_frag(CT, 528, 16 * wc, ks, fr, fq);
#pragma unroll
                    for (int m = 0; m < 2; ++m) acc2[m] = MFMA16(cf, row_frag(QS, 528, 32 * wr + 16 * m, ks, fr, fq), acc2[m]); }
#pragma unroll
                for (int ks = 0; ks < 64; ks += 32) { const bf16x8 vf = tr_frag(VS, 144, ks, 16 * wc, fr, fq);
#pragma unroll
                    for (int m = 0; m < 2; ++m) acc1[m] = MFMA16(vf, row_frag(SP, 144, 32 * wr + 16 * m, ks, fr, fq), acc1[m]); }
#pragma unroll
                for (int m = 0; m < 2; ++m) { const int t = 32 * wr + 16 * m + fr; const float ei = SM[SM_EINT + t];
                    const float den = (SM[SM_DEN4 + t * 4 + 0] + SM[SM_DEN4 + t * 4 + 1]) + (SM[SM_DEN4 + t * 4 + 2] + SM[SM_DEN4 + t * 4 + 3]) + ei * SM[SM_QN + t];
                    const float inv = 1.f / fmaxf(fabsf(den), SM[SM_LOW + t]);
                    const f32x4 hv = (acc1[m] + ei * acc2[m]) * inv;
                    const size_t row = (size_t)(base + (d ? 63 - t : t));
                    v2u o; o.x = pk2(hv[0], hv[1]); o.y = pk2(hv[2], hv[3]);
                    *(v2u*)(HD + ((size_t)d * ML + row) * D + h * DV + jv * 64 + 16 * wc + 4 * fq) = o; }
            }
            { const int pp = tid & 127, qt = tid >> 7, q0 = qt * 16; float np0 = 0.f, np1 = 0.f;
#pragma unroll 8
                for (int q = q0; q < q0 + 16; ++q) { const unsigned kv = *(const LAS unsigned*)(KS + q * 528 + pp * 4); const float w = SM[SM_W + q]; np0 += w * bflo(kv); np1 += w * bfhi(kv); }
                *(LAS f32x2*)(SM + SM_NPART + qt * 256 + 2 * pp) = (f32x2){np0, np1}; }
#pragma unroll
            for (int m = 0; m < 2; ++m)
#pragma unroll
                for (int n = 0; n < 4; ++n) accC[m][n] = accC[m][n] * decay;
#pragma unroll
            for (int ks = 0; ks < 64; ks += 32) { bf16x8 vf[2];
#pragma unroll
                for (int m = 0; m < 2; ++m) vf[m] = tr_frag(VW, 144, ks, 32 * wr + 16 * m, fr, fq);
#pragma unroll
                for (int n = 0; n < 4; ++n) { const bf16x8 kf = tr_frag(KS, 528, ks, 64 * wc + 16 * n, fr, fq);
#pragma unroll
                    for (int m = 0; m < 2; ++m) accC[m][n] = MFMA16(kf, vf[m], accC[m][n]); } }
            RT(9);
            __syncthreads();
            RT(10);
#pragma unroll
            for (int m = 0; m < 2; ++m)
#pragma unroll
                for (int n = 0; n < 4; ++n) { const int v = 32 * wr + 16 * m + fr, dd = 64 * wc + 16 * n + 4 * fq; v2u o; o.x = pk2(accC[m][n][0], accC[m][n][1]); o.y = pk2(accC[m][n][2], accC[m][n][3]);
                    *(LAS v2u*)(CT + v * 528 + dd * 2) = o; }
            if (tid < 256) { n_reg = decay * n_reg + ((SM[SM_NPART + tid] + SM[SM_NPART + 256 + tid]) + (SM[SM_NPART + 512 + tid] + SM[SM_NPART + 768 + tid])); SM[SM_NST + tid] = n_reg; }
            if (F.wave == 0 && step < 67) { SM[SM_A + F.lane] = sc_a; SM[SM_ROWC + F.lane] = sc_r; SM[SM_EINT + F.lane] = sc_e; SM[SM_LOW + F.lane] = sc_l; SM[SM_W + F.lane] = sc_w; if (F.lane == 0) SM[SM_SCAL + 0] = sc_d; }
            RT(11);
        }
        __syncthreads();
    }
}
#undef MFMA16

__device__ __forceinline__ void headnorm_phase(Frame& F) {
    const int gw = F.bid * 8 + F.wave, NGW = F.G * 8;
    const bf16* HD = WSP(bf16, WS_HD); const bf16* QKVO = WSP(bf16, WS_BIG); bf16* A2 = WSP(bf16, WS_A2); const float* ng = F.in[19];
    v4u h0[8], h1[8], ov[8], n0[8], n1[8], no[8];
    if (gw < ML) {
#pragma unroll
        for (int j = 0; j < 8; ++j) { const int c = 8 * (F.lane + 64 * j); h0[j] = *(const v4u*)(HD + (size_t)gw * D + c); h1[j] = *(const v4u*)(HD + ((size_t)ML + gw) * D + c); ov[j] = *(const v4u*)(QKVO + (size_t)gw * DIN1 + 8192 + c); } }
    for (int row = gw; row < ML; row += NGW) {
        const int rn = row + NGW;
        if (rn < ML) {
#pragma unroll
            for (int j = 0; j < 8; ++j) { const int c = 8 * (F.lane + 64 * j); n0[j] = *(const v4u*)(HD + (size_t)rn * D + c); n1[j] = *(const v4u*)(HD + ((size_t)ML + rn) * D + c); no[j] = *(const v4u*)(QKVO + (size_t)rn * DIN1 + 8192 + c); } }
#pragma unroll
        for (int j = 0; j < 8; ++j) {
            float v[8];
#pragma unroll
            for (int k = 0; k < 4; ++k) { v[2 * k] = bflo(h0[j][k]) + bflo(h1[j][k]); v[2 * k + 1] = bfhi(h0[j][k]) + bfhi(h1[j][k]); }
            float sm = ((v[0] + v[1]) + (v[2] + v[3])) + ((v[4] + v[5]) + (v[6] + v[7]));
            const float mean = wave_sum(sm) * (1.f / DV); float q = 0.f;
#pragma unroll
            for (int k = 0; k < 8; ++k) { v[k] -= mean; q += v[k] * v[k]; }
            const float rstd = 1.f / sqrtf(wave_sum(q) * (1.f / DV) + LN_EPS);
            const int c = 8 * (F.lane + 64 * j); const f32x4 g0 = *(const f32x4*)(ng + c), g1 = *(const f32x4*)(ng + c + 4);
            v4u w;
            w.x = pk2(sigmoidf_(bflo(ov[j].x)) * v[0] * rstd * g0.x, sigmoidf_(bfhi(ov[j].x)) * v[1] * rstd * g0.y);
            w.y = pk2(sigmoidf_(bflo(ov[j].y)) * v[2] * rstd * g0.z, sigmoidf_(bfhi(ov[j].y)) * v[3] * rstd * g0.w);
            w.z = pk2(sigmoidf_(bflo(ov[j].z)) * v[4] * rstd * g1.x, sigmoidf_(bfhi(ov[j].z)) * v[5] * rstd * g1.y);
            w.w = pk2(sigmoidf_(bflo(ov[j].w)) * v[6] * rstd * g1.z, sigmoidf_(bfhi(ov[j].w)) * v[7] * rstd * g1.w);
            *(v4u*)(A2 + (size_t)row * D + c) = w;
        }
#pragma unroll
        for (int j = 0; j < 8; ++j) { h0[j] = n0[j]; h1[j] = n1[j]; ov[j] = no[j]; }
    }
}
#define XB_TMO      128
#define XB_XCNT(j)  (256  + 64 * (j))
#define XB_XSUB(j)  (1280 + 64 * (j))
#define XB_XGEN(j)  (2304 + 64 * (j))
#define XB_TOP      3328
#define XB_TOPGEN   3392
#define XCD_BAR_WORDS 3456
#define XB_SPIN_CAP (1u << 22)

__device__ __forceinline__ unsigned xb_ld(unsigned* p)              { return __hip_atomic_load(p, __ATOMIC_RELAXED, __HIP_MEMORY_SCOPE_AGENT); }
__device__ __forceinline__ unsigned xb_add(unsigned* p, unsigned v) { return __hip_atomic_fetch_add(p, v, __ATOMIC_RELAXED, __HIP_MEMORY_SCOPE_AGENT); }
__device__ __forceinline__ unsigned xb_xcc_id() { return (unsigned)__builtin_amdgcn_s_getreg((3 << 11) | 20) & 0xFu; }
#define XB_SPIN(cond, bar) do { unsigned _sp = 0; while (cond) { __builtin_amdgcn_s_sleep(1); \
    if ((++_sp & 255u) == 0u) { if (xb_ld(&(bar)[XB_TMO])) break; if (_sp > XB_SPIN_CAP) { atomicAdd(&(bar)[XB_TMO], 1u); break; } } } } while (0)

struct XcdBarrier { unsigned* bar; unsigned x; volatile LAS unsigned* st; };

__device__ __forceinline__ XcdBarrier xcd_barrier_post(unsigned* bar, volatile LAS unsigned* st) {
    XcdBarrier b; b.bar = bar; b.x = xb_xcc_id(); b.st = st;
    if (threadIdx.x == 0) (void)xb_add(&bar[XB_XCNT(b.x)], 1u);
    return b;
}
__device__ __forceinline__ void xcd_barrier_complete(unsigned* bar, unsigned x, unsigned& nloc, unsigned& nx) {
    const unsigned G = gridDim.x * gridDim.y * gridDim.z;
    unsigned sum, cnt, mine, sp = 0u;
    for (;;) {
        sum = 0u; cnt = 0u; mine = 0u;
#pragma unroll
        for (unsigned j = 0; j < 16; ++j) { const unsigned c = xb_ld(&bar[XB_XCNT(j)]); sum += c; cnt += (c > 0u) ? 1u : 0u; mine = (j == x) ? c : mine; }
        if (sum == G) break;
        __builtin_amdgcn_s_sleep(1);
        if ((++sp & 255u) == 0u) { if (xb_ld(&bar[XB_TMO])) break; if (sp > XB_SPIN_CAP) { atomicAdd(&bar[XB_TMO], 1u); break; } }
    }
    nloc = mine > 0u ? mine : 1u; nx = cnt > 0u ? cnt : 1u;
}
__device__ __forceinline__ void xcd_barrier(const int tid, const XcdBarrier& b) {
    asm volatile("s_waitcnt vmcnt(0)" ::: "memory");
    __syncthreads();
    if (tid == 0) {
        unsigned* bar = b.bar;
        __builtin_amdgcn_s_waitcnt(0);
        unsigned nloc = b.st[0], nx = b.st[1];
        if (nloc == 0u) { xcd_barrier_complete(bar, b.x, nloc, nx); b.st[0] = nloc; b.st[1] = nx; }
        const unsigned old = xb_add(&bar[XB_XSUB(b.x)], 1u);
        const unsigned gen = old / nloc;
        if (old + 1u == (gen + 1u) * nloc) {
            __builtin_amdgcn_fence(__ATOMIC_RELEASE, "agent");
            asm volatile("s_waitcnt vmcnt(0)" ::: "memory");
            const unsigned og = xb_add(&bar[XB_TOP], 1u);
            const unsigned tg = og / nx;
            if (og + 1u == (tg + 1u) * nx) xb_add(&bar[XB_TOPGEN], 1u);
            else XB_SPIN(xb_ld(&bar[XB_TOPGEN]) == tg, bar);
            __builtin_amdgcn_fence(__ATOMIC_ACQUIRE, "agent");
            xb_add(&bar[XB_XGEN(b.x)], 1u);
            asm volatile("s_waitcnt vmcnt(0)" ::: "memory");
        } else {
            XB_SPIN(xb_ld(&bar[XB_XGEN(b.x)]) == gen, bar);
            __builtin_amdgcn_fence(__ATOMIC_ACQUIRE, "agent");
            asm volatile("s_waitcnt vmcnt(0)" ::: "memory");
        }
    }
    __syncthreads();
}

constexpr int N_PHASES = 24;
struct Args { const float* in[24]; float* out; unsigned char* ws; int ph_lo, ph_hi; };
__global__ void __launch_bounds__(NTHR, 2) fwd_kernel(Args args) {
    extern __shared__ __attribute__((aligned(16))) unsigned char lds_raw[];
    Frame F;
    F.lds = (LAS unsigned char*)lds_raw;
    F.wave = __builtin_amdgcn_readfirstlane((int)threadIdx.x >> 6) & 7; F.lane = pg8::fresh_lane(); F.tid = F.wave * 64 + F.lane;
    F.bid = blockIdx.x; F.G = gridDim.x; F.ws = args.ws; F.out = args.out;
#pragma unroll
    for (int i = 0; i < 24; ++i) F.in[i] = args.in[i];
    volatile LAS unsigned* MISC = (volatile LAS unsigned*)(F.lds + MISC_OFF);
    if (F.tid < 64) MISC[F.tid] = 0u;
    __syncthreads();
    const int lo = args.ph_lo, hi = args.ph_hi;
    const bool multi = (hi - lo) > 1;
    unsigned* barw = (unsigned*)(F.ws + WS_CTL) + CW_BAR;
    XcdBarrier bar; bar.bar = barw; bar.x = 0; bar.st = MISC + 8;
    if (multi) bar = xcd_barrier_post(barw, MISC + 8);
#ifndef REP_MASK
#define REP_MASK 0u
#endif
#define IN(k) (lo <= (k) && (k) < hi)
#define NREP(k) (1 + (int)((REP_MASK >> (k)) & 1u))
#ifndef TSEL
#define TSEL 0u
#endif
#ifndef TAMP
#define TAMP 4
#endif
    unsigned long long t_prev = TSEL ? __builtin_amdgcn_s_memrealtime() : 0ull, t_acc = 0ull;
#define TMARK(k) do { if (TSEL) { const unsigned long long t_now = __builtin_amdgcn_s_memrealtime(); if ((TSEL >> (k)) & 1u) t_acc += t_now - t_prev; t_prev = t_now; } } while (0)
#define SEAM(k) do { if (IN(k) && IN((k) + 1)) xcd_barrier(F.tid, bar); TMARK(k); F.lane = pg8::fresh_lane(); F.tid = F.wave * 64 + F.lane; } while (0)
#define RUN(k, ...) _Pragma("unroll") for (int rep_ = 0; rep_ < NREP(k); ++rep_) { __VA_ARGS__ }
    LAS unsigned char* ring = F.lds;

    if (IN(0)) { RUN(0, p0_convert(F); __syncthreads(); p0_adaln(F);) } SEAM(0);
    if (IN(1)) { RUN(1, p1_ln0(F);) } SEAM(1);
    if (IN(2)) { RUN(2, { pg8::Gemm g{WSP(bf16, WS_U), WSP(bf16, WS_W1T), D, D, D, 0, 0, nullptr, 0, 0}; pg8::TileOrder S; S.init(1, ML / 256, DIN0 / 256, F.G, F.bid);
            EpiBf16Plain E{WSP(bf16, WS_BIG), DIN0}; pg8::gemm_phase(F.wave, ring, g, S, E); }
        { pg8::Gemm g{WSP(bf16, WS_U), WSP(bf16, WS_W1T), D, D, 1024, 0, 0, nullptr, 0, 2048}; pg8::TailOrder S; S.init(0, 48, 4, 32, 2, F.G, F.bid);
            EpiSlab E{WSP(float, WS_SLAB), 4}; pg8::gemm_phase(F.wave, ring, g, S, E); }) } SEAM(2);
    if (IN(3)) { RUN(3, reduce_xzs_ctx(F);) } SEAM(3);
    if (IN(4)) { RUN(4, lru_phase(F, &t_acc); pool_pass1(F); pool_ctx(F);) } SEAM(4);
    if (IN(5)) { RUN(5, lru_carry(F); pool_pass2(F);) } SEAM(5);
    if (IN(6)) { RUN(6, lru_apply(F);
        pg8::Gemm g{WSP(bf16, WS_DP), WSP(bf16, WS_PWT), DPOOL, 512, 512, 512 * 2, 512 * 512 * 2, nullptr, 0, 0}; pg8::TileOrder S; S.init(4, MT / 256, 2, F.G, F.bid);
        EpiPool E{WSP(bf16, WS_A2), F.in[15]}; pg8::gemm_phase(F.wave, ring, g, S, E);) } SEAM(6);
    if (IN(7)) { RUN(7, { pg8::Gemm g{WSP(bf16, WS_A2), WSP(bf16, WS_W2T), D, D, D, 0, 0, nullptr, 0, 0}; pg8::TileOrder S; S.init(1, ML / 256, D / 256, F.G, F.bid);
            EpiBf16Plain E{WSP(bf16, WS_YE), D}; pg8::gemm_phase(F.wave, ring, g, S, E); }
        { pg8::Gemm g{WSP(bf16, WS_A2), WSP(bf16, WS_W2T), D, D, 512, 0, 0, nullptr, 0, 1024}; pg8::TailOrder S; S.init(0, 32, 8, 32, 2, F.G, F.bid);
            EpiSlab E{WSP(float, WS_SLAB), 8}; pg8::gemm_phase(F.wave, ring, g, S, E); }) } SEAM(7);
    if (IN(8)) { RUN(8, ln_router_phase(F, 0, MT, rep_ > 0, true, &t_acc);) } SEAM(8);
    if (IN(9)) { RUN(9, topk_phase(F, 4, ER0);) } SEAM(9);
    if (IN(10)) { RUN(10, { pg8::Gemm g{WSP(bf16, WS_U8), WSP(bf16, WS_WGU), D, D, D, 0, (size_t)2048 * D, WSP(int, WS_IDX), ER0, 0}; pg8::TileOrder S; S.init(16, 4, 8, F.G, F.bid);
            EpiGU E{WSP(unsigned char, WS_ACT), ER0}; pg8::gemm_phase<true, 1>(F.wave, ring, g, S, E); }
        { pg8::Gemm g{WSP(bf16, WS_U8), WSP(bf16, WS_WGU), D, D, 2048, 0, (size_t)2048 * D, WSP(int, WS_IDX), ER0, 2048}; pg8::TailOrder S; S.init(1, 128, 2, 4, 1, F.G, F.bid);
            EpiSlab E{WSP(float, WS_SLAB), 2}; pg8::gemm_phase<true, 1>(F.wave, ring, g, S, E); }) } SEAM(10);
    if (IN(11)) { RUN(11, reduce_act_ctx(F);) } SEAM(11);
    if (IN(12)) { RUN(12, pg8::Gemm g{WSP(bf16, WS_ACT), WSP(bf16, WS_WDN), DE, DE, DE, (size_t)ER0 * DE, (size_t)D * DE, nullptr, 0, 0}; pg8::TileOrder S; S.init(16, ER0 / 256, 16, F.G, F.bid);
        EpiDown E{WSP(bf16, WS_YE), WSP(float, WS_GX), ER0}; pg8::gemm_phase<false, 1>(F.wave, ring, g, S, E);) } SEAM(12);
    if (IN(13)) { RUN(13, combine_phase<false>(F, 0, MT, ER0, rep_ > 0);) } SEAM(13);
    if (IN(14)) { RUN(14, { pg8::Gemm g{WSP(bf16, WS_U), WSP(bf16, WS_W3T), D, D, D, 0, 0, nullptr, 0, 0}; pg8::TileOrder S; S.init(1, ML / 256, DIN1 / 256, F.G, F.bid);
            EpiOddIn E{WSP(bf16, WS_BIG), WSP(float, WS_G), F.in[18]}; pg8::gemm_phase(F.wave, ring, g, S, E); }
        { pg8::Gemm g{WSP(bf16, WS_U), WSP(bf16, WS_W3T), D, D, 2048, 0, 0, nullptr, 0, 4096}; pg8::TailOrder S; S.init(2, 82, 2, 0, 0, F.G, F.bid);
            EpiSlab E{WSP(float, WS_SLAB), 2}; pg8::gemm_phase(F.wave, ring, g, S, E); }) } SEAM(14);
    if (IN(15)) { RUN(15, reduce_odd_tail(F);) } SEAM(15);
    if (IN(16)) { RUN(16, mlstm_phase(F, &t_acc);) } SEAM(16);
    if (IN(17)) { RUN(17, headnorm_phase(F);) } SEAM(17);
    if (IN(18)) { RUN(18, pg8::Gemm g{WSP(bf16, WS_A2), WSP(bf16, WS_W4T), D, D, D, 0, 0, nullptr, 0, 0}; pg8::TileOrder S; S.init(1, ML / 256, D / 256, F.G, F.bid);
        EpiBf16Plain E{WSP(bf16, WS_YE), D}; pg8::gemm_phase(F.wave, ring, g, S, E);) } SEAM(18);
    if (IN(19)) { RUN(19, ln_router_phase(F, 1, ML, rep_ > 0, false, &t_acc);) } SEAM(19);
    if (IN(20)) { RUN(20, topk_phase(F, 2, ER1);) } SEAM(20);
    if (IN(21)) { RUN(21, pg8::Gemm g{WSP(bf16, WS_U8), (const bf16*)(WSP(unsigned char, WS_WGU) + (size_t)16 * 2048 * D), D, D, D, 0, (size_t)2048 * D, WSP(int, WS_IDX), ER1, 0}; pg8::TileOrder S; S.init(16, ER1 / 256, 8, F.G, F.bid);
        EpiGU E{WSP(unsigned char, WS_ACT), ER1}; pg8::gemm_phase<true, 1>(F.wave, ring, g, S, E);) } SEAM(21);
    if (IN(22)) { RUN(22, pg8::Gemm g{WSP(bf16, WS_ACT), (const bf16*)(WSP(unsigned char, WS_WDN) + (size_t)16 * D * DE), DE, DE, DE, (size_t)ER1 * DE, (size_t)D * DE, nullptr, 0, 0}; pg8::TileOrder S; S.init(16, ER1 / 256, 16, F.G, F.bid);
        EpiDown E{WSP(bf16, WS_YE), WSP(float, WS_GX), ER1}; pg8::gemm_phase<false, 1>(F.wave, ring, g, S, E);) } SEAM(22);
    if (IN(23)) { RUN(23, combine_phase<true>(F, 1, ML, ER1);) }
    TMARK(23);
    if (TSEL && blockIdx.x == 0) { const unsigned long long t_end = __builtin_amdgcn_s_memrealtime(); while (__builtin_amdgcn_s_memrealtime() - t_end < (unsigned long long)TAMP * t_acc) __builtin_amdgcn_s_sleep(8); }
#undef IN
#undef RUN
#undef SEAM
}

#ifndef MK_ONE_LAUNCH
#define MK_ONE_LAUNCH 0
#endif
extern "C" void kernel_launch(void* const* d_in, const int* in_sizes, int n_in, void* d_out, int out_size, void* d_ws, size_t ws_size, hipStream_t stream) {
    static int grid = 0;
    if (grid == 0) {
        if (n_in != 24 || out_size != ML * D || ws_size < WS_END) { fprintf(stderr, "kernel_launch: unexpected shapes (n_in %d, out %d, ws %zu); nothing launched\n", n_in, out_size, ws_size); grid = -1; return; }
        int dev = 0, cus = 0, per_cu = 0;
        if (hipGetDevice(&dev) != hipSuccess || hipDeviceGetAttribute(&cus, hipDeviceAttributeMultiprocessorCount, dev) != hipSuccess) { grid = -1; return; }
        if (hipFuncSetAttribute((const void*)fwd_kernel, hipFuncAttributeMaxDynamicSharedMemorySize, LDS_BYTES) != hipSuccess) { fprintf(stderr, "kernel_launch: hipFuncSetAttribute failed\n"); grid = -1; return; }
        if (hipOccupancyMaxActiveBlocksPerMultiprocessor(&per_cu, (const void*)fwd_kernel, NTHR, LDS_BYTES) != hipSuccess || per_cu < 1) { fprintf(stderr, "kernel_launch: occupancy query says %d\n", per_cu); }
        (void)hipGetLastError();
        grid = cus;
    }
    if (grid < 0) return;
    if (hipMemsetAsync((char*)d_ws + WS_CTL, 0, CTL_ZERO_BYTES, stream) != hipSuccess) return;
    Args a{};
    for (int i = 0; i < 24; ++i) a.in[i] = (const float*)d_in[i];
    a.out = (float*)d_out; a.ws = (unsigned char*)d_ws;
#if MK_ONE_LAUNCH
    a.ph_lo = 0; a.ph_hi = N_PHASES;
    hipLaunchKernelGGL(fwd_kernel, dim3(grid), dim3(NTHR), LDS_BYTES, stream, a);
#else
    for (int p = 0; p < N_PHASES; ++p) { a.ph_lo = p; a.ph_hi = p + 1; hipLaunchKernelGGL(fwd_kernel, dim3(grid), dim3(NTHR), LDS_BYTES, stream, a); }
#endif
}
```
